# Optimizing an MI355X kernel written in HIP

```python
import jax, jax.numpy as jnp
from jax import lax
import numpy as np

D_MODEL = 1024
BATCH = 4
SEQ = 4096
DEPTH = 2

GROUP_HEADS = 4
HEAD_DIM = 64
GROUP_WIDTH = GROUP_HEADS * HEAD_DIM
N_GROUPS = 4
D_MIX = N_GROUPS * GROUP_WIDTH
BLOCK = 128
RET_CHUNK = 128
MLA_Q_RANK = 256
MLA_KV_RANK = 128
MLA_NOPE = 64
MLA_ROPE = 32
MLA_V = 64
ROPE_BASE = 10000.0
FORGET_BIAS_INIT = 4.0
PEER_HEADS = 8
PEER_KEYS = 128
PEER_EXPERTS = PEER_KEYS * PEER_KEYS
PEER_HALF = 128
PEER_QDIM = 2 * PEER_HALF
PEER_TOPK = 16
PEER_CHUNK = 128
EPS = 1e-6
IN_SPLITS = (GROUP_WIDTH,) * 4 + (GROUP_WIDTH,) * 3 + (GROUP_HEADS,) + (GROUP_WIDTH,) * 3 + (MLA_Q_RANK, MLA_KV_RANK, MLA_ROPE)
D_IN = sum(IN_SPLITS)

kernel_name = 'hybrid_ret_fox_sb_mla_peer'


def rms_norm(x, g):
    xf = x.astype(jnp.float32)
    y = xf * lax.rsqrt(jnp.mean(xf * xf, axis=-1, keepdims=True) + EPS)
    return (y * g.astype(jnp.float32)).astype(x.dtype)


def rope_tables(seq, dim):
    pos = jnp.arange(seq, dtype=jnp.float32)
    inv = ROPE_BASE ** (-jnp.arange(0, dim, 2, dtype=jnp.float32) / dim)
    ang = pos[:, None] * inv[None, :]
    return jnp.cos(ang), jnp.sin(ang)


def apply_rope(t, cos, sin):
    t1, t2 = jnp.split(t.astype(jnp.float32), 2, axis=-1)
    return jnp.concatenate([t1 * cos - t2 * sin, t1 * sin + t2 * cos], axis=-1)


def split_heads(t, n):
    b, s, _ = t.shape
    return t.reshape(b, s, n, -1).transpose(0, 2, 1, 3)


def head_norm(o, g, center):
    o = o.astype(jnp.float32)
    if center:
        o = o - jnp.mean(o, axis=-1, keepdims=True)
    o = o * lax.rsqrt(jnp.mean(o * o, axis=-1, keepdims=True) + EPS)
    b, h, s, d = o.shape
    return o.transpose(0, 2, 1, 3).reshape(b, s, h * d) * g.astype(jnp.float32)


def retention_chunkwise(q, k, v):
    b, h, s, d = q.shape
    dv = v.shape[-1]
    n = s // RET_CHUNK
    log_gamma = jnp.log1p(-(2.0 ** (-5.0 - jnp.arange(h, dtype=jnp.float32))))
    i = jnp.arange(RET_CHUNK, dtype=jnp.float32)
    rel = i[:, None] - i[None, :]
    intra = jnp.where(rel >= 0, jnp.exp(log_gamma[:, None, None] * jnp.maximum(rel, 0.0)), 0.0)
    q_decay = jnp.exp(log_gamma[:, None] * (i + 1.0))[:, :, None]
    k_decay = jnp.exp(log_gamma[:, None] * (RET_CHUNK - 1.0 - i))[:, :, None]
    chunk_decay = jnp.exp(log_gamma * RET_CHUNK)[:, None, None]

    def chunks(t):
        return t.astype(jnp.float32).reshape(b, h, n, RET_CHUNK, -1).transpose(2, 0, 1, 3, 4)

    def step(state, inp):
        qi, ki, vi = inp
        inner = jnp.einsum('bhid,bhjd->bhij', qi, ki) * intra
        out = jnp.einsum('bhij,bhjv->bhiv', inner, vi) + jnp.einsum('bhid,bhdv->bhiv', qi * q_decay, state)
        state = state * chunk_decay + jnp.einsum('bhjd,bhjv->bhdv', ki * k_decay, vi)
        return state, out

    state0 = jnp.zeros((b, h, d, dv), jnp.float32)
    _, out = lax.scan(step, state0, (chunks(q), chunks(k), chunks(v)))
    return out.transpose(1, 2, 0, 3, 4).reshape(b, h, s, dv)


def block_softmax_attention(q, k, v, scale, fcum=None):
    b, h, s, dk = q.shape
    n = s // BLOCK
    kf = k.astype(jnp.float32)
    vf = v.astype(jnp.float32)
    key_pos = jnp.arange(s)
    q_blocks = q.astype(jnp.float32).reshape(b, h, n, BLOCK, dk).transpose(2, 0, 1, 3, 4)
    xs = (jnp.arange(n), q_blocks)
    if fcum is not None:
        xs = xs + (fcum.reshape(b, h, n, BLOCK).transpose(2, 0, 1, 3),)

    def one_block(args):
        blk, qi = args[0], args[1]
        logits = jnp.einsum('bhqd,bhkd->bhqk', qi, kf) * scale
        if fcum is not None:
            logits = logits + args[2][..., :, None] - fcum[..., None, :]
        q_pos = blk * BLOCK + jnp.arange(BLOCK)
        logits = jnp.where(key_pos[None, :] <= q_pos[:, None], logits, -jnp.inf)
        p = jax.nn.softmax(logits, axis=-1)
        return jnp.einsum('bhqk,bhkv->bhqv', p, vf)

    out = lax.map(one_block, xs)
    return out.transpose(1, 2, 0, 3, 4).reshape(b, h, s, -1)


def stick_breaking_attention(q, k, v, scale):
    b, h, s, dk = q.shape
    n = s // BLOCK
    kf = k.astype(jnp.float32)
    vf = v.astype(jnp.float32)
    key_pos = jnp.arange(s)
    q_blocks = q.astype(jnp.float32).reshape(b, h, n, BLOCK, dk).transpose(2, 0, 1, 3, 4)

    def one_block(args):
        blk, qi = args
        z = jnp.einsum('bhqd,bhkd->bhqk', qi, kf) * scale
        q_pos = blk * BLOCK + jnp.arange(BLOCK)
        strict = key_pos[None, :] < q_pos[:, None]
        log_rest = jnp.where(strict, jax.nn.log_sigmoid(-z), 0.0)
        after = lax.cumsum(log_rest, axis=3, reverse=True) - log_rest
        w = jnp.where(strict, jnp.exp(jax.nn.log_sigmoid(z) + after), 0.0)
        return jnp.einsum('bhqk,bhkv->bhqv', w, vf)

    out = lax.map(one_block, (jnp.arange(n), q_blocks))
    return out.transpose(1, 2, 0, 3, 4).reshape(b, h, s, -1)


def latent_attention(cq_raw, ckv_raw, kr_raw, norm_cq, norm_ckv, w_uq, w_ukv, cos, sin):
    c_q = rms_norm(cq_raw, norm_cq)
    q = split_heads(c_q @ w_uq, GROUP_HEADS)
    q_nope, q_rope = q[..., :MLA_NOPE], q[..., MLA_NOPE:]
    c_kv = rms_norm(ckv_raw, norm_ckv)
    kv = split_heads(c_kv @ w_ukv, GROUP_HEADS)
    k_nope, v = kv[..., :MLA_NOPE], kv[..., MLA_NOPE:]
    k_rope = apply_rope(kr_raw[:, None], cos, sin)
    q_full = jnp.concatenate([q_nope.astype(jnp.float32), apply_rope(q_rope, cos, sin)], axis=-1)
    k_full = jnp.concatenate([k_nope.astype(jnp.float32), jnp.broadcast_to(k_rope, k_nope.shape[:-1] + (MLA_ROPE,))], axis=-1)
    return block_softmax_attention(q_full, k_full, v, (MLA_NOPE + MLA_ROPE) ** -0.5)


def hybrid_mixer(h, w_in, b_forget, norm_cq, norm_ckv, w_uq, w_ukv, head_gain, w_out, rope64, rope32):
    proj = h @ w_in
    (rq, rk, rv, rg, fq, fk, fv, ff, sq, sk, sv, cq, ckv, kr) = jnp.split(proj, np.cumsum(IN_SPLITS)[:-1].tolist(), axis=-1)
    cos64, sin64 = rope64
    cos32, sin32 = rope32
    gw = GROUP_WIDTH
    q_a = apply_rope(split_heads(rq, GROUP_HEADS), cos64, sin64)
    k_a = apply_rope(split_heads(rk, GROUP_HEADS), cos64, sin64) * HEAD_DIM ** -0.5
    o_a = retention_chunkwise(q_a, k_a, split_heads(rv, GROUP_HEADS))
    y_a = head_norm(o_a, head_gain[0:gw], True) * jax.nn.silu(rg.astype(jnp.float32))
    log_f = jax.nn.log_sigmoid(ff.astype(jnp.float32) + b_forget.astype(jnp.float32))
    fcum = jnp.cumsum(log_f, axis=1).transpose(0, 2, 1)
    o_b = block_softmax_attention(split_heads(fq, GROUP_HEADS), split_heads(fk, GROUP_HEADS), split_heads(fv, GROUP_HEADS), HEAD_DIM ** -0.5, fcum)
    y_b = head_norm(o_b, head_gain[gw:2 * gw], False)
    o_c = stick_breaking_attention(split_heads(sq, GROUP_HEADS), split_heads(sk, GROUP_HEADS), split_heads(sv, GROUP_HEADS), HEAD_DIM ** -0.5)
    y_c = head_norm(o_c, head_gain[2 * gw:3 * gw], False)
    o_d = latent_attention(cq, ckv, kr, norm_cq, norm_ckv, w_uq, w_ukv, cos32, sin32)
    y_d = head_norm(o_d, head_gain[3 * gw:4 * gw], False)
    y = jnp.concatenate([y_a, y_b, y_c, y_d], axis=-1).astype(h.dtype)
    return y @ w_out


def peer_ffn(h, w_query, sub_keys, expert_u, expert_v):
    b, s, d = h.shape
    t = b * s
    ht = h.reshape(t, d)
    q = (ht @ w_query).astype(jnp.float32).reshape(t, PEER_HEADS, 2, PEER_HALF)
    scores = jnp.einsum('thpc,hpnc->thpn', q, sub_keys.astype(jnp.float32))
    top_s, top_i = lax.top_k(scores, PEER_TOPK)
    kk = PEER_TOPK * PEER_TOPK
    cand_s = (top_s[:, :, 0, :, None] + top_s[:, :, 1, None, :]).reshape(t, PEER_HEADS, kk)
    cand_e = (top_i[:, :, 0, :, None] * PEER_KEYS + top_i[:, :, 1, None, :]).reshape(t, PEER_HEADS, kk)
    best_s, best_pos = lax.top_k(cand_s, PEER_TOPK)
    experts = jnp.take_along_axis(cand_e, best_pos, axis=-1)
    gates = jax.nn.softmax(best_s, axis=-1)
    n = t // PEER_CHUNK
    xs = (ht.reshape(n, PEER_CHUNK, d),
          experts.reshape(n, PEER_CHUNK, PEER_HEADS * PEER_TOPK),
          gates.reshape(n, PEER_CHUNK, PEER_HEADS * PEER_TOPK))

    def one_chunk(args):
        xi, ei, gi = args
        act = jax.nn.gelu(jnp.einsum('cd,ckd->ck', xi, expert_u[ei]).astype(jnp.float32), approximate=False)
        return jnp.einsum('ck,ckd->cd', (gi * act).astype(xi.dtype), expert_v[ei])

    return lax.map(one_chunk, xs).reshape(b, s, d)


def setup_inputs(seed: int = 0) -> dict:
    key = jax.random.key(seed)
    ks = jax.random.split(key, 16)
    f32 = jnp.float32

    def normal(k, shape, scale):
        return jax.random.normal(k, shape, f32) * scale

    def gain(k, shape):
        return 1.0 + 0.02 * jax.random.normal(k, shape, f32)

    return {
        'x': normal(ks[0], (BATCH, SEQ, D_MODEL), 1.0),
        'norm_mix': gain(ks[1], (DEPTH, D_MODEL)),
        'w_in': normal(ks[2], (DEPTH, D_MODEL, D_IN), D_MODEL ** -0.5),
        'b_forget': FORGET_BIAS_INIT + 0.5 * jax.random.normal(ks[3], (DEPTH, GROUP_HEADS), f32),
        'norm_cq': gain(ks[4], (DEPTH, MLA_Q_RANK)),
        'norm_ckv': gain(ks[5], (DEPTH, MLA_KV_RANK)),
        'w_uq': normal(ks[6], (DEPTH, MLA_Q_RANK, GROUP_HEADS * (MLA_NOPE + MLA_ROPE)), MLA_Q_RANK ** -0.5),
        'w_ukv': normal(ks[7], (DEPTH, MLA_KV_RANK, GROUP_HEADS * (MLA_NOPE + MLA_V)), MLA_KV_RANK ** -0.5),
        'head_gain': gain(ks[8], (DEPTH, D_MIX)),
        'w_out': normal(ks[9], (DEPTH, D_MIX, D_MODEL), D_MIX ** -0.5),
        'norm_ffn': gain(ks[10], (DEPTH, D_MODEL)),
        'w_query': normal(ks[11], (DEPTH, D_MODEL, PEER_HEADS * PEER_QDIM), D_MODEL ** -0.5),
        'sub_keys': normal(ks[12], (DEPTH, PEER_HEADS, 2, PEER_KEYS, PEER_HALF), PEER_HALF ** -0.5),
        'expert_u': normal(ks[13], (DEPTH, PEER_EXPERTS, D_MODEL), D_MODEL ** -0.5),
        'expert_v': normal(ks[14], (DEPTH, PEER_EXPERTS, D_MODEL), PEER_HEADS ** -0.5),
        'norm_final': gain(ks[15], (D_MODEL,)),
    }


def reference(x, norm_mix, w_in, b_forget, norm_cq, norm_ckv, w_uq, w_ukv, head_gain, w_out,
              norm_ffn, w_query, sub_keys, expert_u, expert_v, norm_final):
    seq = x.shape[1]
    rope64 = rope_tables(seq, HEAD_DIM)
    rope32 = rope_tables(seq, MLA_ROPE)
    for l in range(DEPTH):
        h = rms_norm(x, norm_mix[l])
        x = x + hybrid_mixer(h, w_in[l], b_forget[l], norm_cq[l], norm_ckv[l], w_uq[l], w_ukv[l],
                             head_gain[l], w_out[l], rope64, rope32)
        h = rms_norm(x, norm_ffn[l])
        x = x + peer_ffn(h, w_query[l], sub_keys[l], expert_u[l], expert_v[l])
    return rms_norm(x, norm_final)
```

```cpp
#include <hip/hip_runtime.h>
#include <hip/hip_cooperative_groups.h>
#include <cstdio>
#include <cstdint>
namespace cg = cooperative_groups;

#ifndef MK_N_LAUNCHES
#define MK_N_LAUNCHES 15
#endif
#ifndef NAIVE_MIX
#define NAIVE_MIX 0
#endif
#ifndef NAIVE_SCORE
#define NAIVE_SCORE 0
#endif
#ifndef MIX_KIND_MASK
#define MIX_KIND_MASK 15
#endif
#ifndef MIX_DEBUG
#define MIX_DEBUG 0
#endif
#ifndef REP_KMASK
#define REP_KMASK 15
#endif
#ifndef REP_SUB
#define REP_SUB -2
#endif
#ifndef FULL_UNROLL
#define FULL_UNROLL 1
#endif
#ifndef USE_CG_SYNC
#define USE_CG_SYNC 0
#endif
#ifndef USE_MFMA_GEMM
#define USE_MFMA_GEMM 1
#endif

#define LAS __attribute__((address_space(3)))
#define GAS __attribute__((address_space(1)))
typedef unsigned short bf16_t;
typedef short bf16x8 __attribute__((ext_vector_type(8)));
typedef float f32x4 __attribute__((ext_vector_type(4)));
typedef float f32x2 __attribute__((ext_vector_type(2)));
typedef unsigned u32x4 __attribute__((ext_vector_type(4)));
typedef unsigned u32x2 __attribute__((ext_vector_type(2)));

constexpr int NTOK = 16384, DM = 1024, SEQ = 4096, NBATCH = 4, DEPTH = 2;
constexpr int DIN = 2980, DINP = 3072;
constexpr int NSUB = 9;
constexpr int NPH = 1 + NSUB * DEPTH + 1;
constexpr float EPS = 1e-6f;
constexpr float LOG2E = 1.4426950408889634f;
constexpr float L2_10000 = 13.287712379549449f;
constexpr int NTHREADS = 512, NWAVES = 8;
constexpr float EU_SCALE = 512.0f, EV_SCALE = 64.0f;

constexpr size_t MiB = 1u << 20;
constexpr size_t WS_CTL = 0, CTL_BYTES = 1 * MiB;
constexpr size_t WS_WIN = 2 * MiB;
constexpr size_t WS_WUQ = 14 * MiB;
constexpr size_t WS_WUKV = 14 * MiB + 512 * 1024;
constexpr size_t WS_SKEY = 15 * MiB;
constexpr size_t WS_WOUT = 16 * MiB;
constexpr size_t WS_WQ = 20 * MiB;
constexpr size_t WS_EU = 32 * MiB;
constexpr size_t WS_EV = 96 * MiB;
constexpr size_t WS_XB = 160 * MiB;
constexpr size_t WS_XR = 192 * MiB;
constexpr size_t WS_Y = 256 * MiB;
constexpr size_t WS_SS1 = 288 * MiB;
constexpr size_t WS_PART2 = WS_SS1 + 64 * 1024;
constexpr size_t WS_PARTQ = WS_PART2 + 1 * MiB;
constexpr size_t WS_PARTKV = WS_PARTQ + 256 * 1024;
constexpr size_t WS_LOGF = WS_PARTKV + 256 * 1024;
constexpr size_t WS_FCUM = WS_LOGF + 256 * 1024;
constexpr size_t WS_ROPE64 = WS_FCUM + 256 * 1024;
constexpr size_t WS_ROPE32 = WS_ROPE64 + 1 * MiB;
constexpr size_t WS_EIDX = 292 * MiB;
constexpr size_t WS_EGATE = 300 * MiB;
constexpr size_t WS_ACT = 308 * MiB;
constexpr size_t WS_RQ = WS_ACT + 0 * MiB, WS_RK = WS_ACT + 8 * MiB, WS_RV = WS_ACT + 16 * MiB, WS_RG = WS_ACT + 24 * MiB;
constexpr size_t WS_FQ = WS_ACT + 32 * MiB, WS_FK = WS_ACT + 40 * MiB, WS_FV = WS_ACT + 48 * MiB;
constexpr size_t WS_SQ = WS_ACT + 56 * MiB, WS_SK = WS_ACT + 64 * MiB, WS_SV = WS_ACT + 72 * MiB;
constexpr size_t WS_CQ = WS_ACT + 80 * MiB;
constexpr size_t WS_CKV = WS_ACT + 88 * MiB;
constexpr size_t WS_QD = WS_ACT + 92 * MiB;
constexpr size_t WS_KD = WS_ACT + 104 * MiB;
constexpr size_t WS_VD = WS_ACT + 116 * MiB;
constexpr size_t WS_QP = WS_ACT;
constexpr size_t WS_HQ = WS_Y;
constexpr size_t WS_HS = WS_Y + 16 * MiB;
constexpr size_t WS_PD = WS_ACT;
constexpr size_t WS_C = WS_ACT + 64 * MiB;
constexpr size_t WS_CS = WS_C + 4 * MiB;
constexpr size_t WS_PSS = WS_ACT + 124 * MiB;
constexpr size_t WS_END = WS_ACT + 125 * MiB;

constexpr int CW_QUEUE = 64;
constexpr int CW_BAR = 4096;

__device__ __forceinline__ unsigned f2bf(float f) { unsigned u = __builtin_bit_cast(unsigned, f); return (u + 0x7fffu + ((u >> 16) & 1u)) >> 16; }
typedef float f32x2_t_ __attribute__((ext_vector_type(2))); typedef __bf16 bf16x2_t_ __attribute__((ext_vector_type(2)));
__device__ __forceinline__ unsigned pk2(float lo, float hi) { f32x2_t_ v = {lo, hi}; bf16x2_t_ b = __builtin_convertvector(v, bf16x2_t_); return __builtin_bit_cast(unsigned, b); }
__device__ __forceinline__ float bflo(unsigned w) { return __builtin_bit_cast(float, w << 16); }
__device__ __forceinline__ float bfhi(unsigned w) { return __builtin_bit_cast(float, w & 0xffff0000u); }
__device__ __forceinline__ void unpack8(const u32x4 w, float* d) { d[0] = bflo(w.x); d[1] = bfhi(w.x); d[2] = bflo(w.y); d[3] = bfhi(w.y); d[4] = bflo(w.z); d[5] = bfhi(w.z); d[6] = bflo(w.w); d[7] = bfhi(w.w); }
__device__ __forceinline__ float bf2f(bf16_t h) { return __builtin_bit_cast(float, (unsigned)h << 16); }
__device__ __forceinline__ int dpp_xor1(int v) { return __builtin_amdgcn_update_dpp(0, v, 0xB1, 0xf, 0xf, false); }
__device__ __forceinline__ int dpp_xor2(int v) { return __builtin_amdgcn_update_dpp(0, v, 0x4E, 0xf, 0xf, false); }
__device__ __forceinline__ int dpp_xor8(int v) { return __builtin_amdgcn_update_dpp(0, v, 0x128, 0xf, 0xf, false); }
__device__ __forceinline__ int dpp_xor4(int lo_src  , int hi_src  ) {
    const int t = __builtin_amdgcn_update_dpp(0, lo_src, 0x104, 0xf, 0x5, false);
    return __builtin_amdgcn_update_dpp(t, hi_src, 0x114, 0xf, 0xa, false);
}
__device__ __forceinline__ float dpp_xor8f(float v) { return __builtin_bit_cast(float, dpp_xor8(__builtin_bit_cast(int, v))); }
__device__ __forceinline__ float dpp_xor1f(float v) { return __builtin_bit_cast(float, dpp_xor1(__builtin_bit_cast(int, v))); }
__device__ __forceinline__ float dpp_xor2f(float v) { return __builtin_bit_cast(float, dpp_xor2(__builtin_bit_cast(int, v))); }
__device__ __forceinline__ float dpp_xor4f(float v) { const int i = __builtin_bit_cast(int, v); return __builtin_bit_cast(float, dpp_xor4(i, i)); }
__device__ __forceinline__ float add_xor16(float x) { unsigned a = __builtin_bit_cast(unsigned, x), b = a; asm volatile("" : "+v"(b)); const auto r = __builtin_amdgcn_permlane16_swap(a, b, false, false);
    return __builtin_bit_cast(float, (unsigned)r[0]) + __builtin_bit_cast(float, (unsigned)r[1]); }
__device__ __forceinline__ float add_xor32(float x) { unsigned a = __builtin_bit_cast(unsigned, x), b = a; asm volatile("" : "+v"(b)); const auto r = __builtin_amdgcn_permlane32_swap(a, b, false, false);
    return __builtin_bit_cast(float, (unsigned)r[0]) + __builtin_bit_cast(float, (unsigned)r[1]); }
__device__ __forceinline__ float max_xor16(float x) { unsigned a = __builtin_bit_cast(unsigned, x), b = a; asm volatile("" : "+v"(b)); const auto r = __builtin_amdgcn_permlane16_swap(a, b, false, false);
    return fmaxf(__builtin_bit_cast(float, (unsigned)r[0]), __builtin_bit_cast(float, (unsigned)r[1])); }
__device__ __forceinline__ float wave_sum(float v) {
    v += dpp_xor1f(v); v += dpp_xor2f(v); v += dpp_xor4f(v); v += dpp_xor8f(v);
    return add_xor32(add_xor16(v));
}
__device__ __forceinline__ float fast_exp2(float x) { return __builtin_amdgcn_exp2f(x); }
__device__ __forceinline__ float fast_log2(float x) { return __builtin_amdgcn_logf(x); }
__device__ __forceinline__ float fast_rcp(float x) { return __builtin_amdgcn_rcpf(x); }
__device__ __forceinline__ void sincos_rev(float ang, float& s, float& c) {
    double rv = (double)ang * 0.15915494309189535; rv -= __builtin_floor(rv); const float fr = (float)rv;
    s = __builtin_amdgcn_sinf(fr); c = __builtin_amdgcn_cosf(fr);
}

__device__ __forceinline__ int tid_() { int t = threadIdx.x; asm volatile("" : "+v"(t)); return t; }
__device__ __forceinline__ int bid_() { int b = blockIdx.x; asm volatile("" : "+s"(b)); return b; }
template <class P> __device__ __forceinline__ P* launder(P* q) { GAS P* g = (GAS P*)q; asm volatile("" : "+s"(g)); return (P*)g; }

struct Params {
    const float* x; const float* norm_mix; const float* w_in; const float* b_forget; const float* norm_cq; const float* norm_ckv;
    const float* w_uq; const float* w_ukv; const float* head_gain; const float* w_out; const float* norm_ffn; const float* w_query;
    const float* sub_keys; const float* expert_u; const float* expert_v; const float* norm_final;
    float* out; unsigned char* ws; int ph_lo, ph_hi;
};

__device__ __forceinline__ int colmap_win(int n) {
    const int tile = n >> 8, c = n & 255;
    switch (tile) {
        case 0: case 1: { const int head = c >> 6, j = c & 63, d = (j >> 1) + 32 * (j & 1); return tile * 256 + head * 64 + d; }
        case 2: return 512 + c;
        case 3: return 768 + c;
        case 4: return 1024 + c;
        case 5: return 1280 + c;
        case 6: return 1536 + c;
        case 7: return 1796 + c;
        case 8: return 2052 + c;
        case 9: return 2308 + c;
        case 10: return 2564 + c;
        default:
            if (c < 128) return 2820 + c;
            if (c < 160) { const int j = c - 128, d = (j >> 1) + 16 * (j & 1); return 2948 + d; }
            if (c < 164) return 1792 + (c - 160);
            return -1;
    }
}
__device__ __forceinline__ int colmap_wuq(int n) {
    if (n >= 384) return -1;
    const int head = n / 96, j = n % 96;
    if (j < 64) return head * 96 + j;
    const int jj = j - 64, d = (jj >> 1) + 16 * (jj & 1);
    return head * 96 + 64 + d;
}
template <int MAPK>
__device__ __forceinline__ void transpose_item(const float* W, int K, int Nold, int Nnew, bf16_t* WT, const float* kscale, LAS float* scr, int item, int lane) {
    const int nblk = Nnew / 32, kb = item / nblk, nb = item % nblk, k0 = 64 * kb, n0 = 32 * nb;
    const int nn = n0 + (lane & 31);
    const int old = (MAPK == 0) ? colmap_win(nn) : (MAPK == 1) ? colmap_wuq(nn) : nn;
    const int oldA = __builtin_amdgcn_readlane(old, 0);
    if (oldA >= 0 && __all(old == oldA + (lane & 31))) {
        f32x4 v[8];
#pragma unroll
        for (int i = 0; i < 8; ++i) v[i] = *(const f32x4*)(W + (size_t)(k0 + 8 * i + (lane >> 3)) * Nold + oldA + 4 * (lane & 7));
#pragma unroll
        for (int i = 0; i < 8; ++i) { const int kk = 8 * i + (lane >> 3); const float ks = kscale ? kscale[k0 + kk] : 1.0f; LAS float* d = scr + kk * 33 + 4 * (lane & 7);
            d[0] = v[i].x * ks; d[1] = v[i].y * ks; d[2] = v[i].z * ks; d[3] = v[i].w * ks; }
    } else {
#pragma unroll 8
        for (int i = 0; i < 32; ++i) {
            const int kk = 2 * i + (lane >> 5);
            float v = 0.f;
            if (old >= 0) { v = W[(size_t)(k0 + kk) * Nold + old]; if (kscale) v *= kscale[k0 + kk]; }
            scr[kk * 33 + (lane & 31)] = v;
        }
    }
    asm volatile("s_waitcnt lgkmcnt(0)" ::: "memory");
    const int c = lane & 7;
#pragma unroll
    for (int j = 0; j < 4; ++j) {
        const int n = (lane >> 3) + 8 * j; const LAS float* s = scr + (8 * c) * 33 + n;
        u32x4 o; o.x = pk2(s[0 * 33], s[1 * 33]); o.y = pk2(s[2 * 33], s[3 * 33]); o.z = pk2(s[4 * 33], s[5 * 33]); o.w = pk2(s[6 * 33], s[7 * 33]);
        *(u32x4*)(WT + (size_t)(n0 + n) * K + k0 + 8 * c) = o;
    }
    asm volatile("s_waitcnt lgkmcnt(0)" ::: "memory");
}
__device__ __forceinline__ void cvt_stream(const float* src, bf16_t* dst, size_t n8, size_t g0, size_t gstride) {
    for (size_t g = g0; g < n8; g += gstride) {
        const f32x4 a = *(const f32x4*)(src + g * 8), b = *(const f32x4*)(src + g * 8 + 4);
        u32x4 o; o.x = pk2(a.x, a.y); o.y = pk2(a.z, a.w); o.z = pk2(b.x, b.y); o.w = pk2(b.z, b.w);
        *(u32x4*)(dst + g * 8) = o;
    }
}
__device__ __forceinline__ unsigned pk4_fp8(float a, float b, float c, float d) { int w = 0; w = __builtin_amdgcn_cvt_pk_fp8_f32(a, b, w, false); w = __builtin_amdgcn_cvt_pk_fp8_f32(c, d, w, true); return (unsigned)w; }
__device__ __forceinline__ unsigned pk4_i8(float a, float b, float c, float d) {
    const float M = 12582912.0f;
    const unsigned ua = __builtin_bit_cast(unsigned, fminf(fmaxf(a, -127.f), 127.f) + M) & 255u, ub = __builtin_bit_cast(unsigned, fminf(fmaxf(b, -127.f), 127.f) + M) & 255u;
    const unsigned uc = __builtin_bit_cast(unsigned, fminf(fmaxf(c, -127.f), 127.f) + M) & 255u, ud = __builtin_bit_cast(unsigned, fminf(fmaxf(d, -127.f), 127.f) + M) & 255u;
    return ua | (ub << 8) | (uc << 16) | (ud << 24);
}
__device__ __forceinline__ void cvt_stream_fp8(const float* src, unsigned char* dst, size_t n16, size_t g0, size_t gstride, float sc, const float* colgain = nullptr) {
    for (size_t g = g0; g < n16; g += gstride) {
        f32x4 a = *(const f32x4*)(src + g * 16), b = *(const f32x4*)(src + g * 16 + 4), c = *(const f32x4*)(src + g * 16 + 8), d = *(const f32x4*)(src + g * 16 + 12);
        if (colgain) { const float* cg = colgain + ((g >> 20) * 1024 + (g & 63) * 16); a *= *(const f32x4*)cg; b *= *(const f32x4*)(cg + 4); c *= *(const f32x4*)(cg + 8); d *= *(const f32x4*)(cg + 12); }
        u32x4 o; o.x = pk4_fp8(a.x * sc, a.y * sc, a.z * sc, a.w * sc); o.y = pk4_fp8(b.x * sc, b.y * sc, b.z * sc, b.w * sc); o.z = pk4_fp8(c.x * sc, c.y * sc, c.z * sc, c.w * sc); o.w = pk4_fp8(d.x * sc, d.y * sc, d.z * sc, d.w * sc);
        const size_t row = g >> 6, c16 = g & 63, lay = row >> 14, e = row & 16383;
        *(u32x4*)(dst + (((lay * 8 + (c16 >> 3)) * 16384 + e) * 128 + (c16 & 7) * 16)) = o;
    }
}
__device__ __forceinline__ void experts_convert(const Params& p, unsigned char* ws, size_t g0, size_t gs) {
    cvt_stream_fp8(p.expert_u, ws + WS_EU, (size_t)DEPTH * 16384 * 1024 / 16, g0, gs, EU_SCALE, p.norm_ffn);
    cvt_stream_fp8(p.expert_v, ws + WS_EV, (size_t)DEPTH * 16384 * 1024 / 16, g0, gs, EV_SCALE);
}
__device__ __forceinline__ void phase_prologue(const Params& p, LAS unsigned char* lds) {
    const int tid = tid_(), lane = tid & 63, wave = tid >> 6;
    const int gw = bid_() * NWAVES + wave, NGW = gridDim.x * NWAVES;
    LAS float* scr = (LAS float*)(lds + wave * 16384);
    unsigned char* ws = launder(p.ws);
    constexpr int I_IN = (DM / 64) * (DINP / 32), I_UQ = (256 / 64) * (512 / 32), I_UKV = (128 / 64) * (512 / 32), I_OUT = (DM / 64) * (DM / 32), I_WQ = (DM / 64) * (2048 / 32);
    constexpr int I_L = I_IN + I_UQ + I_UKV + I_OUT + I_WQ;
    for (int it = gw; it < DEPTH * I_L; it += NGW) {
        const int l = it / I_L; int r = it % I_L;
        if (r < I_IN) { transpose_item<0>(p.w_in + (size_t)l * DM * DIN, DM, DIN, DINP, (bf16_t*)(ws + WS_WIN) + (size_t)l * DINP * DM, p.norm_mix + l * DM, scr, r, lane); continue; } r -= I_IN;
        if (r < I_UQ) { transpose_item<1>(p.w_uq + (size_t)l * 256 * 384, 256, 384, 512, (bf16_t*)(ws + WS_WUQ) + (size_t)l * 512 * 256, p.norm_cq + l * 256, scr, r, lane); continue; } r -= I_UQ;
        if (r < I_UKV) { transpose_item<2>(p.w_ukv + (size_t)l * 128 * 512, 128, 512, 512, (bf16_t*)(ws + WS_WUKV) + (size_t)l * 512 * 128, p.norm_ckv + l * 128, scr, r, lane); continue; } r -= I_UKV;
        if (r < I_OUT) { transpose_item<2>(p.w_out + (size_t)l * DM * DM, DM, DM, DM, (bf16_t*)(ws + WS_WOUT) + (size_t)l * DM * DM, p.head_gain + l * DM, scr, r, lane); continue; } r -= I_OUT;
        transpose_item<2>(p.w_query + (size_t)l * DM * 2048, DM, 2048, 2048, (bf16_t*)(ws + WS_WQ) + (size_t)l * 2048 * DM, p.norm_ffn + l * DM, scr, r, lane);
    }
    const size_t g0 = (size_t)bid_() * NTHREADS + tid, gs = (size_t)gridDim.x * NTHREADS;
    cvt_stream(p.sub_keys, (bf16_t*)(ws + WS_SKEY), (size_t)DEPTH * 8 * 2 * 128 * 128 / 8, g0, gs);
    float* pss = (float*)(ws + WS_PSS); bf16_t* xb = (bf16_t*)(ws + WS_XB);
    for (int m0 = gw * 4; m0 < NTOK; m0 += NGW * 4) {
        f32x4 v[4][4];
#pragma unroll
        for (int r = 0; r < 4; ++r) { const f32x4* xr = (const f32x4*)(p.x + (size_t)(m0 + r) * DM) + lane;
#pragma unroll
            for (int j = 0; j < 4; ++j) v[r][j] = xr[64 * j]; }
#pragma unroll
        for (int r = 0; r < 4; ++r) {
            float s = 0.f; u32x2* o8 = (u32x2*)(xb + (size_t)(m0 + r) * DM) + lane;
#pragma unroll
            for (int j = 0; j < 4; ++j) { const f32x4 w = v[r][j]; s += (w.x * w.x + w.y * w.y) + (w.z * w.z + w.w * w.w); u32x2 o; o.x = pk2(w.x, w.y); o.y = pk2(w.z, w.w); o8[64 * j] = o; }
            s = wave_sum(s);
            float z_ = 0.f; asm volatile("" : "+v"(z_));
            if (lane == 0) { *(f32x4*)(pss + (size_t)(m0 + r) * 8) = (f32x4){s, z_, z_, z_}; *(f32x4*)(pss + (size_t)(m0 + r) * 8 + 4) = (f32x4){z_, z_, z_, z_}; }
        }
    }
}

__device__ __forceinline__ void store8_bf16(bf16_t* dst, const float* v) {
    u32x4 o; o.x = pk2(v[0], v[1]); o.y = pk2(v[2], v[3]); o.z = pk2(v[4], v[5]); o.w = pk2(v[6], v[7]);
    *(u32x4*)dst = o;
}
__device__ __forceinline__ void rope8(float* v, const float* tab) {
    const f32x4 a = *(const f32x4*)tab, b = *(const f32x4*)(tab + 4);
    float t1, t2;
    t1 = v[0]; t2 = v[1]; v[0] = t1 * a.x - t2 * a.y; v[1] = t1 * a.y + t2 * a.x;
    t1 = v[2]; t2 = v[3]; v[2] = t1 * a.z - t2 * a.w; v[3] = t1 * a.w + t2 * a.z;
    t1 = v[4]; t2 = v[5]; v[4] = t1 * b.x - t2 * b.y; v[5] = t1 * b.y + t2 * b.x;
    t1 = v[6]; t2 = v[7]; v[6] = t1 * b.z - t2 * b.w; v[7] = t1 * b.w + t2 * b.z;
}

__device__ __forceinline__ void rope_angles(int pos, int i0, float l2step  , float (&cs)[4], float (&sn)[4]) {
    const float fp = (float)pos;
#pragma unroll
    for (int j = 0; j < 4; ++j) {
        const float fr = __builtin_amdgcn_fractf(fp * (fast_exp2(-(float)(i0 + j) * l2step) * 0.15915494309189535f));
        sn[j] = __builtin_amdgcn_sinf(fr); cs[j] = __builtin_amdgcn_cosf(fr);
    }
}
__device__ __forceinline__ void rope8r(float* v, const float (&cs)[4], const float (&sn)[4]) {
#pragma unroll
    for (int j = 0; j < 4; ++j) { const float t1 = v[2 * j], t2 = v[2 * j + 1]; v[2 * j] = t1 * cs[j] - t2 * sn[j]; v[2 * j + 1] = t1 * sn[j] + t2 * cs[j]; }
}

struct EpiInProj {
    unsigned char* ws; const float* b_forget;
    __device__ __forceinline__ void row16(int row, int pn, int wc, int fq, float (&v)[2][8], float rs) const {
        const int pos = row & (SEQ - 1);
#pragma unroll
        for (int bj = 0; bj < 2; ++bj)
#pragma unroll
            for (int e = 0; e < 8; ++e) v[bj][e] *= rs;
        const int cl0 = 32 * wc + 8 * fq;
        switch (pn) {
            case 0: case 1: {
                bf16_t* dst = (bf16_t*)(ws + (pn == 0 ? WS_RQ : WS_RK)) + (size_t)row * 256;
                float cs[4], sn[4]; rope_angles(pos, (cl0 & 63) >> 1, L2_10000 / 32.0f, cs, sn);
#pragma unroll
                for (int bj = 0; bj < 2; ++bj) { const int c = 128 * bj + cl0; rope8r(v[bj], cs, sn);
                    if (pn == 1) {
#pragma unroll
                        for (int e = 0; e < 8; ++e) v[bj][e] *= 0.125f; }
                    store8_bf16(dst + c, v[bj]); }
            } break;
            case 3: {
                bf16_t* dst = (bf16_t*)(ws + WS_RG) + (size_t)row * 256;
#pragma unroll
                for (int bj = 0; bj < 2; ++bj) {
#pragma unroll
                    for (int e = 0; e < 8; ++e) { const float g = v[bj][e]; v[bj][e] = g / (1.0f + __expf(-g)); }
                    store8_bf16(dst + 128 * bj + cl0, v[bj]); }
            } break;
            case 2: case 5: case 6: case 8: case 9: case 4: case 7: {
                const size_t off = pn == 2 ? WS_RV : pn == 4 ? WS_FQ : pn == 5 ? WS_FK : pn == 6 ? WS_FV : pn == 7 ? WS_SQ : pn == 8 ? WS_SK : WS_SV;
                const float sc = (pn == 4 || pn == 7) ? 0.125f * LOG2E : 1.0f;
                bf16_t* dst = (bf16_t*)(ws + off) + (size_t)row * 256;
#pragma unroll
                for (int bj = 0; bj < 2; ++bj) {
#pragma unroll
                    for (int e = 0; e < 8; ++e) v[bj][e] *= sc;
                    store8_bf16(dst + 128 * bj + cl0, v[bj]); }
            } break;
            case 10: {
                bf16_t* dst = (bf16_t*)(ws + WS_CQ) + (size_t)row * 256; float s = 0.f;
#pragma unroll
                for (int bj = 0; bj < 2; ++bj) {
#pragma unroll
                    for (int e = 0; e < 8; ++e) s += v[bj][e] * v[bj][e];
                    store8_bf16(dst + 128 * bj + cl0, v[bj]); }
                s = add_xor32(add_xor16(s));
                if (fq == 0) ((float*)(ws + WS_PARTQ))[row * 4 + wc] = s;
            } break;
            default: {
                float s = 0.f;
#pragma unroll
                for (int e = 0; e < 8; ++e) s += v[0][e] * v[0][e];
                store8_bf16((bf16_t*)(ws + WS_CKV) + (size_t)row * 128 + cl0, v[0]);
                s = add_xor32(add_xor16(s));
                if (fq == 0) ((float*)(ws + WS_PARTKV))[row * 4 + wc] = s;
                if (wc == 0) {
                    { float cs[4], sn[4]; rope_angles(pos, 4 * fq, L2_10000 / 16.0f, cs, sn); rope8r(v[1], cs, sn); }
                    bf16_t* kd = (bf16_t*)(ws + WS_KD) + (size_t)row * 384 + 64 + 8 * fq;
#pragma unroll
                    for (int h = 0; h < 4; ++h) store8_bf16(kd + 96 * h, v[1]);
                } else if (wc == 1 && fq == 0) {
                    f32x4 lf;
#pragma unroll
                    for (int h = 0; h < 4; ++h) { const float z = v[1][h] + ((const __attribute__((address_space(4))) float*)b_forget)[h]; lf[h] = fminf(z, 0.f) - log1pf(__expf(-fabsf(z))); }
                    *(f32x4*)((float*)(ws + WS_LOGF) + (size_t)row * 4) = lf;
                }
            } break;
        }
    }
};
struct EpiMla {
    unsigned char* ws; int which;
    __device__ __forceinline__ void row16(int row, int pn, int wc, int fq, float (&v)[2][8], float rs) const {
        if (which == 0) {
            const int pos = row & (SEQ - 1);
            bf16_t* dst = (bf16_t*)(ws + WS_QD) + (size_t)row * 384;
#pragma unroll
            for (int bj = 0; bj < 2; ++bj) {
                const int n = 256 * pn + 128 * bj + 32 * wc + 8 * fq;
                if (n < 384) {
                    const int j = n % 96;
                    if (j >= 64) { float cs[4], sn[4]; rope_angles(pos, (j - 64) >> 1, L2_10000 / 16.0f, cs, sn); rope8r(v[bj], cs, sn); }
#pragma unroll
                    for (int e = 0; e < 8; ++e) v[bj][e] *= rs;
                    store8_bf16(dst + n, v[bj]);
                }
            }
        } else {
#pragma unroll
            for (int bj = 0; bj < 2; ++bj) {
                const int head = 2 * pn + bj, j = 32 * wc + 8 * fq;
#pragma unroll
                for (int e = 0; e < 8; ++e) v[bj][e] *= rs;
                bf16_t* dst = (j < 64) ? (bf16_t*)(ws + WS_KD) + (size_t)row * 384 + head * 96 + j : (bf16_t*)(ws + WS_VD) + (size_t)row * 256 + head * 64 + (j - 64);
                store8_bf16(dst, v[bj]);
            }
        }
    }
};
struct EpiOutProj {
    unsigned char* ws; const float* resid;
    __device__ __forceinline__ void row16(int row, int pn, int wc, int fq, float (&v)[2][8]) const {
        bf16_t* xb = (bf16_t*)(ws + WS_XB) + (size_t)row * DM;
        float s = 0.f;
#pragma unroll
        for (int bj = 0; bj < 2; ++bj) {
            const int c = 256 * pn + 128 * bj + 32 * wc + 8 * fq;
#pragma unroll
            for (int e = 0; e < 8; ++e) s += v[bj][e] * v[bj][e];
            store8_bf16(xb + c, v[bj]);
        }
        s = add_xor32(add_xor16(s));
        if (fq == 0) ((float*)(ws + WS_PART2))[(size_t)row * 16 + pn * 4 + wc] = s;
    }
};
__device__ __forceinline__ float rstd2_of(const unsigned char* ws, int row) {
    const f32x4* pp = (const f32x4*)((const float*)(ws + WS_PART2) + (size_t)row * 16);
    const f32x4 a = pp[0], b = pp[1], c = pp[2], d = pp[3];
    const float s = (((a.x + a.y) + (a.z + a.w)) + ((b.x + b.y) + (b.z + b.w))) + (((c.x + c.y) + (c.z + c.w)) + ((d.x + d.y) + (d.z + d.w)));
    return 1.0f / sqrtf(s * (1.0f / DM) + EPS);
}
struct EpiQuery {
    unsigned char* ws;
    __device__ __forceinline__ void row16(int row, int pn, int wc, int fq, float (&v)[2][8], float rs) const {
        const int k = 2 * wc + (fq >> 1), hh = fq & 1;
        bf16_t* dst = (bf16_t*)(ws + WS_QP) + ((size_t)(row >> 5) * 8 + pn) * (2 * 8 * 2 * 32 * 8) + (size_t)((k * 2 + hh) * 32 + (row & 31)) * 8;
#pragma unroll
        for (int bj = 0; bj < 2; ++bj) {
#pragma unroll
            for (int e = 0; e < 8; ++e) v[bj][e] *= rs;
            store8_bf16(dst + bj * (8 * 2 * 32 * 8), v[bj]);
        }
    }
};

struct EpiAll {
    unsigned char* ws; const float* aux; int kind;
    __device__ __forceinline__ void row16(int row, int pn, int wc, int fq, float (&v)[2][8], float rs) const {
        unsigned char* w2 = launder(ws);
        if (kind == 0) { EpiInProj E{w2, aux}; E.row16(row, pn, wc, fq, v, rs); }
        else if (kind == 1 || kind == 2) { EpiMla E{w2, kind - 1}; E.row16(row, pn, wc, fq, v, rs); }
        else if (kind == 3) { EpiOutProj E{w2, aux}; E.row16(row, pn, wc, fq, v); }
        else { EpiQuery E{w2}; E.row16(row, pn, wc, fq, v, rs); }
    }
    __device__ __forceinline__ float row_scale(int row) const {
        if (kind == 0) { const f32x4 sa = *(const f32x4*)((const float*)(ws + WS_PSS) + (size_t)row * 8), sb = *(const f32x4*)((const float*)(ws + WS_PSS) + (size_t)row * 8 + 4);
            return 1.0f / sqrtf((((sa.x + sa.y) + (sa.z + sa.w)) + ((sb.x + sb.y) + (sb.z + sb.w))) * (1.0f / DM) + EPS); }
        if (kind == 1 || kind == 2) { const f32x4 pq = *(const f32x4*)((const float*)(ws + (kind == 1 ? WS_PARTQ : WS_PARTKV)) + (size_t)row * 4); const float ssum = (pq.x + pq.y) + (pq.z + pq.w);
            return kind == 1 ? 1.0f / sqrtf(ssum * (1.0f / 256.0f) + EPS) * (0.10206207261596575f * LOG2E) : 1.0f / sqrtf(ssum * (1.0f / 128.0f) + EPS); }
        if (kind == 4) return rstd2_of(ws, row);
        return 1.0f;
    }
};
struct Gemm { const bf16_t* A; const bf16_t* Bt; int M, N, K, lda, ldb; };

template <class Epi>
__device__ __forceinline__ void gemm_naive(const Gemm g, int c0, int G, const Epi& E) {
    const int tid = tid_(), wid = tid >> 6, lane = tid & 63, wr = wid >> 2, wc = wid & 3, fr = lane & 15, fq = lane >> 4;
    const int nM = g.M / 256, nN = g.N / 256;
    for (int u = c0; u < nM * nN; u += G) {
        const int pm = u / nN, pn = u % nN;
        for (int ai = 0; ai < 2; ++ai)
            for (int m = 0; m < 4; ++m) {
                const int row = pm * 256 + ai * 128 + wr * 64 + m * 16 + fr;
                float v[2][8];
#pragma unroll
                for (int bj = 0; bj < 2; ++bj)
#pragma unroll
                    for (int e = 0; e < 8; ++e) v[bj][e] = 0.f;
                const bf16_t* ap = g.A + (size_t)row * g.lda;
                for (int k = 0; k < g.K; k += 8) {
                    const u32x4 aw = *(const u32x4*)(ap + k);
                    const float a0 = bflo(aw.x), a1 = bfhi(aw.x), a2 = bflo(aw.y), a3 = bfhi(aw.y), a4 = bflo(aw.z), a5 = bfhi(aw.z), a6 = bflo(aw.w), a7 = bfhi(aw.w);
#pragma unroll
                    for (int bj = 0; bj < 2; ++bj)
#pragma unroll
                        for (int e = 0; e < 8; ++e) {
                            const int col = pn * 256 + bj * 128 + wc * 32 + fq * 8 + e;
                            const u32x4 bw = *(const u32x4*)(g.Bt + (size_t)col * g.ldb + k);
                            float s = v[bj][e];
                            s += a0 * bflo(bw.x); s += a1 * bfhi(bw.x); s += a2 * bflo(bw.y); s += a3 * bfhi(bw.y); s += a4 * bflo(bw.z); s += a5 * bfhi(bw.z); s += a6 * bflo(bw.w); s += a7 * bfhi(bw.w);
                            v[bj][e] = s;
                        }
                }
                E.row16(row, pn, wc, fq, v, 1.0f);
            }
    }
}

__device__ __forceinline__ void fcum_scan(unsigned char* ws, int seq  , int tid, LAS unsigned char* lds) {
    const int b = seq >> 2, h = seq & 3, lane = tid & 63, wave = tid >> 6;
    const float* lf = (const float*)(ws + WS_LOGF) + (size_t)b * SEQ * 4 + h + (size_t)(wave * 512 + lane * 8) * 4;
    float* fc = (float*)(ws + WS_FCUM) + (size_t)b * SEQ * 4 + h + (size_t)(wave * 512 + lane * 8) * 4;
    float v[8]; float loc = 0.f;
#pragma unroll
    for (int i = 0; i < 8; ++i) v[i] = lf[4 * i];
#pragma unroll
    for (int i = 0; i < 8; ++i) loc += v[i];
    float inc = loc;
#pragma unroll
    for (int o = 1; o < 64; o <<= 1) { const float t = __shfl_up(inc, o); if (lane >= o) inc += t; }
    volatile LAS float* tot = (volatile LAS float*)(lds + 131072 + 1024);
    if (lane == 63) tot[wave] = inc;
    __syncthreads();
    float run = inc - loc;
#pragma unroll
    for (int w = 0; w < 8; ++w) run += (w < wave) ? tot[w] : 0.f;
#pragma unroll
    for (int i = 0; i < 8; ++i) { run += v[i]; fc[4 * i] = run; }
    __syncthreads();
}

__device__ __forceinline__ void load_row64(const bf16_t* p, float* d) {
#pragma unroll
    for (int i = 0; i < 8; ++i) { const u32x4 w = *(const u32x4*)(p + 8 * i); d[8 * i] = bflo(w.x); d[8 * i + 1] = bfhi(w.x); d[8 * i + 2] = bflo(w.y); d[8 * i + 3] = bfhi(w.y); d[8 * i + 4] = bflo(w.z); d[8 * i + 5] = bfhi(w.z); d[8 * i + 6] = bflo(w.w); d[8 * i + 7] = bfhi(w.w); }
}
template <int NCH>
__device__ __forceinline__ float dot_row(const bf16_t* kp, const float* q) {
    float s = 0.f;
#pragma unroll
    for (int i = 0; i < NCH; ++i) { const u32x4 w = *(const u32x4*)(kp + 8 * i);
        s += q[8 * i] * bflo(w.x); s += q[8 * i + 1] * bfhi(w.x); s += q[8 * i + 2] * bflo(w.y); s += q[8 * i + 3] * bfhi(w.y); s += q[8 * i + 4] * bflo(w.z); s += q[8 * i + 5] * bfhi(w.z); s += q[8 * i + 6] * bflo(w.w); s += q[8 * i + 7] * bfhi(w.w); }
    return s;
}
template <int NCH>
__device__ __forceinline__ float dot_rows(const bf16_t* kp, const bf16_t* qp) {
    float s = 0.f;
#pragma unroll
    for (int i = 0; i < NCH; ++i) { const u32x4 w = *(const u32x4*)(kp + 8 * i); const u32x4 q = *(const u32x4*)(qp + 8 * i);
        s += bflo(q.x) * bflo(w.x); s += bfhi(q.x) * bfhi(w.x); s += bflo(q.y) * bflo(w.y); s += bfhi(q.y) * bfhi(w.y); s += bflo(q.z) * bflo(w.z); s += bfhi(q.z) * bfhi(w.z); s += bflo(q.w) * bflo(w.w); s += bfhi(q.w) * bfhi(w.w); }
    return s;
}
__device__ __forceinline__ void axpy_row64(const bf16_t* vp, float w, float* o) {
#pragma unroll
    for (int i = 0; i < 8; ++i) { const u32x4 x = *(const u32x4*)(vp + 8 * i);
        o[8 * i] += w * bflo(x.x); o[8 * i + 1] += w * bfhi(x.x); o[8 * i + 2] += w * bflo(x.y); o[8 * i + 3] += w * bfhi(x.y); o[8 * i + 4] += w * bflo(x.z); o[8 * i + 5] += w * bfhi(x.z); o[8 * i + 6] += w * bflo(x.w); o[8 * i + 7] += w * bfhi(x.w); }
}
__device__ __forceinline__ void head_norm_store(float* o, bool center, const bf16_t* gate, bf16_t* y) {
    if (center) { float m = 0.f;
#pragma unroll
        for (int i = 0; i < 64; ++i) m += o[i];
        m *= (1.0f / 64.0f);
#pragma unroll
        for (int i = 0; i < 64; ++i) o[i] -= m; }
    float s = 0.f;
#pragma unroll
    for (int i = 0; i < 64; ++i) s += o[i] * o[i];
    const float r = 1.0f / sqrtf(s * (1.0f / 64.0f) + EPS);
#pragma unroll
    for (int i = 0; i < 8; ++i) {
        float t[8];
#pragma unroll
        for (int e = 0; e < 8; ++e) t[e] = o[8 * i + e] * r;
        if (gate) { const u32x4 gw = *(const u32x4*)(gate + 8 * i); t[0] *= bflo(gw.x); t[1] *= bfhi(gw.x); t[2] *= bflo(gw.y); t[3] *= bfhi(gw.y); t[4] *= bflo(gw.z); t[5] *= bfhi(gw.z); t[6] *= bflo(gw.w); t[7] *= bfhi(gw.w); }
        store8_bf16(y + 8 * i, t);
    }
}
__device__ __forceinline__ void mixers_naive(unsigned char* ws) {
    const int tid = tid_();
    for (int u = bid_(); u < 512; u += gridDim.x) {
        const int kind = u >> 7, b = (u >> 5) & 3, h = (u >> 3) & 3, qb = u & 7;
        const int t = qb * 512 + tid; const size_t row = (size_t)b * SEQ + t;
        const int tmax = qb * 512 + (tid | 63);
        bf16_t* y = (bf16_t*)(ws + WS_Y) + row * DM + kind * 256 + h * 64;
        float o[64];
#pragma unroll
        for (int i = 0; i < 64; ++i) o[i] = 0.f;
        if (kind == 0) {
            const bf16_t* Q = (const bf16_t*)(ws + WS_RQ) + row * 256 + h * 64; const bf16_t* K = (const bf16_t*)(ws + WS_RK) + (size_t)b * SEQ * 256 + h * 64; const bf16_t* V = (const bf16_t*)(ws + WS_RV) + (size_t)b * SEQ * 256 + h * 64;
            const float lg = log2f(1.0f - exp2f(-5.0f - (float)h));
            for (int s = 0; s <= tmax; ++s) {
                const float d = dot_rows<8>(K + (size_t)s * 256, Q);
                const float w = (s <= t) ? d * fast_exp2(lg * (float)(t - s)) : 0.f;
                axpy_row64(V + (size_t)s * 256, w, o);
            }
            head_norm_store(o, true, (const bf16_t*)(ws + WS_RG) + row * 256 + h * 64, y);
        } else if (kind == 1) {
            const bf16_t* Q = (const bf16_t*)(ws + WS_FQ) + row * 256 + h * 64; const bf16_t* K = (const bf16_t*)(ws + WS_FK) + (size_t)b * SEQ * 256 + h * 64; const bf16_t* V = (const bf16_t*)(ws + WS_FV) + (size_t)b * SEQ * 256 + h * 64;
            const float* fc = (const float*)(ws + WS_FCUM) + (size_t)b * SEQ * 4 + h;
            float mx = -INFINITY, l = 0.f;
            for (int s = 0; s <= tmax; ++s) {
                const float d = dot_rows<8>(K + (size_t)s * 256, Q) - fc[(size_t)s * 4] * LOG2E;
                if (s <= t) {
                    const float mn = fmaxf(mx, d), al = fast_exp2(mx - mn), w = fast_exp2(d - mn);
                    l = l * al + w; mx = mn;
#pragma unroll
                    for (int i = 0; i < 64; ++i) o[i] *= al;
                    axpy_row64(V + (size_t)s * 256, w, o);
                }
            }
            const float il = 1.0f / l;
#pragma unroll
            for (int i = 0; i < 64; ++i) o[i] *= il;
            head_norm_store(o, false, nullptr, y);
        } else if (kind == 2) {
            const bf16_t* Q = (const bf16_t*)(ws + WS_SQ) + row * 256 + h * 64; const bf16_t* K = (const bf16_t*)(ws + WS_SK) + (size_t)b * SEQ * 256 + h * 64; const bf16_t* V = (const bf16_t*)(ws + WS_SV) + (size_t)b * SEQ * 256 + h * 64;
            float R = 0.f;
            for (int s = tmax - 1; s >= 0; --s) {
                const float z = dot_rows<8>(K + (size_t)s * 256, Q);
                const float sp = fmaxf(z, 0.f) + fast_log2(1.0f + fast_exp2(-fabsf(z)));
                if (s < t) {
                    const float w = fast_exp2(z - sp + R); R -= sp;
                    axpy_row64(V + (size_t)s * 256, w, o);
                }
            }
            head_norm_store(o, false, nullptr, y);
        } else {
            const bf16_t* Q = (const bf16_t*)(ws + WS_QD) + row * 384 + h * 96; const bf16_t* K = (const bf16_t*)(ws + WS_KD) + (size_t)b * SEQ * 384 + h * 96; const bf16_t* V = (const bf16_t*)(ws + WS_VD) + (size_t)b * SEQ * 256 + h * 64;
            float mx = -INFINITY, l = 0.f;
            for (int s = 0; s <= tmax; ++s) {
                const float d = dot_rows<12>(K + (size_t)s * 384, Q);
                if (s <= t) {
                    const float mn = fmaxf(mx, d), al = fast_exp2(mx - mn), w = fast_exp2(d - mn);
                    l = l * al + w; mx = mn;
#pragma unroll
                    for (int i = 0; i < 64; ++i) o[i] *= al;
                    axpy_row64(V + (size_t)s * 256, w, o);
                }
            }
            const float il = 1.0f / l;
#pragma unroll
            for (int i = 0; i < 64; ++i) o[i] *= il;
            head_norm_store(o, false, nullptr, y);
        }
    }
}


typedef float f32x16 __attribute__((ext_vector_type(16)));
typedef float f32x2_t __attribute__((ext_vector_type(2)));
typedef __bf16 bf16x2_t __attribute__((ext_vector_type(2)));
typedef short s16x4 __attribute__((ext_vector_type(4)));
typedef _Float16 h16x2 __attribute__((ext_vector_type(2)));
typedef _Float16 h16x4 __attribute__((ext_vector_type(4)));
#define MFMA32(a, b, c) __builtin_amdgcn_mfma_f32_32x32x16_bf16(a, b, c, 0, 0, 0)
__device__ __forceinline__ unsigned cvtpk(float lo, float hi) { f32x2_t v = {lo, hi}; bf16x2_t b = __builtin_convertvector(v, bf16x2_t); return __builtin_bit_cast(unsigned, b); }
__device__ __forceinline__ int crow(int r, int hi) { return (r & 3) + 8 * (r >> 2) + 4 * hi; }
__device__ __forceinline__ void swap32(float x, float& lo, float& hi) {
    unsigned a = __builtin_bit_cast(unsigned, x), b = a; asm volatile("" : "+v"(b));
    const auto r = __builtin_amdgcn_permlane32_swap(a, b, false, false);
    lo = __builtin_bit_cast(float, (unsigned)r[0]); hi = __builtin_bit_cast(float, (unsigned)r[1]);
}
__device__ __forceinline__ float pair_sum(float x) { float lo, hi; swap32(x, lo, hi); return lo + hi; }
__device__ __forceinline__ float pair_max(float x) { float lo, hi; swap32(x, lo, hi); return __builtin_fmaxf(lo, hi); }
__device__ __forceinline__ s16x4 vtr_read(const LAS unsigned char* p) {
    typedef short v4i16_t __attribute__((ext_vector_type(4)));
    return __builtin_bit_cast(s16x4, __builtin_amdgcn_ds_read_tr16_b64_v4i16((LAS v4i16_t*)p));
}
constexpr int MX_KB = 12288, MX_VB = 8192, MX_STAGE = MX_KB + MX_VB + 256, MX_CTL = 2 * MX_STAGE;
constexpr int MIX_UNITS = 1024;


struct CvtCtx { const float* eu; const float* ev; const float* gain; unsigned char* ws; size_t g0, gs; int j; f32x4 v[4]; };
constexpr int CVT_NJ = 32;
constexpr size_t CVT_NU = (size_t)DEPTH * 16384 * 1024 / 16;
__device__ __forceinline__ void cvt_issue(CvtCtx& c) {
    if (c.j < CVT_NJ) { const size_t g = c.g0 + (size_t)c.j * c.gs; const float* src = (g < CVT_NU) ? c.eu + g * 16 : c.ev + (g - CVT_NU) * 16;
        const GAS f32x4* sp = (const GAS f32x4*)src;
#pragma unroll
        for (int q = 0; q < 4; ++q) c.v[q] = sp[q]; }
}
__device__ __forceinline__ void cvt_finish(CvtCtx& c) {
    asm volatile("" :: "v"(c.v[0]), "v"(c.v[1]), "v"(c.v[2]), "v"(c.v[3]));
    if (c.j < CVT_NJ) {
        const size_t g = c.g0 + (size_t)c.j * c.gs; const bool isu = g < CVT_NU; const size_t gl = isu ? g : g - CVT_NU;
        f32x4 a = c.v[0], b = c.v[1], cc = c.v[2], d = c.v[3];
        float sc = EV_SCALE;
        if (isu) sc = EU_SCALE;
        u32x4 o;
        o.x = pk4_i8(a.x * sc, a.y * sc, a.z * sc, a.w * sc); o.y = pk4_i8(b.x * sc, b.y * sc, b.z * sc, b.w * sc); o.z = pk4_i8(cc.x * sc, cc.y * sc, cc.z * sc, cc.w * sc); o.w = pk4_i8(d.x * sc, d.y * sc, d.z * sc, d.w * sc);
        const size_t row = gl >> 6, c16 = gl & 63, lay = row >> 14, e = row & 16383;
        *(u32x4*)(c.ws + (isu ? WS_EU : WS_EV) + (((lay * 8 + (c16 >> 3)) * 16384 + e) * 128 + (c16 & 7) * 16)) = o;
        ++c.j;
    }
}

constexpr int MX_OST = 24576, MX_OROW = 144;
__device__ __forceinline__ void mix_store_rows(const f32x16& o0, const f32x16& o1, float rn, LAS unsigned char* lds, bf16_t* ybase  ,
                                               const bf16_t* gbase  , int lane, int wave, int r32, int hh) {
    LAS unsigned char* stg = lds + MX_OST + wave * (32 * MX_OROW);
#pragma unroll
    for (int q4 = 0; q4 < 4; ++q4) {
        u32x2 w0, w1; w0.x = cvtpk(o0[4 * q4] * rn, o0[4 * q4 + 1] * rn); w0.y = cvtpk(o0[4 * q4 + 2] * rn, o0[4 * q4 + 3] * rn);
        w1.x = cvtpk(o1[4 * q4] * rn, o1[4 * q4 + 1] * rn); w1.y = cvtpk(o1[4 * q4 + 2] * rn, o1[4 * q4 + 3] * rn);
        *(LAS u32x2*)(stg + r32 * MX_OROW + (8 * q4 + 4 * hh) * 2) = w0; *(LAS u32x2*)(stg + r32 * MX_OROW + 64 + (8 * q4 + 4 * hh) * 2) = w1;
    }
    asm volatile("s_waitcnt lgkmcnt(0)" ::: "memory");
#pragma unroll
    for (int i = 0; i < 4; ++i) {
        const int row = 8 * i + (lane >> 3), ch = lane & 7;
        u32x4 v = *(const LAS u32x4*)(stg + row * MX_OROW + ch * 16);
        if (gbase) { const u32x4 g = *(const u32x4*)(gbase + (size_t)row * 256 + ch * 8); float a[8], b[8]; unpack8(v, a); unpack8(g, b);
            v.x = cvtpk(a[0] * b[0], a[1] * b[1]); v.y = cvtpk(a[2] * b[2], a[3] * b[3]); v.z = cvtpk(a[4] * b[4], a[5] * b[5]); v.w = cvtpk(a[6] * b[6], a[7] * b[7]); }
        *(u32x4*)(ybase + (size_t)row * DM + ch * 8) = v;
    }
}
template <int KIND>
__device__ __forceinline__ void mix_unit(unsigned char* ws, int b, int h, int qb, LAS unsigned char* lds, int tid, CvtCtx& cv) {
    constexpr int DK = (KIND == 3) ? 96 : 64, ND0 = DK / 16;
    asm volatile("" : "+v"(tid));
    const int lane = tid & 63, wave = __builtin_amdgcn_readfirstlane(tid >> 6), r32 = lane & 31, hh = lane >> 5;
    const int q0 = qb * 256, qw0 = q0 + 32 * wave, qpos = qw0 + r32;
    const size_t rowb = (size_t)b * SEQ;
    const bf16_t *Qg, *Kg, *Vg; int ldq, ldk, ldv;
    if (KIND == 0) { Qg = (const bf16_t*)(ws + WS_RQ); Kg = (const bf16_t*)(ws + WS_RK); Vg = (const bf16_t*)(ws + WS_RV); ldq = 256; ldk = 256; ldv = 256; }
    else if (KIND == 1) { Qg = (const bf16_t*)(ws + WS_FQ); Kg = (const bf16_t*)(ws + WS_FK); Vg = (const bf16_t*)(ws + WS_FV); ldq = 256; ldk = 256; ldv = 256; }
    else if (KIND == 2) { Qg = (const bf16_t*)(ws + WS_SQ); Kg = (const bf16_t*)(ws + WS_SK); Vg = (const bf16_t*)(ws + WS_SV); ldq = 256; ldk = 256; ldv = 256; }
    else { Qg = (const bf16_t*)(ws + WS_QD); Kg = (const bf16_t*)(ws + WS_KD); Vg = (const bf16_t*)(ws + WS_VD); ldq = 384; ldk = 384; ldv = 256; }
    Qg += rowb * ldq + h * DK; Kg += rowb * ldk + h * DK; Vg += rowb * ldv + h * 64;
    const float* fcg = (const float*)(ws + WS_FCUM) + rowb * 4 + h;
    bf16x8 qf[ND0];
#pragma unroll
    for (int d0 = 0; d0 < ND0; ++d0) qf[d0] = *(const bf16x8*)(Qg + (size_t)qpos * ldq + 16 * d0 + 8 * hh);
    f32x16 o0, o1;
#pragma unroll
    for (int r = 0; r < 16; ++r) { o0[r] = 0.f; o1[r] = 0.f; }
    float m_run = -INFINITY, R_run = 0.f;
    f32x4 ol = {0.f, 0.f, 0.f, 0.f};
    const short one_ = (r32 == 0 || r32 == 8 || r32 == 20 || r32 == 28) ? (short)0x3F80 : (short)0;
    const bf16x8 ones_frag = (bf16x8){one_, one_, one_, one_, one_, one_, one_, one_};
    float lg = 0.f;
    if (KIND == 0) lg = log2f(1.0f - exp2f(-5.0f - (float)h));
    const int NT = (q0 + 256) / 64;
    u32x4 kst0, kst1, vst; float bst = 0.f;
#define MX_LOAD(t_) do { const int k0_ = (t_) * 64; \
        kst0 = *(const u32x4*)(Kg + (size_t)(k0_ + lane) * ldk + wave * 8); \
        if (KIND == 3) { if (wave < 4) kst1 = *(const u32x4*)(Kg + (size_t)(k0_ + lane) * ldk + (8 + wave) * 8); } \
        vst = *(const u32x4*)(Vg + (size_t)(k0_ + 16 * (wave & 3) + (lane >> 2)) * ldv + (wave >> 2) * 32 + (lane & 3) * 8); \
        if (KIND == 1) { if (tid < 64) bst = fcg[(size_t)(k0_ + tid) * 4]; } } while (0)
#define MX_STORE(st_) do { LAS unsigned char* sb_ = lds + (st_) * MX_STAGE; \
        *(LAS u32x4*)(sb_ + wave * 1024 + lane * 16) = kst0; \
        if (KIND == 3) { if (wave < 4) *(LAS u32x4*)(sb_ + (8 + wave) * 1024 + lane * 16) = kst1; } \
        *(LAS u32x4*)(sb_ + MX_KB + (wave >> 2) * 4096 + (wave & 3) * 1024 + lane * 16) = vst; \
        if (KIND == 1) { if (tid < 64) *(LAS float*)(sb_ + MX_KB + MX_VB + tid * 4) = -bst * LOG2E; } } while (0)
    MX_LOAD(NT - 1); MX_STORE(0);
    __syncthreads();
    volatile LAS unsigned* ctl = (volatile LAS unsigned*)(lds + MX_CTL);
    for (int it = 0; it < NT; ++it) {
        const int t = NT - 1 - it, st = it & 1, k0 = t * 64;
        if (it + 1 < NT) MX_LOAD(t - 1);
        if (KIND == 1 || KIND == 3) cvt_issue(cv);
        if (k0 <= qw0 + 31) {
            const LAS unsigned char* sb = lds + st * MX_STAGE;
            const LAS unsigned char* kp = sb + hh * 1024 + r32 * 16;
            f32x16 p0, p1;
            if (KIND == 1) {
                const LAS float* bp = (const LAS float*)(sb + MX_KB + MX_VB) + 4 * hh;
#pragma unroll
                for (int q4 = 0; q4 < 4; ++q4) { const f32x4 b0 = *(const LAS f32x4*)(bp + 8 * q4), b1 = *(const LAS f32x4*)(bp + 32 + 8 * q4);
                    p0[4 * q4] = b0.x; p0[4 * q4 + 1] = b0.y; p0[4 * q4 + 2] = b0.z; p0[4 * q4 + 3] = b0.w; p1[4 * q4] = b1.x; p1[4 * q4 + 1] = b1.y; p1[4 * q4 + 2] = b1.z; p1[4 * q4 + 3] = b1.w; }
            } else {
#pragma unroll
                for (int r = 0; r < 16; ++r) { p0[r] = 0.f; p1[r] = 0.f; }
            }
            s16x4 vlo[8], vhi[8]; bf16x8 kf0[ND0], kf1[ND0];
            if (KIND == 1) {
#pragma unroll
                for (int d0 = 0; d0 < ND0; ++d0) { kf0[d0] = *(const LAS bf16x8*)(kp + d0 * 2048); kf1[d0] = *(const LAS bf16x8*)(kp + d0 * 2048 + 512); }
            }
            { const LAS unsigned char* vp = sb + MX_KB + ((lane >> 4) & 1) * 32 + (lane & 3) * 8 + (4 * hh + ((lane & 15) >> 2)) * 64;
#pragma unroll
              for (int ks = 0; ks < 4; ++ks) { vlo[ks] = vtr_read(vp + ks * 1024); vhi[ks] = vtr_read(vp + ks * 1024 + 512); vlo[4 + ks] = vtr_read(vp + 4096 + ks * 1024); vhi[4 + ks] = vtr_read(vp + 4096 + ks * 1024 + 512); } }
            if (KIND == 1) {
                __builtin_amdgcn_sched_barrier(0);
#pragma unroll
                for (int d0 = 0; d0 < ND0; ++d0) { p0 = MFMA32(kf0[d0], qf[d0], p0); p1 = MFMA32(kf1[d0], qf[d0], p1); }
            } else {
#pragma unroll
                for (int d0 = 0; d0 < ND0; ++d0) { const bf16x8 a0 = *(const LAS bf16x8*)(kp + d0 * 2048), a1 = *(const LAS bf16x8*)(kp + d0 * 2048 + 512); p0 = MFMA32(a0, qf[d0], p0); p1 = MFMA32(a1, qf[d0], p1); }
            }
            const bool band = (k0 + 63 > qw0);
            if (KIND == 1 || KIND == 3) {
                if (band) {
#pragma unroll
                    for (int r = 0; r < 16; ++r) { const int kp0 = k0 + crow(r, hh); if (kp0 > qpos) p0[r] = -INFINITY; if (kp0 + 32 > qpos) p1[r] = -INFINITY; }
                }
                float tm = __builtin_fmaxf(__builtin_fmaxf(p0[0], p0[1]), p1[0]), tm2 = __builtin_fmaxf(__builtin_fmaxf(p0[2], p0[3]), p1[1]);
                tm = __builtin_fmaxf(__builtin_fmaxf(tm, p1[2]), p1[3]);
#pragma unroll
                for (int r = 4; r < 16; r += 4) { tm = __builtin_fmaxf(__builtin_fmaxf(tm, p0[r]), p0[r + 1]); tm2 = __builtin_fmaxf(__builtin_fmaxf(tm2, p0[r + 2]), p0[r + 3]);
                    tm = __builtin_fmaxf(__builtin_fmaxf(tm, p1[r]), p1[r + 1]); tm2 = __builtin_fmaxf(__builtin_fmaxf(tm2, p1[r + 2]), p1[r + 3]); }
                tm = pair_max(__builtin_fmaxf(tm, tm2));
                if (__any(tm > m_run + 8.0f)) {
                    const float mn = fmaxf(m_run, tm), al = fast_exp2(m_run - mn);
                    ol[0] *= al; m_run = mn;
#pragma unroll
                    for (int r = 0; r < 16; ++r) { o0[r] *= al; o1[r] *= al; }
                }
#pragma unroll
                for (int r = 0; r < 16; ++r) { p0[r] = fast_exp2(p0[r] - m_run); p1[r] = fast_exp2(p1[r] - m_run); }
            } else if (KIND == 0) {
                const float base = lg * (float)(qpos - k0 - 4 * hh);
#pragma unroll
                for (int r = 0; r < 16; ++r) {
                    const float c0 = (float)((r & 3) + 8 * (r >> 2));
                    float w0 = fast_exp2(base - lg * c0), w1 = fast_exp2(base - lg * (c0 + 32.0f));
                    if (band) { const int kp0 = k0 + crow(r, hh); if (kp0 > qpos) w0 = 0.f; if (kp0 + 32 > qpos) w1 = 0.f; }
                    p0[r] *= w0; p1[r] *= w1;
                }
            } else {
                float sp0[16], sp1[16];
#pragma unroll
                for (int r = 0; r < 16; ++r) {
                    const float z0 = p0[r], z1 = p1[r];
                    float s0 = fmaxf(z0, 0.f) + fast_log2(1.0f + fast_exp2(-fabsf(z0))), s1 = fmaxf(z1, 0.f) + fast_log2(1.0f + fast_exp2(-fabsf(z1)));
                    if (band) { const int kp0 = k0 + crow(r, hh); if (kp0 >= qpos) s0 = 0.f; if (kp0 + 32 >= qpos) s1 = 0.f; }
                    sp0[r] = s0; sp1[r] = s1;
                }
                float glo[8], ghi[8];
#pragma unroll
                for (int q4 = 0; q4 < 4; ++q4) {
                    swap32((sp0[4 * q4] + sp0[4 * q4 + 1]) + (sp0[4 * q4 + 2] + sp0[4 * q4 + 3]), glo[q4], ghi[q4]);
                    swap32((sp1[4 * q4] + sp1[4 * q4 + 1]) + (sp1[4 * q4 + 2] + sp1[4 * q4 + 3]), glo[4 + q4], ghi[4 + q4]);
                }
                float suf[16]; float run = 0.f;
#pragma unroll
                for (int i = 7; i >= 0; --i) { suf[2 * i + 1] = run; run += ghi[i]; suf[2 * i] = run; run += glo[i]; }
#pragma unroll
                for (int r = 0; r < 16; ++r) {
                    const int q4 = r >> 2, e = r & 3;
                    float in0 = 0.f, in1 = 0.f;
#pragma unroll
                    for (int e2 = 3; e2 > e; --e2) { in0 += sp0[4 * q4 + e2]; in1 += sp1[4 * q4 + e2]; }
                    const float a0 = R_run - (hh ? suf[2 * q4 + 1] : suf[2 * q4]) - in0;
                    const float a1 = R_run - (hh ? suf[2 * (4 + q4) + 1] : suf[2 * (4 + q4)]) - in1;
                    float w0 = fast_exp2(p0[r] - sp0[r] + a0), w1 = fast_exp2(p1[r] - sp1[r] + a1);
                    if (band) { const int kp0 = k0 + crow(r, hh); if (kp0 >= qpos) w0 = 0.f; if (kp0 + 32 >= qpos) w1 = 0.f; }
                    p0[r] = w0; p1[r] = w1;
                }
                R_run -= run;
            }
            bf16x8 pf[4];
            { u32x4 w;
              w.x = cvtpk(p0[0], p0[1]); w.y = cvtpk(p0[2], p0[3]); w.z = cvtpk(p0[4], p0[5]); w.w = cvtpk(p0[6], p0[7]); pf[0] = __builtin_bit_cast(bf16x8, w);
              w.x = cvtpk(p0[8], p0[9]); w.y = cvtpk(p0[10], p0[11]); w.z = cvtpk(p0[12], p0[13]); w.w = cvtpk(p0[14], p0[15]); pf[1] = __builtin_bit_cast(bf16x8, w);
              w.x = cvtpk(p1[0], p1[1]); w.y = cvtpk(p1[2], p1[3]); w.z = cvtpk(p1[4], p1[5]); w.w = cvtpk(p1[6], p1[7]); pf[2] = __builtin_bit_cast(bf16x8, w);
              w.x = cvtpk(p1[8], p1[9]); w.y = cvtpk(p1[10], p1[11]); w.z = cvtpk(p1[12], p1[13]); w.w = cvtpk(p1[14], p1[15]); pf[3] = __builtin_bit_cast(bf16x8, w); }
#pragma unroll
            for (int ks = 0; ks < 4; ++ks) {
                const bf16x8 va = (bf16x8){vlo[ks][0], vlo[ks][1], vlo[ks][2], vlo[ks][3], vhi[ks][0], vhi[ks][1], vhi[ks][2], vhi[ks][3]};
                const bf16x8 vb = (bf16x8){vlo[4 + ks][0], vlo[4 + ks][1], vlo[4 + ks][2], vlo[4 + ks][3], vhi[4 + ks][0], vhi[4 + ks][1], vhi[4 + ks][2], vhi[4 + ks][3]};
                o0 = MFMA32(va, pf[ks], o0); o1 = MFMA32(vb, pf[ks], o1);
                if (KIND == 1 || KIND == 3) ol = __builtin_amdgcn_mfma_f32_16x16x32_bf16(ones_frag, pf[ks], ol, 0, 0, 0);
            }
        }
        if (KIND == 1 || KIND == 3) { __builtin_amdgcn_sched_barrier(0); cvt_finish(cv); }
        if (it + 1 < NT) MX_STORE(st ^ 1);
        if (KIND == 2) { const bool done = (k0 <= qw0 + 31) && !__any(R_run > -64.0f); if (lane == 0) ctl[8 + 8 * (it & 1) + wave] = done ? 1u : 0u; }
        asm volatile("s_waitcnt lgkmcnt(0)\n\ts_barrier" ::: "memory");
        if (KIND == 2) {
            unsigned alld = 1u;
#pragma unroll
            for (int w = 0; w < 8; ++w) alld &= ctl[8 + 8 * (it & 1) + w];
            if (alld) break;
        }
    }
#undef MX_LOAD
#undef MX_STORE
    if (KIND == 1 || KIND == 3) {
        const float inv = 1.0f / ol[0];
#pragma unroll
        for (int r = 0; r < 16; ++r) { o0[r] *= inv; o1[r] *= inv; }
    }
    if (KIND == 0) {
        float sm = 0.f;
#pragma unroll
        for (int r = 0; r < 16; ++r) sm += o0[r] + o1[r];
        const float mean = pair_sum(sm) * (1.0f / 64.0f);
#pragma unroll
        for (int r = 0; r < 16; ++r) { o0[r] -= mean; o1[r] -= mean; }
    }
    float ss = 0.f;
#pragma unroll
    for (int r = 0; r < 16; ++r) ss += o0[r] * o0[r] + o1[r] * o1[r];
    const float rn = 1.0f / sqrtf(pair_sum(ss) * (1.0f / 64.0f) + EPS);
    mix_store_rows(o0, o1, rn, lds, (bf16_t*)(ws + WS_Y) + (rowb + qw0) * DM + KIND * 256 + h * 64, (const bf16_t*)nullptr, lane, wave, r32, hh);
    __syncthreads();
}

__device__ __forceinline__ void mix_unit_ret(unsigned char* ws, int b, int h, int qb, LAS unsigned char* lds, int tid, CvtCtx& cv) {
    constexpr int ND0 = 4;
    asm volatile("" : "+v"(tid));
    const int lane = tid & 63, wave = __builtin_amdgcn_readfirstlane(tid >> 6), r32 = lane & 31, hh = lane >> 5;
    const int q0 = qb * 256, qw0 = q0 + 32 * wave, qpos = qw0 + r32;
    const size_t rowb = (size_t)b * SEQ;
    const bf16_t* Qg = (const bf16_t*)(ws + WS_RQ) + rowb * 256 + h * 64; const bf16_t* Kg = (const bf16_t*)(ws + WS_RK) + rowb * 256 + h * 64; const bf16_t* Vg = (const bf16_t*)(ws + WS_RV) + rowb * 256 + h * 64;
    bf16x8 qf[ND0];
#pragma unroll
    for (int d0 = 0; d0 < ND0; ++d0) qf[d0] = *(const bf16x8*)(Qg + (size_t)qpos * 256 + 16 * d0 + 8 * hh);
    f32x16 o0, o1, sacc;
#pragma unroll
    for (int r = 0; r < 16; ++r) { o0[r] = 0.f; o1[r] = 0.f; sacc[r] = 0.f; }
    const float lg = log2f(1.0f - exp2f(-5.0f - (float)h));
    const int NT = (q0 + 256) / 64;
    const int vrow = 16 * (wave & 3) + (lane >> 2), vcol = (wave >> 2) * 32 + (lane & 3) * 8, voff = (wave >> 2) * 4096 + (wave & 3) * 1024 + lane * 16;
    const int troff = ((lane >> 4) & 1) * 32 + (lane & 3) * 8 + (4 * hh + ((lane & 15) >> 2)) * 64;
    u32x4 kst0, vst;
#define RT_LOAD(it_) do { const int k0_ = (NT - 1 - (it_)) * 64; \
        if ((it_) < 4) kst0 = *(const u32x4*)(Kg + (size_t)(k0_ + lane) * 256 + wave * 8); \
        else kst0 = *(const u32x4*)(Kg + (size_t)(k0_ + vrow) * 256 + vcol); \
        vst = *(const u32x4*)(Vg + (size_t)(k0_ + vrow) * 256 + vcol); } while (0)
#define RT_STORE(st_, it_) do { LAS unsigned char* sb_ = lds + (st_) * MX_STAGE; \
        if ((it_) < 4) *(LAS u32x4*)(sb_ + wave * 1024 + lane * 16) = kst0; \
        else { const float dc = fast_exp2(lg * (float)(q0 - 1 - ((NT - 1 - (it_)) * 64 + vrow))); float f_[8]; unpack8(kst0, f_); \
               u32x4 w_; w_.x = cvtpk(f_[0] * dc, f_[1] * dc); w_.y = cvtpk(f_[2] * dc, f_[3] * dc); w_.z = cvtpk(f_[4] * dc, f_[5] * dc); w_.w = cvtpk(f_[6] * dc, f_[7] * dc); \
               *(LAS u32x4*)(sb_ + voff) = w_; } \
        *(LAS u32x4*)(sb_ + MX_KB + voff) = vst; } while (0)
    RT_LOAD(0); RT_STORE(0, 0);
    __syncthreads();
    for (int it = 0; it < NT; ++it) {
        const int st = it & 1, k0 = (NT - 1 - it) * 64;
        if (it + 1 < NT) RT_LOAD(it + 1);
        const LAS unsigned char* sb = lds + st * MX_STAGE;
        if (it < 4) {
            if (k0 <= qw0 + 31) {
                const LAS unsigned char* kp = sb + hh * 1024 + r32 * 16;
                f32x16 p0, p1;
#pragma unroll
                for (int r = 0; r < 16; ++r) { p0[r] = 0.f; p1[r] = 0.f; }
#pragma unroll
                for (int d0 = 0; d0 < ND0; ++d0) { const bf16x8 a0 = *(const LAS bf16x8*)(kp + d0 * 2048), a1 = *(const LAS bf16x8*)(kp + d0 * 2048 + 512); p0 = MFMA32(a0, qf[d0], p0); p1 = MFMA32(a1, qf[d0], p1); }
                float lgi = lg; asm volatile("" : "+v"(lgi));
                const float base = lgi * (float)(qpos - k0 - 4 * hh);
#pragma unroll
                for (int r = 0; r < 16; ++r) {
                    const float c0 = (float)((r & 3) + 8 * (r >> 2));
                    float w0 = fast_exp2(base - lgi * c0), w1 = fast_exp2(base - lgi * (c0 + 32.0f));
                    const int kp0 = k0 + crow(r, hh); if (kp0 > qpos) w0 = 0.f; if (kp0 + 32 > qpos) w1 = 0.f;
                    p0[r] *= w0; p1[r] *= w1;
                }
                bf16x8 pf[4];
                { u32x4 w;
                  w.x = cvtpk(p0[0], p0[1]); w.y = cvtpk(p0[2], p0[3]); w.z = cvtpk(p0[4], p0[5]); w.w = cvtpk(p0[6], p0[7]); pf[0] = __builtin_bit_cast(bf16x8, w);
                  w.x = cvtpk(p0[8], p0[9]); w.y = cvtpk(p0[10], p0[11]); w.z = cvtpk(p0[12], p0[13]); w.w = cvtpk(p0[14], p0[15]); pf[1] = __builtin_bit_cast(bf16x8, w);
                  w.x = cvtpk(p1[0], p1[1]); w.y = cvtpk(p1[2], p1[3]); w.z = cvtpk(p1[4], p1[5]); w.w = cvtpk(p1[6], p1[7]); pf[2] = __builtin_bit_cast(bf16x8, w);
                  w.x = cvtpk(p1[8], p1[9]); w.y = cvtpk(p1[10], p1[11]); w.z = cvtpk(p1[12], p1[13]); w.w = cvtpk(p1[14], p1[15]); pf[3] = __builtin_bit_cast(bf16x8, w); }
                const LAS unsigned char* vp = sb + MX_KB + troff;
#pragma unroll
                for (int ks = 0; ks < 4; ++ks) {
                    const s16x4 a_lo = vtr_read(vp + ks * 1024), a_hi = vtr_read(vp + ks * 1024 + 512), b_lo = vtr_read(vp + 4096 + ks * 1024), b_hi = vtr_read(vp + 4096 + ks * 1024 + 512);
                    const bf16x8 va = (bf16x8){a_lo[0], a_lo[1], a_lo[2], a_lo[3], a_hi[0], a_hi[1], a_hi[2], a_hi[3]};
                    const bf16x8 vb = (bf16x8){b_lo[0], b_lo[1], b_lo[2], b_lo[3], b_hi[0], b_hi[1], b_hi[2], b_hi[3]};
                    o0 = MFMA32(va, pf[ks], o0); o1 = MFMA32(vb, pf[ks], o1);
                }
            }
        } else {
            const int bd = (wave >> 1) & 1, bk = wave & 1, ks0 = 2 * (wave >> 2);
            const LAS unsigned char* vp = sb + MX_KB + troff + bd * 4096; const LAS unsigned char* kq = sb + troff + bk * 4096;
#pragma unroll
            for (int q = 0; q < 2; ++q) {
                const s16x4 a_lo = vtr_read(vp + (ks0 + q) * 1024), a_hi = vtr_read(vp + (ks0 + q) * 1024 + 512);
                const s16x4 b_lo = vtr_read(kq + (ks0 + q) * 1024), b_hi = vtr_read(kq + (ks0 + q) * 1024 + 512);
                const bf16x8 va = (bf16x8){a_lo[0], a_lo[1], a_lo[2], a_lo[3], a_hi[0], a_hi[1], a_hi[2], a_hi[3]};
                const bf16x8 kb = (bf16x8){b_lo[0], b_lo[1], b_lo[2], b_lo[3], b_hi[0], b_hi[1], b_hi[2], b_hi[3]};
                sacc = MFMA32(va, kb, sacc);
            }
        }
        if (it + 1 < NT) RT_STORE(st ^ 1, it + 1);
        asm volatile("s_waitcnt lgkmcnt(0)\n\ts_barrier" ::: "memory");
    }
#undef RT_LOAD
#undef RT_STORE
    if (NT > 4) {
        const int bd = (wave >> 1) & 1, bk = wave & 1;
        LAS float* sx = (LAS float*)lds + (bd * 2 + bk) * 1024 + lane;
        if (wave >= 4) {
#pragma unroll
            for (int r = 0; r < 16; ++r) sx[r * 64] = sacc[r];
        }
        __syncthreads();
        LAS unsigned char* ksb = lds + 16384;
        if (wave < 4) {
#pragma unroll
            for (int r = 0; r < 16; ++r) {
                const float v = sacc[r] + sx[r * 64];
                const int dv = 32 * bd + crow(r, hh), dk = 32 * bk + r32;
                *(LAS bf16_t*)(ksb + (dk >> 3) * 1024 + dv * 16 + (dk & 7) * 2) = (bf16_t)f2bf(v);
            }
        }
        __syncthreads();
        const LAS unsigned char* kp = ksb + hh * 1024 + r32 * 16;
        f32x16 p0, p1;
#pragma unroll
        for (int r = 0; r < 16; ++r) { p0[r] = 0.f; p1[r] = 0.f; }
#pragma unroll
        for (int d0 = 0; d0 < ND0; ++d0) { const bf16x8 a0 = *(const LAS bf16x8*)(kp + d0 * 2048), a1 = *(const LAS bf16x8*)(kp + d0 * 2048 + 512); p0 = MFMA32(a0, qf[d0], p0); p1 = MFMA32(a1, qf[d0], p1); }
        const float ff = fast_exp2(lg * (float)(qpos - q0 + 1));
#pragma unroll
        for (int r = 0; r < 16; ++r) { o0[r] += p0[r] * ff; o1[r] += p1[r] * ff; }
    }
    float sm = 0.f;
#pragma unroll
    for (int r = 0; r < 16; ++r) sm += o0[r] + o1[r];
    const float mean = pair_sum(sm) * (1.0f / 64.0f);
#pragma unroll
    for (int r = 0; r < 16; ++r) { o0[r] -= mean; o1[r] -= mean; }
    float ss = 0.f;
#pragma unroll
    for (int r = 0; r < 16; ++r) ss += o0[r] * o0[r] + o1[r] * o1[r];
    const float rn = 1.0f / sqrtf(pair_sum(ss) * (1.0f / 64.0f) + EPS);
    mix_store_rows(o0, o1, rn, lds, (bf16_t*)(ws + WS_Y) + (rowb + qw0) * DM + h * 64, (const bf16_t*)(ws + WS_RG) + (rowb + qw0) * 256 + h * 64, lane, wave, r32, hh);
    __syncthreads();
}
template <int SET>
__device__ __forceinline__ void mixers_mfma(const Params& p, unsigned char* ws, int layer, LAS unsigned char* lds) {
    const int tid = tid_();
    CvtCtx cv; cv.eu = p.expert_u; cv.ev = p.expert_v; cv.gain = p.norm_ffn; cv.ws = ws; cv.g0 = (size_t)bid_() * NTHREADS + tid; cv.gs = (size_t)gridDim.x * NTHREADS;
    cv.j = (SET == 1 && layer == 0) ? 0 : CVT_NJ;
#pragma unroll
    for (int q = 0; q < 4; ++q) cv.v[q] = (f32x4){0.f, 0.f, 0.f, 0.f};
    unsigned* qhead = (unsigned*)(ws + WS_CTL) + CW_QUEUE + 64 * (2 * layer + SET);
    volatile LAS unsigned* ctl = (volatile LAS unsigned*)(lds + MX_CTL);
    for (;;) {
        if (tid == 0) ctl[0] = atomicAdd(qhead, 1u);
        __syncthreads();
        const unsigned i = ctl[0];
        __syncthreads();
        if (i >= (unsigned)(MIX_UNITS / 2)) break;
        int kind, qb; const int bh = (int)(i & 15u);
        if (SET == 1) { qb = 15 - (int)(i >> 5); kind = (i & 16u) ? 3 : 1; }
        else if (i < 80u) { kind = 0; qb = 15 - (int)(i >> 4); }
        else if (i < 336u) { kind = 2; qb = 15 - (int)((i - 80u) >> 4); }
        else { kind = 0; qb = 10 - (int)((i - 336u) >> 4); }
        const int b = bh >> 2, h = bh & 3;
        if (SET == 1) { if (kind == 1) mix_unit<1>(ws, b, h, qb, lds, tid, cv); else mix_unit<3>(ws, b, h, qb, lds, tid, cv); }
        else { if (kind == 0) mix_unit_ret(ws, b, h, qb, lds, tid, cv); else mix_unit<2>(ws, b, h, qb, lds, tid, cv); }
    }
    if (SET == 1) { while (cv.j < CVT_NJ) { cvt_issue(cv); cvt_finish(cv); } }
}

#define TOPK_INSERT(tv, ti, vv, ii) do { float v_ = (vv); int i_ = (ii); \
    _Pragma("unroll") for (int j_ = 0; j_ < 16; ++j_) { const bool gt_ = v_ > tv[j_]; const float nv_ = gt_ ? tv[j_] : v_; const int ni_ = gt_ ? ti[j_] : i_; \
        tv[j_] = gt_ ? v_ : tv[j_]; ti[j_] = gt_ ? i_ : ti[j_]; v_ = nv_; i_ = ni_; } } while (0)
__device__ __forceinline__ void peer_score_naive(unsigned char* ws, int layer) {
    const int tid = tid_();
    const bf16_t* SK = (const bf16_t*)(ws + WS_SKEY) + (size_t)layer * 8 * 2 * 128 * 128;
    for (int u = bid_(); u < 256; u += gridDim.x) {
        const int h = u >> 5, t = (u & 31) * 512 + tid;
        const bf16_t* qp = (const bf16_t*)(ws + WS_QP) + (size_t)t * 2048 + h * 256;
        float sv[2][16]; int si[2][16];
#pragma unroll
        for (int p = 0; p < 2; ++p) {
#pragma unroll
            for (int j = 0; j < 16; ++j) { sv[p][j] = -INFINITY; si[p][j] = 0; }
            const bf16_t* kp = SK + (size_t)(h * 2 + p) * 128 * 128;
            for (int n = 0; n < 128; ++n) {
                const float s = dot_rows<16>(kp + (size_t)n * 128, qp + p * 128);
                TOPK_INSERT(sv[p], si[p], s, n);
            }
        }
        float bv[16]; int bi[16];
#pragma unroll
        for (int j = 0; j < 16; ++j) { bv[j] = -INFINITY; bi[j] = 0; }
#pragma unroll
        for (int a = 0; a < 16; ++a)
#pragma unroll
            for (int b = 0; b < 16; ++b) { TOPK_INSERT(bv, bi, sv[0][a] + sv[1][b], si[0][a] * 128 + si[1][b]); }
        float sum = 0.f; const float bmax = bv[0];
#pragma unroll
        for (int j = 0; j < 16; ++j) { bv[j] = __expf(bv[j] - bmax); sum += bv[j]; }
        const float inv = 1.0f / sum;
        int* eo = (int*)(ws + WS_EIDX) + (size_t)t * 128 + h * 16; float* go = (float*)(ws + WS_EGATE) + (size_t)t * 128 + h * 16;
#pragma unroll
        for (int j = 0; j < 16; ++j) { eo[(j & 7) * 16 + (j >> 3) - 14 * h] = bi[j]; go[(j & 7) * 16 + (j >> 3) - 14 * h] = bv[j] * inv; }
    }
}


__device__ __forceinline__ int fkey(float f) { const int i = __builtin_bit_cast(int, f); return i ^ ((i >> 31) & 0x7fffffff); }
__device__ __forceinline__ float keyf(int k) { const int i = k ^ ((k >> 31) & 0x7fffffff); return __builtin_bit_cast(float, i); }
#define KINS(t, x) do { int x_ = (x); _Pragma("unroll") for (int j_ = 0; j_ < 16; ++j_) { const int hi_ = max(t[j_], x_); x_ = min(t[j_], x_); t[j_] = hi_; } } while (0)
#define KCE(a, b) do { const int hi_ = max(a, b), lo_ = min(a, b); a = hi_; b = lo_; } while (0)
#define KC(i, j) KCE(a[i], a[j])
__device__ __forceinline__ void sort16_desc(int (&a)[16]) {
    KC(0, 13); KC(1, 12); KC(2, 15); KC(3, 14); KC(4, 8); KC(5, 6); KC(7, 11); KC(9, 10);
    KC(0, 5); KC(1, 7); KC(2, 9); KC(3, 4); KC(6, 13); KC(8, 14); KC(10, 15); KC(11, 12);
    KC(0, 1); KC(2, 3); KC(4, 5); KC(6, 8); KC(7, 9); KC(10, 11); KC(12, 13); KC(14, 15);
    KC(0, 2); KC(1, 3); KC(4, 10); KC(5, 11); KC(6, 7); KC(8, 9); KC(12, 14); KC(13, 15);
    KC(1, 2); KC(3, 12); KC(4, 6); KC(5, 7); KC(8, 10); KC(9, 11); KC(13, 14);
    KC(1, 4); KC(2, 6); KC(5, 8); KC(7, 10); KC(9, 13); KC(11, 14);
    KC(2, 4); KC(3, 6); KC(9, 12); KC(11, 13);
    KC(3, 5); KC(6, 8); KC(7, 9); KC(10, 12);
    KC(3, 4); KC(5, 6); KC(7, 8); KC(9, 10); KC(11, 12);
    KC(6, 7); KC(8, 9);
}
#undef KC
__device__ __forceinline__ void merge16_desc(int (&a)[16], const int (&b)[16]) {
#pragma unroll
    for (int i = 0; i < 16; ++i) a[i] = max(a[i], b[15 - i]);
#pragma unroll
    for (int j = 8; j > 0; j >>= 1)
#pragma unroll
        for (int i = 0; i < 16; ++i) { const int l = i ^ j; if (l > i) KCE(a[i], a[l]); }
}
constexpr int PS_UNITS = 512;
__device__ __forceinline__ void peer_score_mfma(unsigned char* ws, int layer, LAS unsigned char* lds) {
    const int tid = tid_(), lane = tid & 63, wave = __builtin_amdgcn_readfirstlane(tid >> 6), r32 = lane & 31, hh = lane >> 5;
    const bf16_t* SKg = (const bf16_t*)(ws + WS_SKEY) + (size_t)layer * 8 * 2 * 128 * 128;
    LAS unsigned char* slot = lds + 65536 + tid * 36;
    for (int u0 = 2 * bid_(); u0 < PS_UNITS; u0 += 2 * gridDim.x) {
        const int h = u0 >> 6;
#define PS_QROW(u_) ((const bf16_t*)(ws + WS_QP) + ((size_t)((((u_) & 63) * 256 + 32 * wave) >> 5) * 8 + h) * (2 * 8 * 2 * 32 * 8) + (size_t)(hh * 32 + r32) * 8)
        bf16x8 qf[8];
        { const bf16_t* q0_ = PS_QROW(u0);
#pragma unroll
          for (int k = 0; k < 8; ++k) qf[k] = *(const bf16x8*)(q0_ + k * (2 * 32 * 8)); }
#pragma unroll
        for (int i = 0; i < 8; ++i) {
            const int x = tid + 512 * i, pp = x >> 11, n = (x >> 4) & 127, c = x & 15;
            const u32x4 v = *(const u32x4*)(SKg + ((size_t)(h * 2 + pp) * 128 + n) * 128 + 8 * c);
            *(LAS u32x4*)(lds + pp * 32768 + c * 2048 + n * 16) = v;
        }
        __syncthreads();
      for (int rep = 0; rep < 2; ++rep) {
        const int u = u0 + rep, tok0 = (u & 63) * 256 + 32 * wave;
        const bf16_t* qrow = PS_QROW(u);
        const bf16_t* qnext = PS_QROW(u0 + 1);
        int fin0[16], fin1[16];
#pragma unroll
        for (int pp = 0; pp < 2; ++pp) {
            const LAS unsigned char* kp = lds + pp * 32768 + hh * 2048 + r32 * 16;
            int top[16];
#pragma unroll
            for (int half = 0; half < 2; ++half) {
                int ga[16], gb[16];
#pragma unroll
                for (int q = 0; q < 2; ++q) {
                    const int nb = 2 * half + q;
                    f32x16 acc;
#pragma unroll
                    for (int r = 0; r < 16; ++r) acc[r] = 0.f;
#pragma unroll
                    for (int k = 0; k < 8; ++k) { const bf16x8 a = *(const LAS bf16x8*)(kp + k * 4096 + nb * 512); acc = MFMA32(a, qf[k], acc); }
                    if (nb == 3) { const bf16_t* qn_ = (pp == 0) ? qrow + (8 * 2 * 32 * 8) : qnext;
#pragma unroll
                        for (int k = 0; k < 8; ++k) qf[k] = *(const bf16x8*)(qn_ + k * (2 * 32 * 8));
                    }
#pragma unroll
                    for (int r = 0; r < 16; ++r) { const int n = 32 * nb + crow(r, 0) + 4 * hh; const int key = (fkey(acc[r]) & ~127) | n; if (q == 0) ga[r] = key; else gb[r] = key; }
                }
                sort16_desc(ga); sort16_desc(gb); merge16_desc(ga, gb);
                if (half == 0) {
#pragma unroll
                    for (int j = 0; j < 16; ++j) top[j] = ga[j];
                } else merge16_desc(top, ga);
            }
            int oth[16];
#pragma unroll
            for (int j = 0; j < 16; ++j) { unsigned a_ = (unsigned)top[j], b_ = a_; asm volatile("" : "+v"(b_)); const auto r_ = __builtin_amdgcn_permlane32_swap(a_, b_, false, false); top[j] = (int)r_[0]; oth[j] = (int)r_[1]; }
            merge16_desc(top, oth);
#pragma unroll
            for (int j = 0; j < 16; ++j) { if (pp == 0) fin0[j] = top[j]; else fin1[j] = top[j]; }
        }
#pragma unroll
        for (int q = 0; q < 4; ++q) {
            *(LAS unsigned*)(slot + 4 * q) = (unsigned)(fin0[4 * q] & 127) | ((unsigned)(fin0[4 * q + 1] & 127) << 8) | ((unsigned)(fin0[4 * q + 2] & 127) << 16) | ((unsigned)(fin0[4 * q + 3] & 127) << 24);
            *(LAS unsigned*)(slot + 16 + 4 * q) = (unsigned)(fin1[4 * q] & 127) | ((unsigned)(fin1[4 * q + 1] & 127) << 8) | ((unsigned)(fin1[4 * q + 2] & 127) << 16) | ((unsigned)(fin1[4 * q + 3] & 127) << 24);
        }
        float v0[16], v1[16];
#pragma unroll
        for (int j = 0; j < 16; ++j) { v0[j] = keyf(fin0[j] & ~127); v1[j] = keyf(fin1[j] & ~127); }
#define CAND(a, b) ((fkey(v0[a] + v1[b]) & ~255) | ((a) * 16 + (b)))
        int best[16], c1[16], c2[16];
        best[0] = CAND(0, 0); best[1] = CAND(0, 1); best[2] = CAND(0, 2); best[3] = CAND(0, 3); best[4] = CAND(0, 4); best[5] = CAND(0, 5); best[6] = CAND(0, 6); best[7] = CAND(0, 7); best[8] = CAND(0, 8); best[9] = CAND(0, 9); best[10] = CAND(0, 10); best[11] = CAND(0, 11); best[12] = CAND(0, 12); best[13] = CAND(0, 13); best[14] = CAND(0, 14); best[15] = CAND(0, 15);
        c1[0] = CAND(1, 0); c1[1] = CAND(1, 1); c1[2] = CAND(1, 2); c1[3] = CAND(1, 3); c1[4] = CAND(1, 4); c1[5] = CAND(1, 5); c1[6] = CAND(1, 6); c1[7] = CAND(1, 7); c1[8] = CAND(2, 0); c1[9] = CAND(2, 1); c1[10] = CAND(2, 2); c1[11] = CAND(2, 3); c1[12] = CAND(2, 4); c1[13] = CAND(3, 0); c1[14] = CAND(3, 1); c1[15] = CAND(3, 2);
        c2[0] = CAND(3, 3); c2[1] = CAND(4, 0); c2[2] = CAND(4, 1); c2[3] = CAND(4, 2); c2[4] = CAND(5, 0); c2[5] = CAND(5, 1); c2[6] = CAND(6, 0); c2[7] = CAND(6, 1); c2[8] = CAND(7, 0); c2[9] = CAND(7, 1); c2[10] = CAND(8, 0); c2[11] = CAND(9, 0); c2[12] = CAND(10, 0); c2[13] = CAND(11, 0); c2[14] = CAND(12, 0); c2[15] = CAND(13, 0);
        sort16_desc(c1); sort16_desc(c2);
        merge16_desc(best, c1); merge16_desc(best, c2);
        KINS(best, CAND(14, 0)); KINS(best, CAND(15, 0));
#undef CAND
        float gv[16]; int eid[16];
        const float bmax = keyf(best[0] & ~255); float gsum = 0.f;
#pragma unroll
        for (int j = 0; j < 16; ++j) {
            const int ab = best[j] & 255;
            const int ia = *(const LAS unsigned char*)(slot + (ab >> 4)), ib = *(const LAS unsigned char*)(slot + 16 + (ab & 15));
            eid[j] = ia * 128 + ib;
            gv[j] = __expf(keyf(best[j] & ~255) - bmax); gsum += gv[j];
        }
        const float ginv = 1.0f / gsum;
        const size_t ob = (size_t)(tok0 + r32) * 128 + 2 * h;
        if (hh == 0) {
            int* eo = (int*)(ws + WS_EIDX) + ob;
#pragma unroll
            for (int g = 0; g < 8; ++g) *(u32x2*)(eo + g * 16) = (u32x2){(unsigned)eid[g], (unsigned)eid[g + 8]};
        } else {
            float* go = (float*)(ws + WS_EGATE) + ob;
#pragma unroll
            for (int g = 0; g < 8; ++g) *(f32x2*)(go + g * 16) = (f32x2){gv[g] * ginv, gv[g + 8] * ginv};
        }
      }
#undef PS_QROW
        __syncthreads();
    }
}

__device__ __forceinline__ void unpack16_fp8(const u32x4 w, float* d) {
    f32x2 t;
    t = __builtin_amdgcn_cvt_pk_f32_fp8((int)w.x, false); d[0] = t.x; d[1] = t.y; t = __builtin_amdgcn_cvt_pk_f32_fp8((int)w.x, true); d[2] = t.x; d[3] = t.y;
    t = __builtin_amdgcn_cvt_pk_f32_fp8((int)w.y, false); d[4] = t.x; d[5] = t.y; t = __builtin_amdgcn_cvt_pk_f32_fp8((int)w.y, true); d[6] = t.x; d[7] = t.y;
    t = __builtin_amdgcn_cvt_pk_f32_fp8((int)w.z, false); d[8] = t.x; d[9] = t.y; t = __builtin_amdgcn_cvt_pk_f32_fp8((int)w.z, true); d[10] = t.x; d[11] = t.y;
    t = __builtin_amdgcn_cvt_pk_f32_fp8((int)w.w, false); d[12] = t.x; d[13] = t.y; t = __builtin_amdgcn_cvt_pk_f32_fp8((int)w.w, true); d[14] = t.x; d[15] = t.y;
}
__device__ __forceinline__ void peer_gather(const Params& p, int layer, int dry = 0) {
    unsigned char* ws = launder(p.ws);
    const int tid = tid_(), lane = tid & 63, wave = tid >> 6;
    const int gw = bid_() * NWAVES + wave, NGW = gridDim.x * NWAVES;
    const unsigned char* EU = ws + WS_EU + (size_t)layer * 16384 * 1024; const unsigned char* EV = ws + WS_EV + (size_t)layer * 16384 * 1024;
    const float* gn = p.norm_ffn + layer * DM;
    const bool last = (layer == DEPTH - 1);
    for (int t = gw; t < NTOK; t += NGW) {
        float* xr = (float*)(ws + WS_XR) + (size_t)t * DM + 16 * lane;
        float x1[16], hh[16], acc[16];
#pragma unroll
        for (int i = 0; i < 4; ++i) { const f32x4 a = *(const f32x4*)(xr + 4 * i); x1[4 * i] = a.x; x1[4 * i + 1] = a.y; x1[4 * i + 2] = a.z; x1[4 * i + 3] = a.w; }
        const float rs = rstd2_of(ws, t);
#pragma unroll
        for (int i = 0; i < 4; ++i) { const f32x4 g = *(const f32x4*)(gn + 16 * lane + 4 * i); hh[4 * i] = x1[4 * i] * rs * g.x; hh[4 * i + 1] = x1[4 * i + 1] * rs * g.y; hh[4 * i + 2] = x1[4 * i + 2] * rs * g.z; hh[4 * i + 3] = x1[4 * i + 3] * rs * g.w; }
#pragma unroll
        for (int i = 0; i < 16; ++i) acc[i] = 0.f;
        const int* ei = (const int*)(ws + WS_EIDX) + (size_t)t * 128; const float* eg = (const float*)(ws + WS_EGATE) + (size_t)t * 128;
        for (int hd = 0; hd < 8; ++hd) {
            const int slot = (lane >> 2) & 15;
            const int e_l = ei[hd * 16 + slot]; const float g_l = eg[hd * 16 + slot];
            float part[16];
#pragma unroll
            for (int j = 0; j < 16; ++j) {
                const int e = __builtin_amdgcn_readlane(e_l, 4 * j);
                const u32x4 w0 = *(const u32x4*)(EU + (size_t)e * 1024 + 16 * lane);
                float f[16], s = 0.f;
                unpack16_fp8(w0, f);
#pragma unroll
                for (int i = 0; i < 16; ++i) s += hh[i] * f[i];
                part[j] = s;
            }
            float q8[8], q4[4], q2[2], q1;
            { const bool up = (lane & 32) != 0;
#pragma unroll
              for (int i = 0; i < 8; ++i) { const float mine = up ? part[i + 8] : part[i], theirs = up ? part[i] : part[i + 8]; q8[i] = mine + __shfl_xor(theirs, 32); } }
            { const bool up = (lane & 16) != 0;
#pragma unroll
              for (int i = 0; i < 4; ++i) { const float mine = up ? q8[i + 4] : q8[i], theirs = up ? q8[i] : q8[i + 4]; q4[i] = mine + __shfl_xor(theirs, 16); } }
            { const bool up = (lane & 8) != 0;
#pragma unroll
              for (int i = 0; i < 2; ++i) { const float mine = up ? q4[i + 2] : q4[i], theirs = up ? q4[i] : q4[i + 2]; q2[i] = mine + __shfl_xor(theirs, 8); } }
            { const bool up = (lane & 4) != 0; const float mine = up ? q2[1] : q2[0], theirs = up ? q2[0] : q2[1]; q1 = mine + __shfl_xor(theirs, 4); }
            q1 += __shfl_xor(q1, 2); q1 += __shfl_xor(q1, 1);
            q1 *= (1.0f / EU_SCALE);
            const float act = 0.5f * q1 * (1.0f + erff(q1 * 0.70710678118654752f));
            const float c_l = g_l * act;
#pragma unroll
            for (int j = 0; j < 16; ++j) {
                const int e = __builtin_amdgcn_readlane(e_l, 4 * j);
                const float c = __builtin_bit_cast(float, __builtin_amdgcn_readlane(__builtin_bit_cast(int, c_l), 4 * j));
                const u32x4 w0 = *(const u32x4*)(EV + (size_t)e * 1024 + 16 * lane);
                float f[16];
                unpack16_fp8(w0, f);
#pragma unroll
                for (int i = 0; i < 16; ++i) acc[i] += c * f[i];
            }
        }
        float s = 0.f;
#pragma unroll
        for (int i = 0; i < 16; ++i) { x1[i] += acc[i] * (1.0f / EV_SCALE); s += x1[i] * x1[i]; }
        s = wave_sum(s);
        if (dry) continue;
        if (!last) {
#pragma unroll
            for (int i = 0; i < 4; ++i) *(f32x4*)(xr + 4 * i) = (f32x4){x1[4 * i], x1[4 * i + 1], x1[4 * i + 2], x1[4 * i + 3]};
            bf16_t* xb = (bf16_t*)(ws + WS_XB) + (size_t)t * DM + 16 * lane;
            store8_bf16(xb, x1); store8_bf16(xb + 8, x1 + 8);
            if (lane == 0) ((float*)(ws + WS_SS1))[t] = s;
        } else {
            const float r = 1.0f / sqrtf(s * (1.0f / DM) + EPS);
            float* o = p.out + (size_t)t * DM + 16 * lane; const float* gf = p.norm_final + 16 * lane;
#pragma unroll
            for (int i = 0; i < 4; ++i) { const f32x4 g = *(const f32x4*)(gf + 4 * i); *(f32x4*)(o + 4 * i) = (f32x4){x1[4 * i] * r * g.x, x1[4 * i + 1] * r * g.y, x1[4 * i + 2] * r * g.z, x1[4 * i + 3] * r * g.w}; }
        }
    }
}


__device__ __forceinline__ float dot16_fp8(const u32x4 w, const float* h) {
    float f[16]; unpack16_fp8(w, f); float s = 0.f;
#pragma unroll
    for (int i = 0; i < 16; ++i) s += h[i] * f[i];
    return s;
}
__device__ __forceinline__ void gather_u(const Params& p, int layer) {
    unsigned char* ws = launder(p.ws);
    const int tid = tid_(), lane = tid & 63, wave = __builtin_amdgcn_readfirstlane(tid >> 6), sl = lane & 7, eg = lane >> 3;
    const unsigned char* EU = ws + WS_EU + (size_t)layer * 16384 * 1024;
    const unsigned sl16 = 16u * sl, eg64 = 64u * eg, pdo = (16u * eg + 2u * sl) * 2u;
    for (int unit = bid_(); unit < 256; unit += gridDim.x) {
        const int x = unit & 7, j = unit >> 3;
        unsigned char* pd = ws + WS_PD + (size_t)x * NTOK * 128 * 2;
        const int tb = 512 * j + 64 * wave;
        const unsigned char* eub = EU + (size_t)x * 16384 * 128;
        const unsigned char* eib = ws + WS_EIDX;
        const unsigned char* hqb = ws + WS_HQ + 128 * x;
        u32x4 wA[16], wB[16]; int idn[16]; u32x4 hqn; float hsn;
#define GU_IDS(dst, t_) do { const u32x4* ei_ = (const u32x4*)(eib + (size_t)(t_) * 512 + eg64); _Pragma("unroll") for (int i = 0; i < 4; ++i) { const u32x4 e4_ = ei_[i]; dst[4 * i] = (int)e4_.x; dst[4 * i + 1] = (int)e4_.y; dst[4 * i + 2] = (int)e4_.z; dst[4 * i + 3] = (int)e4_.w; } } while (0)
#define GU_PCS(wd, ids) do { _Pragma("unroll") for (int i = 0; i < 16; ++i) wd[i] = *(const u32x4*)(eub + (unsigned)(((unsigned)ids[i] << 7) + sl16)); } while (0)
#define GU_X(t_) do { hqn = *(const u32x4*)(hqb + (size_t)(t_) * DM + sl16); hsn = ((const float*)(ws + WS_HS))[(size_t)(t_) * 8 + x] * (1.0f / EU_SCALE); } while (0)
#define GU_TOKEN(W, WN, tt_) do { \
            const int t = tb + (tt_), tn = tb + ((tt_) + 1 < 64 ? (tt_) + 1 : 63), tnn = tb + ((tt_) + 2 < 64 ? (tt_) + 2 : 63); \
            const u32x4 hq = hqn; const float hs = hsn; \
            GU_PCS(WN, idn);                  \
            GU_IDS(idn, tnn); GU_X(tn); \
            int part[16]; \
              \
            _Pragma("unroll") for (int i = 0; i < 16; ++i) { const u32x4 wp = W[i]; int a_ = __builtin_amdgcn_sdot4((int)wp.x, (int)hq.x, 0, true); a_ = __builtin_amdgcn_sdot4((int)wp.y, (int)hq.y, a_, false); \
                a_ = __builtin_amdgcn_sdot4((int)wp.z, (int)hq.z, a_, false); part[i] = __builtin_amdgcn_sdot4((int)wp.w, (int)hq.w, a_, false); } \
            int q8[8], q4[4], q2[2]; \
            { const bool up = (lane & 4) != 0; _Pragma("unroll") for (int m = 0; m < 8; ++m) { const int mine = up ? part[m + 8] : part[m]; q8[m] = mine + dpp_xor4(part[m], part[m + 8]); } } \
            { const bool up = (lane & 2) != 0; _Pragma("unroll") for (int m = 0; m < 4; ++m) { const int s1 = q8[m] + dpp_xor2(q8[m]), s2 = q8[m + 4] + dpp_xor2(q8[m + 4]); q4[m] = up ? s2 : s1; } } \
            { const bool up = (lane & 1) != 0; _Pragma("unroll") for (int m = 0; m < 2; ++m) { const int s1 = q4[m] + dpp_xor1(q4[m]), s2 = q4[m + 2] + dpp_xor1(q4[m + 2]); q2[m] = up ? s2 : s1; } } \
              \
            *(h16x2*)(pd + (size_t)t * 256 + pdo) = (h16x2){(_Float16)((float)q2[0] * hs), (_Float16)((float)q2[1] * hs)}; } while (0)
        GU_IDS(idn, tb); GU_X(tb);
        GU_PCS(wA, idn);
        GU_IDS(idn, tb + 1);
        for (int tt = 0; tt < 64; tt += 2) { GU_TOKEN(wA, wB, tt); GU_TOKEN(wB, wA, tt + 1); }
#undef GU_TOKEN
#undef GU_IDS
#undef GU_PCS
#undef GU_X
    }
}
__device__ __forceinline__ void gather_act(const Params& p) {
    unsigned char* ws = launder(p.ws);
    const size_t g0 = (size_t)bid_() * NTHREADS + tid_(), gs = (size_t)gridDim.x * NTHREADS;
    const h16x4* pd = (const h16x4*)(ws + WS_PD); const f32x4* gt = (const f32x4*)(ws + WS_EGATE); unsigned* c8 = (unsigned*)(ws + WS_C); float* csv = (float*)(ws + WS_CS);
    constexpr size_t N4 = (size_t)NTOK * 128 / 4;
    for (size_t i = g0; i < N4; i += gs) {
        h16x4 ph[8];
#pragma unroll
        for (int x = 0; x < 8; ++x) ph[x] = pd[i + (size_t)x * N4];
        f32x4 a = {0.f, 0.f, 0.f, 0.f};
#pragma unroll
        for (int x = 0; x < 8; ++x) { a[0] += (float)ph[x][0]; a[1] += (float)ph[x][1]; a[2] += (float)ph[x][2]; a[3] += (float)ph[x][3]; }
        const f32x4 g = gt[i]; f32x4 r;
#pragma unroll
        for (int q = 0; q < 4; ++q) { const float v = a[q]; r[q] = g[q] * (0.5f * v * (1.0f + erff(v * 0.70710678118654752f))); }
        float cam = fmaxf(fmaxf(fabsf(r[0]), fabsf(r[1])), fmaxf(fabsf(r[2]), fabsf(r[3])));
        cam = fmaxf(cam, dpp_xor1f(cam)); cam = fmaxf(cam, dpp_xor2f(cam)); cam = fmaxf(cam, dpp_xor4f(cam)); cam = fmaxf(cam, dpp_xor8f(cam)); cam = max_xor16(cam);
        const float csc = cam > 0.f ? 127.0f / cam : 0.f;
        c8[i] = pk4_i8(r[0] * csc, r[1] * csc, r[2] * csc, r[3] * csc);
        if ((i & 31) == 0) csv[i >> 5] = cam * (1.0f / (127.0f * EV_SCALE));
    }
}
__device__ __forceinline__ void gather_v(const Params& p, int layer) {
    unsigned char* ws = launder(p.ws);
    const int tid = tid_(), lane = tid & 63, wave = __builtin_amdgcn_readfirstlane(tid >> 6), sl = lane & 7, eg = lane >> 3;
    const unsigned char* EV = ws + WS_EV + (size_t)layer * 16384 * 1024;
    const bool last = (layer == DEPTH - 1);
    const unsigned sl16 = 16u * sl, eg64 = 64u * eg, eg16 = 16u * eg, eg4 = 4u * eg, xbo = 32u * sl + 4u * eg;
    for (int unit = bid_(); unit < 256; unit += gridDim.x) {
        const int x = unit & 7, j = unit >> 3;
        const int tb = 512 * j + 64 * wave;
        const unsigned char* evb = EV + (size_t)x * 16384 * 128;
        const unsigned char* eib = ws + WS_EIDX; const unsigned char* cib = ws + WS_C; const unsigned char* csb = ws + WS_CS;
        unsigned char* xbb = ws + WS_XB + 256 * x;
        u32x4 wA[16], wB[16]; int idn[16]; u32x4 cA, cB; float sA, sB; unsigned x1n;
#define GV_IDS(dst, t_) do { const u32x4* ei_ = (const u32x4*)(eib + (size_t)(t_) * 512 + eg64); _Pragma("unroll") for (int i = 0; i < 4; ++i) { const u32x4 e4_ = ei_[i]; dst[4 * i] = (int)e4_.x; dst[4 * i + 1] = (int)e4_.y; dst[4 * i + 2] = (int)e4_.z; dst[4 * i + 3] = (int)e4_.w; } } while (0)
#define GV_PCS(wd, ids, lo) do { _Pragma("unroll") for (int i = (lo); i < (lo) + 8; ++i) wd[i] = *(const u32x4*)(evb + (unsigned)(((unsigned)ids[i] << 7) + sl16)); } while (0)
#define GV_CF(cd, sd, t_) do { cd = *(const u32x4*)(cib + (size_t)(t_) * 128 + eg16); sd = *(const float*)(csb + (size_t)(t_) * 4); } while (0)
#define GV_ACC(W, lo) do { _Pragma("unroll") for (int g_ = (lo) / 4; g_ < (lo) / 4 + 2; ++g_) { \
                const u32x4 r0 = W[4 * g_], r1 = W[4 * g_ + 1], r2 = W[4 * g_ + 2], r3 = W[4 * g_ + 3]; \
                _Pragma("unroll") for (int d_ = 0; d_ < 4; ++d_) { \
                    const unsigned lo01 = __builtin_amdgcn_perm(r1[d_], r0[d_], 0x05010400u), hi01 = __builtin_amdgcn_perm(r1[d_], r0[d_], 0x07030602u); \
                    const unsigned lo23 = __builtin_amdgcn_perm(r3[d_], r2[d_], 0x05010400u), hi23 = __builtin_amdgcn_perm(r3[d_], r2[d_], 0x07030602u); \
                      \
                    acc[4 * d_ + 0] = (g_ == 0) ? __builtin_amdgcn_sdot4((int)__builtin_amdgcn_perm(lo23, lo01, 0x05040100u), cq[g_], 0, true) : __builtin_amdgcn_sdot4((int)__builtin_amdgcn_perm(lo23, lo01, 0x05040100u), cq[g_], acc[4 * d_ + 0], false); \
                    acc[4 * d_ + 1] = (g_ == 0) ? __builtin_amdgcn_sdot4((int)__builtin_amdgcn_perm(lo23, lo01, 0x07060302u), cq[g_], 0, true) : __builtin_amdgcn_sdot4((int)__builtin_amdgcn_perm(lo23, lo01, 0x07060302u), cq[g_], acc[4 * d_ + 1], false); \
                    acc[4 * d_ + 2] = (g_ == 0) ? __builtin_amdgcn_sdot4((int)__builtin_amdgcn_perm(hi23, hi01, 0x05040100u), cq[g_], 0, true) : __builtin_amdgcn_sdot4((int)__builtin_amdgcn_perm(hi23, hi01, 0x05040100u), cq[g_], acc[4 * d_ + 2], false); \
                    acc[4 * d_ + 3] = (g_ == 0) ? __builtin_amdgcn_sdot4((int)__builtin_amdgcn_perm(hi23, hi01, 0x07060302u), cq[g_], 0, true) : __builtin_amdgcn_sdot4((int)__builtin_amdgcn_perm(hi23, hi01, 0x07060302u), cq[g_], acc[4 * d_ + 3], false); } } } while (0)
#define GV_TOKEN(W, C, S, WN, CN, SN, tt_) do { \
            const int t = tb + (tt_), tn = tb + ((tt_) + 1 < 64 ? (tt_) + 1 : 63), tnn = tb + ((tt_) + 2 < 64 ? (tt_) + 2 : 63); \
            const unsigned x1 = x1n; \
            GV_PCS(WN, idn, 0);               \
            const float cs = S; int cq[4]; cq[0] = (int)C.x; cq[1] = (int)C.y; cq[2] = (int)C.z; cq[3] = (int)C.w; \
            int acc[16]; \
            _Pragma("unroll") for (int q = 0; q < 16; ++q) acc[q] = 0; \
            GV_ACC(W, 0); \
            GV_PCS(WN, idn, 8);               \
            GV_CF(CN, SN, tn); GV_IDS(idn, tnn); \
            x1n = *(const unsigned*)(xbb + (size_t)tn * (DM * 2) + xbo); \
            GV_ACC(W, 8); \
            int q8[8], q4[4]; float q2[2]; \
              \
              \
            _Pragma("unroll") for (int m = 0; m < 8; ++m) { \
                const auto r_ = __builtin_amdgcn_permlane32_swap((unsigned)acc[m], (unsigned)acc[m + 8], false, false); q8[m] = (int)r_[0] + (int)r_[1]; } \
            _Pragma("unroll") for (int m = 0; m < 4; ++m) { \
                const auto r_ = __builtin_amdgcn_permlane16_swap((unsigned)q8[m], (unsigned)q8[m + 4], false, false); q4[m] = (int)r_[0] + (int)r_[1]; } \
            { const bool up = (lane & 8) != 0; _Pragma("unroll") for (int m = 0; m < 2; ++m) { const int s1 = q4[m] + dpp_xor8(q4[m]), s2 = q4[m + 2] + dpp_xor8(q4[m + 2]); q2[m] = (float)(up ? s2 : s1) * cs; } } \
              \
            const float y0 = bflo(x1) + q2[0], y1 = bfhi(x1) + q2[1]; \
            *(unsigned*)(xbb + (size_t)t * (DM * 2) + xbo) = pk2(y0, y1); \
            const float ssq = wave_sum(y0 * y0 + y1 * y1); \
            if (lane == 0) ((float*)(ws + WS_PSS))[(size_t)t * 8 + x] = ssq; } while (0)
        GV_IDS(idn, tb);
        x1n = *(const unsigned*)(xbb + (size_t)tb * (DM * 2) + xbo);
        GV_PCS(wA, idn, 0); GV_PCS(wA, idn, 8); GV_CF(cA, sA, tb);
        GV_IDS(idn, tb + 1);
        for (int tt = 0; tt < 64; tt += 2) { GV_TOKEN(wA, cA, sA, wB, cB, sB, tt); GV_TOKEN(wB, cB, sB, wA, cA, sA, tt + 1); }
#undef GV_TOKEN
#undef GV_ACC
#undef GV_CF
#undef GV_IDS
#undef GV_PCS
    }
}
__device__ __forceinline__ void final_norm(const Params& p) {
    unsigned char* ws = launder(p.ws);
    const int tid = tid_(), lane = tid & 63, wave = tid >> 6;
    const int gw = bid_() * NWAVES + wave, NGW = gridDim.x * NWAVES;
    for (int m = gw; m < NTOK; m += NGW) {
        const f32x4 sa = *(const f32x4*)((const float*)(ws + WS_PSS) + (size_t)m * 8), sb = *(const f32x4*)((const float*)(ws + WS_PSS) + (size_t)m * 8 + 4);
        const float r = 1.0f / sqrtf((((sa.x + sa.y) + (sa.z + sa.w)) + ((sb.x + sb.y) + (sb.z + sb.w))) * (1.0f / DM) + EPS);
        const u32x2* xr = (const u32x2*)((const bf16_t*)(ws + WS_XB) + (size_t)m * DM) + lane; const f32x4* gf = (const f32x4*)p.norm_final + lane;
        f32x4* o = (f32x4*)(p.out + (size_t)m * DM) + lane;
#pragma unroll
        for (int q = 0; q < 4; ++q) { const u32x2 w = xr[64 * q]; const f32x4 g = gf[64 * q]; o[64 * q] = (f32x4){bflo(w.x) * r * g.x, bfhi(w.x) * r * g.y, bflo(w.y) * r * g.z, bfhi(w.y) * r * g.w}; }
    }
}

namespace pg8 {
#define PG8_LAS __attribute__((address_space(3)))
constexpr int BM = 256, BK = 64, HALF = 128, HTB = HALF * BK * 2, STAGE_BYTES = 8 * HTB, NXCD = 8, WGM = 8;
__host__ __device__ __forceinline__ int lds_byte(int r, int c) { const int st = (r >> 4) * 2 + (c >> 5), rr = r & 15, cc = c & 31, ob = rr * 64 + cc * 2; return st * 1024 + (ob ^ (((ob >> 9) & 1) << 5)); }
__host__ __device__ __forceinline__ void stage_rc(int b, int& R, int& C) { const int st = b / 1024, sb = b % 1024, swz = sb ^ (((sb >> 9) & 1) << 5); R = (st >> 1) * 16 + swz / 64; C = (st & 1) * 32 + (swz % 64) / 2; }
__host__ __device__ __forceinline__ int perm32(int rho) { const int n = rho >> 4, i = rho & 15; return 8 * (i >> 2) + 4 * n + (i & 3); }
struct Unit { int pm, pn, idx; };
typedef ::Gemm Gemm;
struct StaticOrder {
    int nM, nN, nwg, G, c;
    __host__ __device__ void init(int M, int N, int G_, int c_) { nM = M / BM; nN = N / BM; nwg = nM * nN; G = G_; c = c_; }
    __host__ __device__ bool next(int i, Unit& u) const {
        const long L = (long)i * G + c; if (L >= nwg) return false;
        int wgid = (int)L; { const int q = nwg / NXCD, r = nwg % NXCD, xcd = wgid % NXCD, off = wgid / NXCD; wgid = (xcd < r ? xcd * (q + 1) : r * (q + 1) + (xcd - r) * q) + off; }
        const int nig = WGM * nN, gid = wgid / nig, fm = gid * WGM, gsz = (nM - fm) < WGM ? (nM - fm) : WGM;
        u.pm = fm + ((wgid % nig) % gsz); u.pn = (wgid % nig) / gsz; u.idx = i; return true;
    }
    __device__ __forceinline__ void a_ready(const Unit&) const {}
    __device__ __forceinline__ void done(const Unit&) const {}
};
constexpr int RS_TAB_OFF = 131072 + 1024, RS_MAX_UNITS = 8;
template <class Epi> struct EpiAdapt {
    static constexpr bool PERM = true, AFTER_DRAIN = false;
    const Epi& e; PG8_LAS unsigned char* lds0;
    __device__ __forceinline__ void operator()(const f32x4 (&acc)[2][2][4][2], const Unit& u, int wr, int wc, int fr, int fq) const {
        const PG8_LAS float* rst = (const PG8_LAS float*)(lds0 + RS_TAB_OFF) + (u.idx & (RS_MAX_UNITS - 1)) * 256;
        const bool resid = (e.kind == 3);
        u32x4 rcur[2], rnxt[2];
        const int col0 = u.pn * BM + wc * 32 + 8 * fq;
#define EA_LOADRES(dst, g_) do { const GAS bf16_t* rr_ = (const GAS bf16_t*)e.aux + (size_t)(u.pm * BM + ((g_) >> 2) * HALF + wr * 64 + ((g_) & 3) * 16 + fr) * DM + col0; \
            dst[0] = *(const GAS u32x4*)rr_; dst[1] = *(const GAS u32x4*)(rr_ + HALF); } while (0)
        if (resid) EA_LOADRES(rcur, 0);
#pragma unroll
        for (int g = 0; g < 8; ++g) {
            const int ai = g >> 2, m = g & 3;
            const int rl = ai * HALF + wr * 64 + m * 16 + fr, row = u.pm * BM + rl;
            if (resid && g < 7) EA_LOADRES(rnxt, g + 1);
            const float rs = rst[rl];
            float v[2][8];
#pragma unroll
            for (int bj = 0; bj < 2; ++bj) { const f32x4 a = acc[ai][bj][m][0], b = acc[ai][bj][m][1]; v[bj][0] = a[0]; v[bj][1] = a[1]; v[bj][2] = a[2]; v[bj][3] = a[3]; v[bj][4] = b[0]; v[bj][5] = b[1]; v[bj][6] = b[2]; v[bj][7] = b[3]; }
            if (resid) {
#pragma unroll
                for (int bj = 0; bj < 2; ++bj) { float r8[8]; unpack8(rcur[bj], r8);
#pragma unroll
                    for (int e_ = 0; e_ < 8; ++e_) v[bj][e_] += r8[e_]; }
            }
            e.row16(row, u.pn, wc, fq, v, rs);
            asm volatile("" ::: "memory");
            if (resid && g < 7) { rcur[0] = rnxt[0]; rcur[1] = rnxt[1]; }
        }
#undef EA_LOADRES
    }
};
template <class Epi, class Sched, bool ALIGN_EPI = false, bool SP2 = false>
__device__ __forceinline__ void gemm_phase(PG8_LAS unsigned char* lds, const Gemm g, const Sched& S, const Epi& E) {
    const int tid = tid_(), wid = __builtin_amdgcn_readfirstlane(tid >> 6), lane = tid & 63, wr = wid >> 2, wc = wid & 3, fr = lane & 15, fq = lane >> 4;
    const int K = g.K, nt = K / BK; const int lda = g.lda, ldb = g.ldb;
    unsigned voffA[2], voffB[2];
#pragma unroll
    for (int i = 0; i < 2; ++i) { int R, C; stage_rc(tid * 16 + i * 8192, R, C); const int Rb = Epi::PERM ? ((R & ~31) + perm32(R & 31)) : R;
        voffA[i] = (unsigned)(R * lda + C) * 2u; voffB[i] = (unsigned)(Rb * ldb + C) * 2u; }
    const size_t kstep = (size_t)(BK * 2);
    const size_t hstepA = (size_t)HALF * lda * 2, hstepB = (size_t)HALF * ldb * 2;
    const size_t tstepA = 2 * hstepA, tstepB = 2 * hstepB;
    const unsigned ldsw = (unsigned)wid * 1024u;
    const int aoff = lds_byte(wr * 64 + fr, fq * 8), boff = lds_byte(wc * 32 + fr, fq * 8);
#define PG8_SA(b, h) (((b) * 2 + (h)) * HTB)
#define PG8_SB(b, h) ((4 + (b) * 2 + (h)) * HTB)
#define PG8_STAGE(bufoff, gbase, voff) do { _Pragma("unroll") for (int _i = 0; _i < 2; ++_i) \
        __builtin_amdgcn_global_load_lds((const unsigned*)((const char*)(gbase) + (voff)[_i]), (PG8_LAS unsigned*)(lds + (bufoff) + ldsw + _i * 8192), 16, 0, 0); } while (0)
#define PG8_LDA(dst, b, h) do { _Pragma("unroll") for (int m = 0; m < 4; ++m) _Pragma("unroll") for (int k = 0; k < 2; ++k) dst[m][k] = *(const PG8_LAS bf16x8*)(lds + PG8_SA(b, h) + aoff + m * 2048 + k * 1024); } while (0)
#define PG8_LDB(dst, b, h) do { _Pragma("unroll") for (int n = 0; n < 2; ++n) _Pragma("unroll") for (int k = 0; k < 2; ++k) dst[n][k] = *(const PG8_LAS bf16x8*)(lds + PG8_SB(b, h) + boff + n * 2048 + k * 1024); } while (0)
#define PG8_MMA(ai, bj, At, Bt) do { __builtin_amdgcn_s_setprio(1); _Pragma("unroll") for (int m = 0; m < 4; ++m) _Pragma("unroll") for (int n = 0; n < 2; ++n) _Pragma("unroll") for (int k = 0; k < 2; ++k) \
        acc[ai][bj][m][n] = __builtin_amdgcn_mfma_f32_16x16x32_bf16(Bt[n][k], At[m][k], acc[ai][bj][m][n], 0, 0, 0); __builtin_amdgcn_s_setprio(0); } while (0)
#define PG8_WAIT_V(n) asm volatile("s_waitcnt vmcnt(" #n ")" ::: "memory")
#define PG8_WAIT_L(n) asm volatile("s_waitcnt lgkmcnt(" #n ")" ::: "memory")
#define PG8_BAR __builtin_amdgcn_s_barrier()
#define PG8_SCHED __builtin_amdgcn_sched_barrier(0)
    Unit cur, nxt; int ui = 0;
    if (!S.next(0, cur)) return;
    float zero_ = 0.f; asm volatile("" : "+v"(zero_));
    f32x4 acc[2][2][4][2];
#pragma unroll
    for (int a = 0; a < 2; ++a)
#pragma unroll
        for (int b = 0; b < 2; ++b)
#pragma unroll
            for (int m = 0; m < 4; ++m)
#pragma unroll
                for (int n = 0; n < 2; ++n) acc[a][b][m][n] = (f32x4){zero_, zero_, zero_, zero_};
    bf16x8 At[4][2], B0[2][2], B1[2][2];
    const char* cA = (const char*)g.A + (size_t)cur.pm * tstepA; const char* cB = (const char*)g.Bt + (size_t)cur.pn * tstepB;
    S.a_ready(cur);
    if constexpr (SP2) {
        PG8_STAGE(PG8_SB(0, 0), cB, voffB); PG8_STAGE(PG8_SB(0, 1), cB + hstepB, voffB); PG8_STAGE(PG8_SA(0, 0), cA, voffA); PG8_STAGE(PG8_SA(0, 1), cA + hstepA, voffA);
        if (wr == 1) PG8_BAR;
        PG8_WAIT_V(2); PG8_BAR;
        PG8_STAGE(PG8_SB(1, 0), cB + kstep, voffB); PG8_STAGE(PG8_SA(1, 0), cA + kstep, voffA); PG8_STAGE(PG8_SB(1, 1), cB + hstepB + kstep, voffB);
        PG8_WAIT_V(6); PG8_BAR;
    } else {
        PG8_STAGE(PG8_SB(0, 0), cB, voffB); PG8_STAGE(PG8_SA(0, 0), cA, voffA); PG8_STAGE(PG8_SB(0, 1), cB + hstepB, voffB); PG8_STAGE(PG8_SA(0, 1), cA + hstepA, voffA);
        if (wr == 1) PG8_BAR;
        PG8_WAIT_V(4); PG8_BAR;
        PG8_STAGE(PG8_SB(1, 0), cB + kstep, voffB); PG8_STAGE(PG8_SA(1, 0), cA + kstep, voffA); PG8_STAGE(PG8_SB(1, 1), cB + hstepB + kstep, voffB);
        PG8_WAIT_V(6); PG8_BAR;
    }
    for (;;) {
        const bool has_next = S.next(ui + 1, nxt);
        const char* nA = has_next ? (const char*)g.A + (size_t)nxt.pm * tstepA : cA; const char* nB = has_next ? (const char*)g.Bt + (size_t)nxt.pn * tstepB : cB;
        for (int t = 0; t < nt; t += 2) {
            const bool last = (t == nt - 2);
            const char* a1 = cA + (size_t)(t + 1) * kstep;
            const char* a2 = last ? nA : cA + (size_t)(t + 2) * kstep; const char* b2 = last ? nB : cB + (size_t)(t + 2) * kstep;
            const char* a3 = a2 + kstep; const char* b3 = b2 + kstep;
            if (last && has_next) S.a_ready(nxt);
            if constexpr (SP2) {
            PG8_LDB(B0, 0, 0); PG8_LDB(B1, 0, 1); PG8_SCHED; PG8_LDA(At, 0, 0); PG8_STAGE(PG8_SA(1, 1), a1 + hstepA, voffA);
            PG8_WAIT_V(8); PG8_WAIT_L(0); PG8_BAR; PG8_MMA(0, 0, At, B0); PG8_MMA(0, 1, At, B1); PG8_BAR; PG8_SCHED;
            PG8_LDA(At, 0, 1); PG8_STAGE(PG8_SB(0, 0), b2, voffB); PG8_STAGE(PG8_SB(0, 1), b2 + hstepB, voffB); PG8_STAGE(PG8_SA(0, 0), a2, voffA);
            PG8_WAIT_V(8); PG8_WAIT_L(0); PG8_BAR; PG8_MMA(1, 0, At, B0); PG8_MMA(1, 1, At, B1); PG8_BAR; PG8_SCHED;
            PG8_LDB(B0, 1, 0); PG8_LDB(B1, 1, 1); PG8_SCHED; PG8_LDA(At, 1, 0); PG8_STAGE(PG8_SA(0, 1), a2 + hstepA, voffA);
            PG8_WAIT_V(8); PG8_WAIT_L(0); PG8_BAR; PG8_MMA(0, 0, At, B0); PG8_MMA(0, 1, At, B1); PG8_BAR; PG8_SCHED;
            PG8_LDA(At, 1, 1); PG8_STAGE(PG8_SB(1, 0), b3, voffB); PG8_STAGE(PG8_SB(1, 1), b3 + hstepB, voffB); PG8_STAGE(PG8_SA(1, 0), a3, voffA);
            PG8_WAIT_V(8); PG8_WAIT_L(0); PG8_BAR; PG8_MMA(1, 0, At, B0); PG8_MMA(1, 1, At, B1); PG8_BAR; PG8_SCHED;
            } else {
            PG8_LDB(B0, 0, 0); PG8_SCHED; PG8_LDA(At, 0, 0); PG8_STAGE(PG8_SA(1, 1), a1 + hstepA, voffA);
            PG8_WAIT_L(8); PG8_BAR; PG8_WAIT_L(0); PG8_MMA(0, 0, At, B0); PG8_BAR; PG8_SCHED;
            PG8_LDB(B1, 0, 1); PG8_STAGE(PG8_SB(0, 0), b2, voffB);
            PG8_BAR; PG8_WAIT_L(0); PG8_MMA(0, 1, At, B1); PG8_BAR;
            PG8_LDA(At, 0, 1); PG8_STAGE(PG8_SA(0, 0), a2, voffA);
            PG8_BAR; PG8_WAIT_L(0); PG8_MMA(1, 0, At, B0); PG8_BAR; PG8_SCHED;
            PG8_STAGE(PG8_SB(0, 1), b2 + hstepB, voffB);
            PG8_WAIT_V(6); PG8_BAR; PG8_MMA(1, 1, At, B1); PG8_BAR;
            PG8_LDB(B0, 1, 0); PG8_SCHED; PG8_LDA(At, 1, 0); PG8_STAGE(PG8_SA(0, 1), a2 + hstepA, voffA);
            PG8_WAIT_L(8); PG8_BAR; PG8_WAIT_L(0); PG8_MMA(0, 0, At, B0); PG8_BAR; PG8_SCHED;
            PG8_LDB(B1, 1, 1); PG8_STAGE(PG8_SB(1, 0), b3, voffB);
            PG8_BAR; PG8_WAIT_L(0); PG8_MMA(0, 1, At, B1); PG8_BAR;
            PG8_LDA(At, 1, 1); PG8_STAGE(PG8_SA(1, 0), a3, voffA);
            PG8_BAR; PG8_WAIT_L(0); PG8_MMA(1, 0, At, B0); PG8_BAR; PG8_SCHED;
            PG8_STAGE(PG8_SB(1, 1), b3 + hstepB, voffB);
            PG8_WAIT_V(6); PG8_BAR; PG8_MMA(1, 1, At, B1); PG8_BAR;
            }
        }
        if constexpr (ALIGN_EPI) { if (wr == 0) PG8_BAR; }
        if constexpr (!Epi::AFTER_DRAIN) { E(acc, cur, wr, wc, fr, fq); S.done(cur); }
        if (!has_next) break;
#pragma unroll
        for (int a = 0; a < 2; ++a)
#pragma unroll
            for (int b = 0; b < 2; ++b)
#pragma unroll
                for (int m = 0; m < 4; ++m)
#pragma unroll
                    for (int n = 0; n < 2; ++n) acc[a][b][m][n] = (f32x4){zero_, zero_, zero_, zero_};
        cur = nxt; cA = nA; cB = nB; ++ui;
        if constexpr (ALIGN_EPI) { if (wr == 1) PG8_BAR; }
    }
    PG8_WAIT_V(0);
    if constexpr (!ALIGN_EPI) { if (wr == 0) PG8_BAR; }
    PG8_BAR;
    if constexpr (Epi::AFTER_DRAIN) { E.fused(acc, cur, wr, wc, fr, fq, lds, wid, lane); S.done(cur); }
#undef PG8_SA
#undef PG8_SB
#undef PG8_STAGE
#undef PG8_LDA
#undef PG8_LDB
#undef PG8_MMA
#undef PG8_WAIT_V
#undef PG8_WAIT_L
#undef PG8_BAR
#undef PG8_SCHED
}
}

template <class Epi> __device__ __forceinline__ void run_gemm(LAS unsigned char* lds, const Gemm g, int c0, int G, const Epi& E) {
#if USE_MFMA_GEMM
    pg8::StaticOrder S; S.init(g.M, g.N, G, c0);
    {
        const int tid = tid_(); pg8::Unit u;
        if (tid < 256) { for (int i = 0; i < pg8::RS_MAX_UNITS && S.next(i, u); ++i) ((LAS float*)(lds + pg8::RS_TAB_OFF))[i * 256 + tid] = E.row_scale(u.pm * 256 + tid); }
        __syncthreads();
    }
    pg8::EpiAdapt<Epi> EA{E, lds};
    pg8::gemm_phase<pg8::EpiAdapt<Epi>, pg8::StaticOrder, true, true>(lds, g, S, EA);
#else
    gemm_naive<Epi>(g, c0, G, E);
#endif
}

__device__ __forceinline__ void hquant_rows(unsigned char* ws, const float* gain) {
    const int tid = tid_(), lane = tid & 63, wave = tid >> 6;
    const int gw = bid_() * NWAVES + wave, NGW = gridDim.x * NWAVES;
    f32x4 gv[4];
#pragma unroll
    for (int q = 0; q < 4; ++q) gv[q] = *(const GAS f32x4*)((const GAS float*)gain + 16 * lane + 4 * q);
    for (int m = gw; m < NTOK; m += NGW) {
        const u32x4* xr = (const u32x4*)((const bf16_t*)(ws + WS_XB) + (size_t)m * DM + 16 * lane);
        const float rs = rstd2_of(ws, m);
        float h[16]; float am = 0.f;
        { const u32x4 w0 = xr[0], w1 = xr[1]; unpack8(w0, h); unpack8(w1, h + 8); }
#pragma unroll
        for (int q = 0; q < 4; ++q) { const f32x4 g = gv[q]; h[4 * q] *= rs * g.x; h[4 * q + 1] *= rs * g.y; h[4 * q + 2] *= rs * g.z; h[4 * q + 3] *= rs * g.w; }
#pragma unroll
        for (int i = 0; i < 16; ++i) am = fmaxf(am, fabsf(h[i]));
        am = fmaxf(am, dpp_xor1f(am)); am = fmaxf(am, dpp_xor2f(am)); am = fmaxf(am, dpp_xor4f(am));
        const float sc = am > 0.f ? 127.0f / am : 0.f;
        u32x4 o; o.x = pk4_i8(h[0] * sc, h[1] * sc, h[2] * sc, h[3] * sc); o.y = pk4_i8(h[4] * sc, h[5] * sc, h[6] * sc, h[7] * sc); o.z = pk4_i8(h[8] * sc, h[9] * sc, h[10] * sc, h[11] * sc); o.w = pk4_i8(h[12] * sc, h[13] * sc, h[14] * sc, h[15] * sc);
        *(u32x4*)(ws + WS_HQ + (size_t)m * DM + 16 * lane) = o;
        if ((lane & 7) == 0) ((float*)(ws + WS_HS))[(size_t)m * 8 + (lane >> 3)] = am * (1.0f / 127.0f);
    }
}
__device__ __forceinline__ void gemm_phase_any(const Params& p, int sub, int layer, LAS unsigned char* lds) {
    unsigned char* ws = launder(p.ws);
    const int G = gridDim.x, bx = bid_();
    Gemm g; EpiAll E; E.ws = ws; E.aux = nullptr; int c0 = bx, Gs = G;
    g.M = NTOK;
    if (sub == 0) { g.A = (const bf16_t*)(ws + WS_XB); g.Bt = (const bf16_t*)(ws + WS_WIN) + (size_t)layer * DINP * DM; g.N = DINP; g.K = DM; E.kind = 0; E.aux = p.b_forget + layer * 4; }
    else if (sub == 1) {
        if (bx < 16) fcum_scan(ws, bx, tid_(), lds);
        const int G1 = G / 2; const bool first = bx < G1;
        g.A = first ? (const bf16_t*)(ws + WS_CQ) : (const bf16_t*)(ws + WS_CKV);
        g.Bt = first ? (const bf16_t*)(ws + WS_WUQ) + (size_t)layer * 512 * 256 : (const bf16_t*)(ws + WS_WUKV) + (size_t)layer * 512 * 128;
        g.N = 512; g.K = first ? 256 : 128; E.kind = first ? 1 : 2; c0 = first ? bx : bx - G1; Gs = first ? G1 : G - G1;
    }
    else if (sub == 3) { g.A = (const bf16_t*)(ws + WS_Y); g.Bt = (const bf16_t*)(ws + WS_WOUT) + (size_t)layer * DM * DM; g.N = DM; g.K = DM; E.kind = 3; E.aux = (const float*)(ws + WS_XB); }
    else { hquant_rows(ws, p.norm_ffn + layer * DM); g.A = (const bf16_t*)(ws + WS_XB); g.Bt = (const bf16_t*)(ws + WS_WQ) + (size_t)layer * 2048 * DM; g.N = 2048; g.K = DM; E.kind = 4; }
    g.lda = g.K; g.ldb = g.K;
    run_gemm(lds, g, c0, Gs, E);
    if (sub == 1) mixers_mfma<0>(p, ws, layer, lds);
}
template <int SUB>
__device__ __forceinline__ void run_phase(const Params& p, int layer, LAS unsigned char* lds) {
    unsigned char* ws = launder(p.ws);
    if constexpr (SUB == -1) { phase_prologue(p, lds); }
    else if constexpr (SUB == 0 || SUB == 1 || SUB == 3 || SUB == 4) { gemm_phase_any(p, SUB, layer, lds); }
    else if constexpr (SUB == 2) {
#if NAIVE_MIX || MIX_DEBUG
        mixers_naive(ws);
#else
        mixers_mfma<1>(p, ws, layer, lds);
#endif
    }
    else if constexpr (SUB == 17) { mixers_mfma<0>(p, ws, layer, lds); mixers_mfma<1>(p, ws, layer, lds); }
    else if constexpr (SUB == 5) {
#if NAIVE_SCORE
        peer_score_naive(ws, layer);
#else
        peer_score_mfma(ws, layer, lds);
#endif
    }
    else if constexpr (SUB == 6) { gather_u(p, layer); }
    else if constexpr (SUB == 7) { gather_act(p); }
    else if constexpr (SUB == 8) { gather_v(p, layer); }
    else if constexpr (SUB == 9) { final_norm(p); }
}
template <int SUB>
__global__ void __launch_bounds__(NTHREADS, 2) phase_kernel(Params p, int layer) {
    extern __shared__ __attribute__((aligned(16))) unsigned char lds_raw[];
    run_phase<SUB>(p, layer, (LAS unsigned char*)lds_raw);
}


typedef GAS unsigned gu32;
#define XB_TMO      128
#define XB_XCNT(j)  (256  + 64 * (j))
#define XB_XSUB(j)  (1280 + 64 * (j))
#define XB_XGEN(j)  (2304 + 64 * (j))
#define XB_TOP      3328
#define XB_TOPGEN   3392
#define XCD_BAR_WORDS 3456
#define XB_SPIN_CAP (1u << 18)

__device__ __forceinline__ unsigned xb_ld(unsigned* p)              { return __hip_atomic_load(p, __ATOMIC_RELAXED, __HIP_MEMORY_SCOPE_AGENT); }
__device__ __forceinline__ unsigned xb_add(unsigned* p, unsigned v) { return __hip_atomic_fetch_add(p, v, __ATOMIC_RELAXED, __HIP_MEMORY_SCOPE_AGENT); }
__device__ __forceinline__ unsigned xb_xcc_id() { return (unsigned)__builtin_amdgcn_s_getreg((3 << 11) | 20) & 0xFu; }
#define XB_SPIN(cond, bar) do { unsigned _sp = 0; while (cond) { __builtin_amdgcn_s_sleep(1); \
    if ((++_sp & 255u) == 0u) { if (xb_ld(&(bar)[XB_TMO])) break; if (_sp > XB_SPIN_CAP) { atomicAdd(&(bar)[XB_TMO], 1u); break; } } } } while (0)

struct XcdBarrier {
    unsigned* bar; unsigned x;
    volatile LAS unsigned* st;
};

__device__ __forceinline__ XcdBarrier xcd_barrier_post(unsigned* bar, volatile LAS unsigned* st) {
    XcdBarrier b; b.bar = bar; b.x = xb_xcc_id(); b.st = st;
    if (threadIdx.x == 0) (void)xb_add(&bar[XB_XCNT(b.x)], 1u);
    return b;
}
__device__ __forceinline__ void xcd_barrier_complete(unsigned* bar, unsigned x, unsigned& nloc, unsigned& nx) {
    const unsigned G = gridDim.x * gridDim.y * gridDim.z;
    unsigned sum, cnt, mine, sp = 0u;
    for (;;) {
        sum = 0u; cnt = 0u; mine = 0u;
#pragma unroll
        for (unsigned j = 0; j < 16; ++j) { const unsigned c = xb_ld(&bar[XB_XCNT(j)]); sum += c; cnt += (c > 0u) ? 1u : 0u; mine = (j == x) ? c : mine; }
        if (sum == G) break;
        __builtin_amdgcn_s_sleep(1);
        if ((++sp & 255u) == 0u) { if (xb_ld(&bar[XB_TMO])) break; if (sp > XB_SPIN_CAP) { atomicAdd(&bar[XB_TMO], 1u); break; } }
    }
    nloc = mine > 0u ? mine : 1u; nx = cnt > 0u ? cnt : 1u;
}

__device__ __forceinline__ void xcd_barrier(const XcdBarrier& b) {
    asm volatile("s_waitcnt vmcnt(0)" ::: "memory");
    __syncthreads();
    if (threadIdx.x == 0) {
        unsigned* bar = b.bar;
        __builtin_amdgcn_s_waitcnt(0);
        unsigned nloc = b.st[0], nx = b.st[1];
        if (nloc == 0u) { xcd_barrier_complete(bar, b.x, nloc, nx); b.st[0] = nloc; b.st[1] = nx; }
        const unsigned old = xb_add(&bar[XB_XSUB(b.x)], 1u);
        const unsigned gen = old / nloc;
        if (old + 1u == (gen + 1u) * nloc) {
            __builtin_amdgcn_fence(__ATOMIC_RELEASE, "agent");
            asm volatile("s_waitcnt vmcnt(0)" ::: "memory");
            const unsigned og = xb_add(&bar[XB_TOP], 1u);
            const unsigned tg = og / nx;
            if (og + 1u == (tg + 1u) * nx) xb_add(&bar[XB_TOPGEN], 1u);
            else XB_SPIN(xb_ld(&bar[XB_TOPGEN]) == tg, bar);
            __builtin_amdgcn_fence(__ATOMIC_ACQUIRE, "agent");
            xb_add(&bar[XB_XGEN(b.x)], 1u);
            asm volatile("s_waitcnt vmcnt(0)" ::: "memory");
        } else {
            XB_SPIN(xb_ld(&bar[XB_XGEN(b.x)]) == gen, bar);
            __builtin_amdgcn_fence(__ATOMIC_ACQUIRE, "agent");
            asm volatile("s_waitcnt vmcnt(0)" ::: "memory");
        }
    }
    __syncthreads();
}


template <int PH>
__device__ __forceinline__ void one_phase(const Params& p, LAS unsigned char* lds) {
#if defined(__HIP_DEVICE_COMPILE__)
    typedef const __attribute__((address_space(4))) Params* KP;
    KP kp = (KP)__builtin_amdgcn_kernarg_segment_ptr(); asm volatile("" : "+s"(kp));
    Params q;
    { const __attribute__((address_space(4))) unsigned long long* src = (const __attribute__((address_space(4))) unsigned long long*)kp; unsigned long long* dst = (unsigned long long*)&q;
#pragma unroll
      for (int i = 0; i < (int)(sizeof(Params) / 8); ++i) dst[i] = src[i]; }
#else
    const Params q = p;
#endif
    if (!(q.ph_lo <= PH && PH < q.ph_hi)) return;
    if constexpr (PH == 0) run_phase<-1>(q, 0, lds);
    else if constexpr (PH == NPH - 1) run_phase<9>(q, 0, lds);
    else {
        constexpr int layer = (PH - 1) / NSUB, sub = (PH - 1) % NSUB;
        if constexpr (sub == 0 || sub == 1 || sub == 3 || sub == 4) gemm_phase_any(q, sub, layer, lds);
        else if constexpr (sub == 2) { if (!NAIVE_MIX && !MIX_DEBUG) run_phase<2>(q, layer, lds); }
        else if constexpr (sub == 5) { if (!NAIVE_SCORE) run_phase<5>(q, layer, lds); }
        else if constexpr (sub == 6) run_phase<6>(q, layer, lds);
        else if constexpr (sub == 7) run_phase<7>(q, layer, lds);
        else run_phase<8>(q, layer, lds);
    }
    if (PH + 1 < q.ph_hi) { XcdBarrier xb; xb.bar = (unsigned*)(launder(q.ws) + WS_CTL) + CW_BAR; xb.x = xb_xcc_id(); xb.st = (volatile LAS unsigned*)(lds + 131072 + 320) + 8; xcd_barrier(xb); }
}
__global__ void __launch_bounds__(NTHREADS, 2) fwd_kernel(Params p) {
    extern __shared__ __attribute__((aligned(16))) unsigned char lds_raw[];
    LAS unsigned char* lds = (LAS unsigned char*)lds_raw;
    volatile LAS unsigned* misc = (volatile LAS unsigned*)(lds + 131072 + 320);
    if (threadIdx.x < 32) misc[threadIdx.x] = 0u;
    __syncthreads();
    (void)xcd_barrier_post((unsigned*)(p.ws + WS_CTL) + CW_BAR, misc + 8);
    one_phase<0>(p, lds); one_phase<1>(p, lds); one_phase<2>(p, lds); one_phase<3>(p, lds); one_phase<4>(p, lds);
    one_phase<5>(p, lds); one_phase<6>(p, lds); one_phase<7>(p, lds); one_phase<8>(p, lds); one_phase<9>(p, lds);
    one_phase<10>(p, lds); one_phase<11>(p, lds); one_phase<12>(p, lds); one_phase<13>(p, lds); one_phase<14>(p, lds);
    one_phase<15>(p, lds); one_phase<16>(p, lds); one_phase<17>(p, lds); one_phase<18>(p, lds); one_phase<19>(p, lds);
    static_assert(NPH == 20, "phase list above");
}

constexpr int LDS_BYTES = 147456;

template <int SUB> static void launch_phase(const Params& p, int layer, int grid, hipStream_t stream) {
    static bool attr = false;
    if (!attr) { (void)hipFuncSetAttribute((const void*)phase_kernel<SUB>, hipFuncAttributeMaxDynamicSharedMemorySize, LDS_BYTES); attr = true; }
    hipLaunchKernelGGL(phase_kernel<SUB>, dim3(grid), dim3(NTHREADS), LDS_BYTES, stream, p, layer);
}
extern "C" void kernel_launch(void* const* d_in, const int* in_sizes, int n_in, void* d_out, int out_size, void* d_ws, size_t ws_size, hipStream_t stream) {
    static int grid = 0;
    if (grid == 0) {
        if (n_in != 16 || out_size != NTOK * DM || ws_size < WS_END) { fprintf(stderr, "kernel_launch: unexpected sizes (n_in %d out %d ws %zu)\n", n_in, out_size, ws_size); grid = -1; return; }
        int dev = 0, cus = 0, per_cu = 0;
        (void)hipGetDevice(&dev); (void)hipDeviceGetAttribute(&cus, hipDeviceAttributeMultiprocessorCount, dev);
        (void)hipFuncSetAttribute((const void*)fwd_kernel, hipFuncAttributeMaxDynamicSharedMemorySize, LDS_BYTES);
        if (hipOccupancyMaxActiveBlocksPerMultiprocessor(&per_cu, (const void*)fwd_kernel, NTHREADS, LDS_BYTES) != hipSuccess || per_cu < 1) { fprintf(stderr, "kernel_launch: occupancy query reports %d blocks per CU for the fused kernel\n", per_cu); per_cu = 1; }
        (void)hipGetLastError();
        grid = (cus > 0 ? cus : 256) * (per_cu < 1 ? per_cu : 1);
    }
    if (grid < 0) return;
    (void)hipMemsetAsync((char*)d_ws + WS_CTL, 0, CTL_BYTES, stream);
    Params p{};
    p.x = (const float*)d_in[0]; p.norm_mix = (const float*)d_in[1]; p.w_in = (const float*)d_in[2]; p.b_forget = (const float*)d_in[3]; p.norm_cq = (const float*)d_in[4]; p.norm_ckv = (const float*)d_in[5];
    p.w_uq = (const float*)d_in[6]; p.w_ukv = (const float*)d_in[7]; p.head_gain = (const float*)d_in[8]; p.w_out = (const float*)d_in[9]; p.norm_ffn = (const float*)d_in[10]; p.w_query = (const float*)d_in[11];
    p.sub_keys = (const float*)d_in[12]; p.expert_u = (const float*)d_in[13]; p.expert_v = (const float*)d_in[14]; p.norm_final = (const float*)d_in[15];
    p.out = (float*)d_out; p.ws = (unsigned char*)d_ws;
    static bool attr = false;
    if (!attr) { (void)hipFuncSetAttribute((const void*)fwd_kernel, hipFuncAttributeMaxDynamicSharedMemorySize, LDS_BYTES); attr = true; }
    int ph = 0;
    while (ph < NPH) {
        const int sub = (ph == 0 || ph == NPH - 1) ? -1 : (ph - 1) % NSUB, layer = (ph == 0 || ph == NPH - 1) ? 0 : (ph - 1) / NSUB;
        if ((NAIVE_MIX || MIX_DEBUG) && sub == 2) { launch_phase<2>(p, layer, grid, stream); if (MIX_DEBUG) launch_phase<17>(p, layer, grid, stream); ++ph; continue; }
        if (NAIVE_SCORE && sub == 5) { launch_phase<5>(p, layer, grid, stream); ++ph; continue; }
        int hi = ph + 1;
        while (hi < NPH) { const int s2 = (hi == NPH - 1) ? -1 : (hi - 1) % NSUB; if (((NAIVE_MIX || MIX_DEBUG) && s2 == 2) || (NAIVE_SCORE && s2 == 5)) break; ++hi; }
        p.ph_lo = ph; p.ph_hi = hi;
        void* args[] = {&p};
        hipError_t e = hipLaunchCooperativeKernel((const void*)fwd_kernel, dim3(grid), dim3(NTHREADS), args, LDS_BYTES, stream);
        if (e != hipSuccess) fprintf(stderr, "cooperative launch failed: %s (grid %d, phases %d..%d)\n", hipGetErrorString(e), grid, ph, hi);
        ph = hi;
    }
}
```

```cpp
#include <hip/hip_runtime.h>
#include <hip/hip_cooperative_groups.h>
#include <cstdio>
#include <cstdint>
namespace cg = cooperative_groups;

#ifndef MK_N_LAUNCHES
#define MK_N_LAUNCHES 15
#endif
#ifndef NAIVE_MIX
#define NAIVE_MIX 0
#endif
#ifndef NAIVE_SCORE
#define NAIVE_SCORE 0
#endif
#ifndef MIX_KIND_MASK
#define MIX_KIND_MASK 15
#endif
#ifndef MIX_DEBUG
#define MIX_DEBUG 0
#endif
#ifndef REP_KMASK
#define REP_KMASK 15
#endif
#ifndef REP_SUB
#define REP_SUB -2
#endif
#ifndef FULL_UNROLL
#define FULL_UNROLL 1
#endif
#ifndef USE_CG_SYNC
#define USE_CG_SYNC 0
#endif
#ifndef USE_MFMA_GEMM
#define USE_MFMA_GEMM 1
#endif

#define LAS __attribute__((address_space(3)))
#define GAS __attribute__((address_space(1)))
typedef unsigned short bf16_t;
typedef short bf16x8 __attribute__((ext_vector_type(8)));
typedef float f32x4 __attribute__((ext_vector_type(4)));
typedef float f32x2 __attribute__((ext_vector_type(2)));
typedef unsigned u32x4 __attribute__((ext_vector_type(4)));
typedef unsigned u32x2 __attribute__((ext_vector_type(2)));

constexpr int NTOK = 16384, DM = 1024, SEQ = 4096, NBATCH = 4, DEPTH = 2;
constexpr int DIN = 2980, DINP = 3072;
constexpr int NSUB = 9;
constexpr int NPH = 1 + NSUB * DEPTH + 1;
constexpr float EPS = 1e-6f;
constexpr float LOG2E = 1.4426950408889634f;
constexpr float L2_10000 = 13.287712379549449f;
constexpr int NTHREADS = 512, NWAVES = 8;
constexpr float EU_SCALE = 512.0f, EV_SCALE = 64.0f;

constexpr size_t MiB = 1u << 20;
constexpr size_t WS_CTL = 0, CTL_BYTES = 1 * MiB;
constexpr size_t WS_WIN = 2 * MiB;
constexpr size_t WS_WUQ = 14 * MiB;
constexpr size_t WS_WUKV = 14 * MiB + 512 * 1024;
constexpr size_t WS_SKEY = 15 * MiB;
constexpr size_t WS_WOUT = 16 * MiB;
constexpr size_t WS_WQ = 20 * MiB;
constexpr size_t WS_EU = 32 * MiB;
constexpr size_t WS_EV = 96 * MiB;
constexpr size_t WS_XB = 160 * MiB;
constexpr size_t WS_XR = 192 * MiB;
constexpr size_t WS_Y = 256 * MiB;
constexpr size_t WS_SS1 = 288 * MiB;
constexpr size_t WS_PART2 = WS_SS1 + 64 * 1024;
constexpr size_t WS_PARTQ = WS_PART2 + 1 * MiB;
constexpr size_t WS_PARTKV = WS_PARTQ + 256 * 1024;
constexpr size_t WS_LOGF = WS_PARTKV + 256 * 1024;
constexpr size_t WS_FCUM = WS_LOGF + 256 * 1024;
constexpr size_t WS_ROPE64 = WS_FCUM + 256 * 1024;
constexpr size_t WS_ROPE32 = WS_ROPE64 + 1 * MiB;
constexpr size_t WS_EIDX = 292 * MiB;
constexpr size_t WS_EGATE = 300 * MiB;
constexpr size_t WS_ACT = 308 * MiB;
constexpr size_t WS_RQ = WS_ACT + 0 * MiB, WS_RK = WS_ACT + 8 * MiB, WS_RV = WS_ACT + 16 * MiB, WS_RG = WS_ACT + 24 * MiB;
constexpr size_t WS_FQ = WS_ACT + 32 * MiB, WS_FK = WS_ACT + 40 * MiB, WS_FV = WS_ACT + 48 * MiB;
constexpr size_t WS_SQ = WS_ACT + 56 * MiB, WS_SK = WS_ACT + 64 * MiB, WS_SV = WS_ACT + 72 * MiB;
constexpr size_t WS_CQ = WS_ACT + 80 * MiB;
constexpr size_t WS_CKV = WS_ACT + 88 * MiB;
constexpr size_t WS_QD = WS_ACT + 92 * MiB;
constexpr size_t WS_KD = WS_ACT + 104 * MiB;
constexpr size_t WS_VD = WS_ACT + 116 * MiB;
constexpr size_t WS_QP = WS_ACT;
constexpr size_t WS_HQ = WS_Y;
constexpr size_t WS_HS = WS_Y + 16 * MiB;
constexpr size_t WS_PD = WS_ACT;
constexpr size_t WS_C = WS_ACT + 64 * MiB;
constexpr size_t WS_CS = WS_C + 4 * MiB;
constexpr size_t WS_PSS = WS_ACT + 124 * MiB;
constexpr size_t WS_END = WS_ACT + 125 * MiB;

constexpr int CW_QUEUE = 64;
constexpr int CW_BAR = 4096;

__device__ __forceinline__ unsigned f2bf(float f) { unsigned u = __builtin_bit_cast(unsigned, f); return (u + 0x7fffu + ((u >> 16) & 1u)) >> 16; }
typedef float f32x2_t_ __attribute__((ext_vector_type(2))); typedef __bf16 bf16x2_t_ __attribute__((ext_vector_type(2)));
__device__ __forceinline__ unsigned pk2(float lo, float hi) { f32x2_t_ v = {lo, hi}; bf16x2_t_ b = __builtin_convertvector(v, bf16x2_t_); return __builtin_bit_cast(unsigned, b); }
__device__ __forceinline__ float bflo(unsigned w) { return __builtin_bit_cast(float, w << 16); }
__device__ __forceinline__ float bfhi(unsigned w) { return __builtin_bit_cast(float, w & 0xffff0000u); }
__device__ __forceinline__ void unpack8(const u32x4 w, float* d) { d[0] = bflo(w.x); d[1] = bfhi(w.x); d[2] = bflo(w.y); d[3] = bfhi(w.y); d[4] = bflo(w.z); d[5] = bfhi(w.z); d[6] = bflo(w.w); d[7] = bfhi(w.w); }
__device__ __forceinline__ float bf2f(bf16_t h) { return __builtin_bit_cast(float, (unsigned)h << 16); }
__device__ __forceinline__ int dpp_xor1(int v) { return __builtin_amdgcn_update_dpp(0, v, 0xB1, 0xf, 0xf, false); }
__device__ __forceinline__ int dpp_xor2(int v) { return __builtin_amdgcn_update_dpp(0, v, 0x4E, 0xf, 0xf, false); }
__device__ __forceinline__ int dpp_xor8(int v) { return __builtin_amdgcn_update_dpp(0, v, 0x128, 0xf, 0xf, false); }
__device__ __forceinline__ int dpp_xor4(int lo_src  , int hi_src  ) {
    const int t = __builtin_amdgcn_update_dpp(0, lo_src, 0x104, 0xf, 0x5, false);
    return __builtin_amdgcn_update_dpp(t, hi_src, 0x114, 0xf, 0xa, false);
}
__device__ __forceinline__ float dpp_xor8f(float v) { return __builtin_bit_cast(float, dpp_xor8(__builtin_bit_cast(int, v))); }
__device__ __forceinline__ float dpp_xor1f(float v) { return __builtin_bit_cast(float, dpp_xor1(__builtin_bit_cast(int, v))); }
__device__ __forceinline__ float dpp_xor2f(float v) { return __builtin_bit_cast(float, dpp_xor2(__builtin_bit_cast(int, v))); }
__device__ __forceinline__ float dpp_xor4f(float v) { const int i = __builtin_bit_cast(int, v); return __builtin_bit_cast(float, dpp_xor4(i, i)); }
__device__ __forceinline__ float add_xor16(float x) { unsigned a = __builtin_bit_cast(unsigned, x), b = a; asm volatile("" : "+v"(b)); const auto r = __builtin_amdgcn_permlane16_swap(a, b, false, false);
    return __builtin_bit_cast(float, (unsigned)r[0]) + __builtin_bit_cast(float, (unsigned)r[1]); }
__device__ __forceinline__ float add_xor32(float x) { unsigned a = __builtin_bit_cast(unsigned, x), b = a; asm volatile("" : "+v"(b)); const auto r = __builtin_amdgcn_permlane32_swap(a, b, false, false);
    return __builtin_bit_cast(float, (unsigned)r[0]) + __builtin_bit_cast(float, (unsigned)r[1]); }
__device__ __forceinline__ float max_xor16(float x) { unsigned a = __builtin_bit_cast(unsigned, x), b = a; asm volatile("" : "+v"(b)); const auto r = __builtin_amdgcn_permlane16_swap(a, b, false, false);
    return fmaxf(__builtin_bit_cast(float, (unsigned)r[0]), __builtin_bit_cast(float, (unsigned)r[1])); }
__device__ __forceinline__ float wave_sum(float v) {
    v += dpp_xor1f(v); v += dpp_xor2f(v); v += dpp_xor4f(v); v += dpp_xor8f(v);
    return add_xor32(add_xor16(v));
}
__device__ __forceinline__ float fast_exp2(float x) { return __builtin_amdgcn_exp2f(x); }
__device__ __forceinline__ float fast_log2(float x) { return __builtin_amdgcn_logf(x); }
__device__ __forceinline__ float fast_rcp(float x) { return __builtin_amdgcn_rcpf(x); }
__device__ __forceinline__ void sincos_rev(float ang, float& s, float& c) {
    double rv = (double)ang * 0.15915494309189535; rv -= __builtin_floor(rv); const float fr = (float)rv;
    s = __builtin_amdgcn_sinf(fr); c = __builtin_amdgcn_cosf(fr);
}

__device__ __forceinline__ int tid_() { int t = threadIdx.x; asm volatile("" : "+v"(t)); return t; }
__device__ __forceinline__ int bid_() { int b = blockIdx.x; asm volatile("" : "+s"(b)); return b; }
template <class P> __device__ __forceinline__ P* launder(P* q) { GAS P* g = (GAS P*)q; asm volatile("" : "+s"(g)); return (P*)g; }

struct Params {
    const float* x; const float* norm_mix; const float* w_in; const float* b_forget; const float* norm_cq; const float* norm_ckv;
    const float* w_uq; const float* w_ukv; const float* head_gain; const float* w_out; const float* norm_ffn; const float* w_query;
    const float* sub_keys; const float* expert_u; const float* expert_v; const float* norm_final;
    float* out; unsigned char* ws; int ph_lo, ph_hi;
};

__device__ __forceinline__ int colmap_win(int n) {
    const int tile = n >> 8, c = n & 255;
    switch (tile) {
        case 0: case 1: { const int head = c >> 6, j = c & 63, d = (j >> 1) + 32 * (j & 1); return tile * 256 + head * 64 + d; }
        case 2: return 512 + c;
        case 3: return 768 + c;
        case 4: return 1024 + c;
        case 5: return 1280 + c;
        case 6: return 1536 + c;
        case 7: return 1796 + c;
        case 8: return 2052 + c;
        case 9: return 2308 + c;
        case 10: return 2564 + c;
        default:
            if (c < 128) return 2820 + c;
            if (c < 160) { const int j = c - 128, d = (j >> 1) + 16 * (j & 1); return 2948 + d; }
            if (c < 164) return 1792 + (c - 160);
            return -1;
    }
}
__device__ __forceinline__ int colmap_wuq(int n) {
    if (n >= 384) return -1;
    const int head = n / 96, j = n % 96;
    if (j < 64) return head * 96 + j;
    const int jj = j - 64, d = (jj >> 1) + 16 * (jj & 1);
    return head * 96 + 64 + d;
}
template <int MAPK>
__device__ __forceinline__ void transpose_item(const float* W, int K, int Nold, int Nnew, bf16_t* WT, const float* kscale, LAS float* scr, int item, int lane) {
    const int nblk = Nnew / 32, kb = item / nblk, nb = item % nblk, k0 = 64 * kb, n0 = 32 * nb;
    const int nn = n0 + (lane & 31);
    const int old = (MAPK == 0) ? colmap_win(nn) : (MAPK == 1) ? colmap_wuq(nn) : nn;
    const int oldA = __builtin_amdgcn_readlane(old, 0);
    if (oldA >= 0 && __all(old == oldA + (lane & 31))) {
        f32x4 v[8];
#pragma unroll
        for (int i = 0; i < 8; ++i) v[i] = *(const f32x4*)(W + (size_t)(k0 + 8 * i + (lane >> 3)) * Nold + oldA + 4 * (lane & 7));
#pragma unroll
        for (int i = 0; i < 8; ++i) { const int kk = 8 * i + (lane >> 3); const float ks = kscale ? kscale[k0 + kk] : 1.0f; LAS float* d = scr + kk * 33 + 4 * (lane & 7);
            d[0] = v[i].x * ks; d[1] = v[i].y * ks; d[2] = v[i].z * ks; d[3] = v[i].w * ks; }
    } else {
#pragma unroll 8
        for (int i = 0; i < 32; ++i) {
            const int kk = 2 * i + (lane >> 5);
            float v = 0.f;
            if (old >= 0) { v = W[(size_t)(k0 + kk) * Nold + old]; if (kscale) v *= kscale[k0 + kk]; }
            scr[kk * 33 + (lane & 31)] = v;
        }
    }
    asm volatile("s_waitcnt lgkmcnt(0)" ::: "memory");
    const int c = lane & 7;
#pragma unroll
    for (int j = 0; j < 4; ++j) {
        const int n = (lane >> 3) + 8 * j; const LAS float* s = scr + (8 * c) * 33 + n;
        u32x4 o; o.x = pk2(s[0 * 33], s[1 * 33]); o.y = pk2(s[2 * 33], s[3 * 33]); o.z = pk2(s[4 * 33], s[5 * 33]); o.w = pk2(s[6 * 33], s[7 * 33]);
        *(u32x4*)(WT + (size_t)(n0 + n) * K + k0 + 8 * c) = o;
    }
    asm volatile("s_waitcnt lgkmcnt(0)" ::: "memory");
}
__device__ __forceinline__ void cvt_stream(const float* src, bf16_t* dst, size_t n8, size_t g0, size_t gstride) {
    for (size_t g = g0; g < n8; g += gstride) {
        const f32x4 a = *(const f32x4*)(src + g * 8), b = *(const f32x4*)(src + g * 8 + 4);
        u32x4 o; o.x = pk2(a.x, a.y); o.y = pk2(a.z, a.w); o.z = pk2(b.x, b.y); o.w = pk2(b.z, b.w);
        *(u32x4*)(dst + g * 8) = o;
    }
}
__device__ __forceinline__ unsigned pk4_fp8(float a, float b, float c, float d) { int w = 0; w = __builtin_amdgcn_cvt_pk_fp8_f32(a, b, w, false); w = __builtin_amdgcn_cvt_pk_fp8_f32(c, d, w, true); return (unsigned)w; }
__device__ __forceinline__ unsigned pk4_i8(float a, float b, float c, float d) {
    const float M = 12582912.0f;
    const unsigned ua = __builtin_bit_cast(unsigned, fminf(fmaxf(a, -127.f), 127.f) + M) & 255u, ub = __builtin_bit_cast(unsigned, fminf(fmaxf(b, -127.f), 127.f) + M) & 255u;
    const unsigned uc = __builtin_bit_cast(unsigned, fminf(fmaxf(c, -127.f), 127.f) + M) & 255u, ud = __builtin_bit_cast(unsigned, fminf(fmaxf(d, -127.f), 127.f) + M) & 255u;
    return ua | (ub << 8) | (uc << 16) | (ud << 24);
}
__device__ __forceinline__ void cvt_stream_fp8(const float* src, unsigned char* dst, size_t n16, size_t g0, size_t gstride, float sc, const float* colgain = nullptr) {
    for (size_t g = g0; g < n16; g += gstride) {
        f32x4 a = *(const f32x4*)(src + g * 16), b = *(const f32x4*)(src + g * 16 + 4), c = *(const f32x4*)(src + g * 16 + 8), d = *(const f32x4*)(src + g * 16 + 12);
        if (colgain) { const float* cg = colgain + ((g >> 20) * 1024 + (g & 63) * 16); a *= *(const f32x4*)cg; b *= *(const f32x4*)(cg + 4); c *= *(const f32x4*)(cg + 8); d *= *(const f32x4*)(cg + 12); }
        u32x4 o; o.x = pk4_fp8(a.x * sc, a.y * sc, a.z * sc, a.w * sc); o.y = pk4_fp8(b.x * sc, b.y * sc, b.z * sc, b.w * sc); o.z = pk4_fp8(c.x * sc, c.y * sc, c.z * sc, c.w * sc); o.w = pk4_fp8(d.x * sc, d.y * sc, d.z * sc, d.w * sc);
        const size_t row = g >> 6, c16 = g & 63, lay = row >> 14, e = row & 16383;
        *(u32x4*)(dst + (((lay * 8 + (c16 >> 3)) * 16384 + e) * 128 + (c16 & 7) * 16)) = o;
    }
}
__device__ __forceinline__ void experts_convert(const Params& p, unsigned char* ws, size_t g0, size_t gs) {
    cvt_stream_fp8(p.expert_u, ws + WS_EU, (size_t)DEPTH * 16384 * 1024 / 16, g0, gs, EU_SCALE, p.norm_ffn);
    cvt_stream_fp8(p.expert_v, ws + WS_EV, (size_t)DEPTH * 16384 * 1024 / 16, g0, gs, EV_SCALE);
}
__device__ __forceinline__ void phase_prologue(const Params& p, LAS unsigned char* lds) {
    const int tid = tid_(), lane = tid & 63, wave = tid >> 6;
    const int gw = bid_() * NWAVES + wave, NGW = gridDim.x * NWAVES;
    LAS float* scr = (LAS float*)(lds + wave * 16384);
    unsigned char* ws = launder(p.ws);
    constexpr int I_IN = (DM / 64) * (DINP / 32), I_UQ = (256 / 64) * (512 / 32), I_UKV = (128 / 64) * (512 / 32), I_OUT = (DM / 64) * (DM / 32), I_WQ = (DM / 64) * (2048 / 32);
    constexpr int I_L = I_IN + I_UQ + I_UKV + I_OUT + I_WQ;
    for (int it = gw; it < DEPTH * I_L; it += NGW) {
        const int l = it / I_L; int r = it % I_L;
        if (r < I_IN) { transpose_item<0>(p.w_in + (size_t)l * DM * DIN, DM, DIN, DINP, (bf16_t*)(ws + WS_WIN) + (size_t)l * DINP * DM, p.norm_mix + l * DM, scr, r, lane); continue; } r -= I_IN;
        if (r < I_UQ) { transpose_item<1>(p.w_uq + (size_t)l * 256 * 384, 256, 384, 512, (bf16_t*)(ws + WS_WUQ) + (size_t)l * 512 * 256, p.norm_cq + l * 256, scr, r, lane); continue; } r -= I_UQ;
        if (r < I_UKV) { transpose_item<2>(p.w_ukv + (size_t)l * 128 * 512, 128, 512, 512, (bf16_t*)(ws + WS_WUKV) + (size_t)l * 512 * 128, p.norm_ckv + l * 128, scr, r, lane); continue; } r -= I_UKV;
        if (r < I_OUT) { transpose_item<2>(p.w_out + (size_t)l * DM * DM, DM, DM, DM, (bf16_t*)(ws + WS_WOUT) + (size_t)l * DM * DM, p.head_gain + l * DM, scr, r, lane); continue; } r -= I_OUT;
        transpose_item<2>(p.w_query + (size_t)l * DM * 2048, DM, 2048, 2048, (bf16_t*)(ws + WS_WQ) + (size_t)l * 2048 * DM, p.norm_ffn + l * DM, scr, r, lane);
    }
    const size_t g0 = (size_t)bid_() * NTHREADS + tid, gs = (size_t)gridDim.x * NTHREADS;
    cvt_stream(p.sub_keys, (bf16_t*)(ws + WS_SKEY), (size_t)DEPTH * 8 * 2 * 128 * 128 / 8, g0, gs);
    float* pss = (float*)(ws + WS_PSS); bf16_t* xb = (bf16_t*)(ws + WS_XB);
    for (int m0 = gw * 4; m0 < NTOK; m0 += NGW * 4) {
        f32x4 v[4][4];
#pragma unroll
        for (int r = 0; r < 4; ++r) { const f32x4* xr = (const f32x4*)(p.x + (size_t)(m0 + r) * DM) + lane;
#pragma unroll
            for (int j = 0; j < 4; ++j) v[r][j] = xr[64 * j]; }
#pragma unroll
        for (int r = 0; r < 4; ++r) {
            float s = 0.f; u32x2* o8 = (u32x2*)(xb + (size_t)(m0 + r) * DM) + lane;
#pragma unroll
            for (int j = 0; j < 4; ++j) { const f32x4 w = v[r][j]; s += (w.x * w.x + w.y * w.y) + (w.z * w.z + w.w * w.w); u32x2 o; o.x = pk2(w.x, w.y); o.y = pk2(w.z, w.w); o8[64 * j] = o; }
            s = wave_sum(s);
            float z_ = 0.f; asm volatile("" : "+v"(z_));
            if (lane == 0) { *(f32x4*)(pss + (size_t)(m0 + r) * 8) = (f32x4){s, z_, z_, z_}; *(f32x4*)(pss + (size_t)(m0 + r) * 8 + 4) = (f32x4){z_, z_, z_, z_}; }
        }
    }
}

__device__ __forceinline__ void store8_bf16(bf16_t* dst, const float* v) {
    u32x4 o; o.x = pk2(v[0], v[1]); o.y = pk2(v[2], v[3]); o.z = pk2(v[4], v[5]); o.w = pk2(v[6], v[7]);
    *(u32x4*)dst = o;
}
__device__ __forceinline__ void rope8(float* v, const float* tab) {
    const f32x4 a = *(const f32x4*)tab, b = *(const f32x4*)(tab + 4);
    float t1, t2;
    t1 = v[0]; t2 = v[1]; v[0] = t1 * a.x - t2 * a.y; v[1] = t1 * a.y + t2 * a.x;
    t1 = v[2]; t2 = v[3]; v[2] = t1 * a.z - t2 * a.w; v[3] = t1 * a.w + t2 * a.z;
    t1 = v[4]; t2 = v[5]; v[4] = t1 * b.x - t2 * b.y; v[5] = t1 * b.y + t2 * b.x;
    t1 = v[6]; t2 = v[7]; v[6] = t1 * b.z - t2 * b.w; v[7] = t1 * b.w + t2 * b.z;
}

__device__ __forceinline__ void rope_angles(int pos, int i0, float l2step  , float (&cs)[4], float (&sn)[4]) {
    const float fp = (float)pos;
#pragma unroll
    for (int j = 0; j < 4; ++j) {
        const float fr = __builtin_amdgcn_fractf(fp * (fast_exp2(-(float)(i0 + j) * l2step) * 0.15915494309189535f));
        sn[j] = __builtin_amdgcn_sinf(fr); cs[j] = __builtin_amdgcn_cosf(fr);
    }
}
__device__ __forceinline__ void rope8r(float* v, const float (&cs)[4], const float (&sn)[4]) {
#pragma unroll
    for (int j = 0; j < 4; ++j) { const float t1 = v[2 * j], t2 = v[2 * j + 1]; v[2 * j] = t1 * cs[j] - t2 * sn[j]; v[2 * j + 1] = t1 * sn[j] + t2 * cs[j]; }
}

struct EpiInProj {
    unsigned char* ws; const float* b_forget;
    __device__ __forceinline__ void row16(int row, int pn, int wc, int fq, float (&v)[2][8], float rs) const {
        const int pos = row & (SEQ - 1);
#pragma unroll
        for (int bj = 0; bj < 2; ++bj)
#pragma unroll
            for (int e = 0; e < 8; ++e) v[bj][e] *= rs;
        const int cl0 = 32 * wc + 8 * fq;
        switch (pn) {
            case 0: case 1: {
                bf16_t* dst = (bf16_t*)(ws + (pn == 0 ? WS_RQ : WS_RK)) + (size_t)row * 256;
                float cs[4], sn[4]; rope_angles(pos, (cl0 & 63) >> 1, L2_10000 / 32.0f, cs, sn);
#pragma unroll
                for (int bj = 0; bj < 2; ++bj) { const int c = 128 * bj + cl0; rope8r(v[bj], cs, sn);
                    if (pn == 1) {
#pragma unroll
                        for (int e = 0; e < 8; ++e) v[bj][e] *= 0.125f; }
                    store8_bf16(dst + c, v[bj]); }
            } break;
            case 3: {
                bf16_t* dst = (bf16_t*)(ws + WS_RG) + (size_t)row * 256;
#pragma unroll
                for (int bj = 0; bj < 2; ++bj) {
#pragma unroll
                    for (int e = 0; e < 8; ++e) { const float g = v[bj][e]; v[bj][e] = g / (1.0f + __expf(-g)); }
                    store8_bf16(dst + 128 * bj + cl0, v[bj]); }
            } break;
            case 2: case 5: case 6: case 8: case 9: case 4: case 7: {
                const size_t off = pn == 2 ? WS_RV : pn == 4 ? WS_FQ : pn == 5 ? WS_FK : pn == 6 ? WS_FV : pn == 7 ? WS_SQ : pn == 8 ? WS_SK : WS_SV;
                const float sc = (pn == 4 || pn == 7) ? 0.125f * LOG2E : 1.0f;
                bf16_t* dst = (bf16_t*)(ws + off) + (size_t)row * 256;
#pragma unroll
                for (int bj = 0; bj < 2; ++bj) {
#pragma unroll
                    for (int e = 0; e < 8; ++e) v[bj][e] *= sc;
                    store8_bf16(dst + 128 * bj + cl0, v[bj]); }
            } break;
            case 10: {
                bf16_t* dst = (bf16_t*)(ws + WS_CQ) + (size_t)row * 256; float s = 0.f;
#pragma unroll
                for (int bj = 0; bj < 2; ++bj) {
#pragma unroll
                    for (int e = 0; e < 8; ++e) s += v[bj][e] * v[bj][e];
                    store8_bf16(dst + 128 * bj + cl0, v[bj]); }
                s = add_xor32(add_xor16(s));
                if (fq == 0) ((float*)(ws + WS_PARTQ))[row * 4 + wc] = s;
            } break;
            default: {
                float s = 0.f;
#pragma unroll
                for (int e = 0; e < 8; ++e) s += v[0][e] * v[0][e];
                store8_bf16((bf16_t*)(ws + WS_CKV) + (size_t)row * 128 + cl0, v[0]);
                s = add_xor32(add_xor16(s));
                if (fq == 0) ((float*)(ws + WS_PARTKV))[row * 4 + wc] = s;
                if (wc == 0) {
                    { float cs[4], sn[4]; rope_angles(pos, 4 * fq, L2_10000 / 16.0f, cs, sn); rope8r(v[1], cs, sn); }
                    bf16_t* kd = (bf16_t*)(ws + WS_KD) + (size_t)row * 384 + 64 + 8 * fq;
#pragma unroll
                    for (int h = 0; h < 4; ++h) store8_bf16(kd + 96 * h, v[1]);
                } else if (wc == 1 && fq == 0) {
                    f32x4 lf;
#pragma unroll
                    for (int h = 0; h < 4; ++h) { const float z = v[1][h] + ((const __attribute__((address_space(4))) float*)b_forget)[h]; lf[h] = fminf(z, 0.f) - log1pf(__expf(-fabsf(z))); }
                    *(f32x4*)((float*)(ws + WS_LOGF) + (size_t)row * 4) = lf;
                }
            } break;
        }
    }
};
struct EpiMla {
    unsigned char* ws; int which;
    __device__ __forceinline__ void row16(int row, int pn, int wc, int fq, float (&v)[2][8], float rs) const {
        if (which == 0) {
            const int pos = row & (SEQ - 1);
            bf16_t* dst = (bf16_t*)(ws + WS_QD) + (size_t)row * 384;
#pragma unroll
            for (int bj = 0; bj < 2; ++bj) {
                const int n = 256 * pn + 128 * bj + 32 * wc + 8 * fq;
                if (n < 384) {
                    const int j = n % 96;
                    if (j >= 64) { float cs[4], sn[4]; rope_angles(pos, (j - 64) >> 1, L2_10000 / 16.0f, cs, sn); rope8r(v[bj], cs, sn); }
#pragma unroll
                    for (int e = 0; e < 8; ++e) v[bj][e] *= rs;
                    store8_bf16(dst + n, v[bj]);
                }
            }
        } else {
#pragma unroll
            for (int bj = 0; bj < 2; ++bj) {
                const int head = 2 * pn + bj, j = 32 * wc + 8 * fq;
#pragma unroll
                for (int e = 0; e < 8; ++e) v[bj][e] *= rs;
                bf16_t* dst = (j < 64) ? (bf16_t*)(ws + WS_KD) + (size_t)row * 384 + head * 96 + j : (bf16_t*)(ws + WS_VD) + (size_t)row * 256 + head * 64 + (j - 64);
                store8_bf16(dst, v[bj]);
            }
        }
    }
};
struct EpiOutProj {
    unsigned char* ws; const float* resid;
    __device__ __forceinline__ void row16(int row, int pn, int wc, int fq, float (&v)[2][8]) const {
        bf16_t* xb = (bf16_t*)(ws + WS_XB) + (size_t)row * DM;
        float s = 0.f;
#pragma unroll
        for (int bj = 0; bj < 2; ++bj) {
            const int c = 256 * pn + 128 * bj + 32 * wc + 8 * fq;
#pragma unroll
            for (int e = 0; e < 8; ++e) s += v[bj][e] * v[bj][e];
            store8_bf16(xb + c, v[bj]);
        }
        s = add_xor32(add_xor16(s));
        if (fq == 0) ((float*)(ws + WS_PART2))[(size_t)row * 16 + pn * 4 + wc] = s;
    }
};
__device__ __forceinline__ float rstd2_of(const unsigned char* ws, int row) {
    const f32x4* pp = (const f32x4*)((const float*)(ws + WS_PART2) + (size_t)row * 16);
    const f32x4 a = pp[0], b = pp[1], c = pp[2], d = pp[3];
    const float s = (((a.x + a.y) + (a.z + a.w)) + ((b.x + b.y) + (b.z + b.w))) + (((c.x + c.y) + (c.z + c.w)) + ((d.x + d.y) + (d.z + d.w)));
    return 1.0f / sqrtf(s * (1.0f / DM) + EPS);
}
struct EpiQuery {
    unsigned char* ws;
    __device__ __forceinline__ void row16(int row, int pn, int wc, int fq, float (&v)[2][8], float rs) const {
        const int k = 2 * wc + (fq >> 1), hh = fq & 1;
        bf16_t* dst = (bf16_t*)(ws + WS_QP) + ((size_t)(row >> 5) * 8 + pn) * (2 * 8 * 2 * 32 * 8) + (size_t)((k * 2 + hh) * 32 + (row & 31)) * 8;
#pragma unroll
        for (int bj = 0; bj < 2; ++bj) {
#pragma unroll
            for (int e = 0; e < 8; ++e) v[bj][e] *= rs;
            store8_bf16(dst + bj * (8 * 2 * 32 * 8), v[bj]);
        }
    }
};

struct EpiAll {
    unsigned char* ws; const float* aux; int kind;
    __device__ __forceinline__ void row16(int row, int pn, int wc, int fq, float (&v)[2][8], float rs) const {
        unsigned char* w2 = launder(ws);
        if (kind == 0) { EpiInProj E{w2, aux}; E.row16(row, pn, wc, fq, v, rs); }
        else if (kind == 1 || kind == 2) { EpiMla E{w2, kind - 1}; E.row16(row, pn, wc, fq, v, rs); }
        else if (kind == 3) { EpiOutProj E{w2, aux}; E.row16(row, pn, wc, fq, v); }
        else { EpiQuery E{w2}; E.row16(row, pn, wc, fq, v, rs); }
    }
    __device__ __forceinline__ float row_scale(int row) const {
        if (kind == 0) { const f32x4 sa = *(const f32x4*)((const float*)(ws + WS_PSS) + (size_t)row * 8), sb = *(const f32x4*)((const float*)(ws + WS_PSS) + (size_t)row * 8 + 4);
            return 1.0f / sqrtf((((sa.x + sa.y) + (sa.z + sa.w)) + ((sb.x + sb.y) + (sb.z + sb.w))) * (1.0f / DM) + EPS); }
        if (kind == 1 || kind == 2) { const f32x4 pq = *(const f32x4*)((const float*)(ws + (kind == 1 ? WS_PARTQ : WS_PARTKV)) + (size_t)row * 4); const float ssum = (pq.x + pq.y) + (pq.z + pq.w);
            return kind == 1 ? 1.0f / sqrtf(ssum * (1.0f / 256.0f) + EPS) * (0.10206207261596575f * LOG2E) : 1.0f / sqrtf(ssum * (1.0f / 128.0f) + EPS); }
        if (kind == 4) return rstd2_of(ws, row);
        return 1.0f;
    }
};
struct Gemm { const bf16_t* A; const bf16_t* Bt; int M, N, K, lda, ldb; };

template <class Epi>
__device__ __forceinline__ void gemm_naive(const Gemm g, int c0, int G, const Epi& E) {
    const int tid = tid_(), wid = tid >> 6, lane = tid & 63, wr = wid >> 2, wc = wid & 3, fr = lane & 15, fq = lane >> 4;
    const int nM = g.M / 256, nN = g.N / 256;
    for (int u = c0; u < nM * nN; u += G) {
        const int pm = u / nN, pn = u % nN;
        for (int ai = 0; ai < 2; ++ai)
            for (int m = 0; m < 4; ++m) {
                const int row = pm * 256 + ai * 128 + wr * 64 + m * 16 + fr;
                float v[2][8];
#pragma unroll
                for (int bj = 0; bj < 2; ++bj)
#pragma unroll
                    for (int e = 0; e < 8; ++e) v[bj][e] = 0.f;
                const bf16_t* ap = g.A + (size_t)row * g.lda;
                for (int k = 0; k < g.K; k += 8) {
                    const u32x4 aw = *(const u32x4*)(ap + k);
                    const float a0 = bflo(aw.x), a1 = bfhi(aw.x), a2 = bflo(aw.y), a3 = bfhi(aw.y), a4 = bflo(aw.z), a5 = bfhi(aw.z), a6 = bflo(aw.w), a7 = bfhi(aw.w);
#pragma unroll
                    for (int bj = 0; bj < 2; ++bj)
#pragma unroll
                        for (int e = 0; e < 8; ++e) {
                            const int col = pn * 256 + bj * 128 + wc * 32 + fq * 8 + e;
                            const u32x4 bw = *(const u32x4*)(g.Bt + (size_t)col * g.ldb + k);
                            float s = v[bj][e];
                            s += a0 * bflo(bw.x); s += a1 * bfhi(bw.x); s += a2 * bflo(bw.y); s += a3 * bfhi(bw.y); s += a4 * bflo(bw.z); s += a5 * bfhi(bw.z); s += a6 * bflo(bw.w); s += a7 * bfhi(bw.w);
                            v[bj][e] = s;
                        }
                }
                E.row16(row, pn, wc, fq, v, 1.0f);
            }
    }
}

__device__ __forceinline__ void fcum_scan(unsigned char* ws, int seq  , int tid, LAS unsigned char* lds) {
    const int b = seq >> 2, h = seq & 3, lane = tid & 63, wave = tid >> 6;
    const float* lf = (const float*)(ws + WS_LOGF) + (size_t)b * SEQ * 4 + h + (size_t)(wave * 512 + lane * 8) * 4;
    float* fc = (float*)(ws + WS_FCUM) + (size_t)b * SEQ * 4 + h + (size_t)(wave * 512 + lane * 8) * 4;
    float v[8]; float loc = 0.f;
#pragma unroll
    for (int i = 0; i < 8; ++i) v[i] = lf[4 * i];
#pragma unroll
    for (int i = 0; i < 8; ++i) loc += v[i];
    float inc = loc;
#pragma unroll
    for (int o = 1; o < 64; o <<= 1) { const float t = __shfl_up(inc, o); if (lane >= o) inc += t; }
    volatile LAS float* tot = (volatile LAS float*)(lds + 131072 + 1024);
    if (lane == 63) tot[wave] = inc;
    __syncthreads();
    float run = inc - loc;
#pragma unroll
    for (int w = 0; w < 8; ++w) run += (w < wave) ? tot[w] : 0.f;
#pragma unroll
    for (int i = 0; i < 8; ++i) { run += v[i]; fc[4 * i] = run; }
    __syncthreads();
}

__device__ __forceinline__ void load_row64(const bf16_t* p, float* d) {
#pragma unroll
    for (int i = 0; i < 8; ++i) { const u32x4 w = *(const u32x4*)(p + 8 * i); d[8 * i] = bflo(w.x); d[8 * i + 1] = bfhi(w.x); d[8 * i + 2] = bflo(w.y); d[8 * i + 3] = bfhi(w.y); d[8 * i + 4] = bflo(w.z); d[8 * i + 5] = bfhi(w.z); d[8 * i + 6] = bflo(w.w); d[8 * i + 7] = bfhi(w.w); }
}
template <int NCH>
__device__ __forceinline__ float dot_row(const bf16_t* kp, const float* q) {
    float s = 0.f;
#pragma unroll
    for (int i = 0; i < NCH; ++i) { const u32x4 w = *(const u32x4*)(kp + 8 * i);
        s += q[8 * i] * bflo(w.x); s += q[8 * i + 1] * bfhi(w.x); s += q[8 * i + 2] * bflo(w.y); s += q[8 * i + 3] * bfhi(w.y); s += q[8 * i + 4] * bflo(w.z); s += q[8 * i + 5] * bfhi(w.z); s += q[8 * i + 6] * bflo(w.w); s += q[8 * i + 7] * bfhi(w.w); }
    return s;
}
template <int NCH>
__device__ __forceinline__ float dot_rows(const bf16_t* kp, const bf16_t* qp) {
    float s = 0.f;
#pragma unroll
    for (int i = 0; i < NCH; ++i) { const u32x4 w = *(const u32x4*)(kp + 8 * i); const u32x4 q = *(const u32x4*)(qp + 8 * i);
        s += bflo(q.x) * bflo(w.x); s += bfhi(q.x) * bfhi(w.x); s += bflo(q.y) * bflo(w.y); s += bfhi(q.y) * bfhi(w.y); s += bflo(q.z) * bflo(w.z); s += bfhi(q.z) * bfhi(w.z); s += bflo(q.w) * bflo(w.w); s += bfhi(q.w) * bfhi(w.w); }
    return s;
}
__device__ __forceinline__ void axpy_row64(const bf16_t* vp, float w, float* o) {
#pragma unroll
    for (int i = 0; i < 8; ++i) { const u32x4 x = *(const u32x4*)(vp + 8 * i);
        o[8 * i] += w * bflo(x.x); o[8 * i + 1] += w * bfhi(x.x); o[8 * i + 2] += w * bflo(x.y); o[8 * i + 3] += w * bfhi(x.y); o[8 * i + 4] += w * bflo(x.z); o[8 * i + 5] += w * bfhi(x.z); o[8 * i + 6] += w * bflo(x.w); o[8 * i + 7] += w * bfhi(x.w); }
}
__device__ __forceinline__ void head_norm_store(float* o, bool center, const bf16_t* gate, bf16_t* y) {
    if (center) { float m = 0.f;
#pragma unroll
        for (int i = 0; i < 64; ++i) m += o[i];
        m *= (1.0f / 64.0f);
#pragma unroll
        for (int i = 0; i < 64; ++i) o[i] -= m; }
    float s = 0.f;
#pragma unroll
    for (int i = 0; i < 64; ++i) s += o[i] * o[i];
    const float r = 1.0f / sqrtf(s * (1.0f / 64.0f) + EPS);
#pragma unroll
    for (int i = 0; i < 8; ++i) {
        float t[8];
#pragma unroll
        for (int e = 0; e < 8; ++e) t[e] = o[8 * i + e] * r;
        if (gate) { const u32x4 gw = *(const u32x4*)(gate + 8 * i); t[0] *= bflo(gw.x); t[1] *= bfhi(gw.x); t[2] *= bflo(gw.y); t[3] *= bfhi(gw.y); t[4] *= bflo(gw.z); t[5] *= bfhi(gw.z); t[6] *= bflo(gw.w); t[7] *= bfhi(gw.w); }
        store8_bf16(y + 8 * i, t);
    }
}
__device__ __forceinline__ void mixers_naive(unsigned char* ws) {
    const int tid = tid_();
    for (int u = bid_(); u < 512; u += gridDim.x) {
        const int kind = u >> 7, b = (u >> 5) & 3, h = (u >> 3) & 3, qb = u & 7;
        const int t = qb * 512 + tid; const size_t row = (size_t)b * SEQ + t;
        const int tmax = qb * 512 + (tid | 63);
        bf16_t* y = (bf16_t*)(ws + WS_Y) + row * DM + kind * 256 + h * 64;
        float o[64];
#pragma unroll
        for (int i = 0; i < 64; ++i) o[i] = 0.f;
        if (kind == 0) {
            const bf16_t* Q = (const bf16_t*)(ws + WS_RQ) + row * 256 + h * 64; const bf16_t* K = (const bf16_t*)(ws + WS_RK) + (size_t)b * SEQ * 256 + h * 64; const bf16_t* V = (const bf16_t*)(ws + WS_RV) + (size_t)b * SEQ * 256 + h * 64;
            const float lg = log2f(1.0f - exp2f(-5.0f - (float)h));
            for (int s = 0; s <= tmax; ++s) {
                const float d = dot_rows<8>(K + (size_t)s * 256, Q);
                const float w = (s <= t) ? d * fast_exp2(lg * (float)(t - s)) : 0.f;
                axpy_row64(V + (size_t)s * 256, w, o);
            }
            head_norm_store(o, true, (const bf16_t*)(ws + WS_RG) + row * 256 + h * 64, y);
        } else if (kind == 1) {
            const bf16_t* Q = (const bf16_t*)(ws + WS_FQ) + row * 256 + h * 64; const bf16_t* K = (const bf16_t*)(ws + WS_FK) + (size_t)b * SEQ * 256 + h * 64; const bf16_t* V = (const bf16_t*)(ws + WS_FV) + (size_t)b * SEQ * 256 + h * 64;
            const float* fc = (const float*)(ws + WS_FCUM) + (size_t)b * SEQ * 4 + h;
            float mx = -INFINITY, l = 0.f;
            for (int s = 0; s <= tmax; ++s) {
                const float d = dot_rows<8>(K + (size_t)s * 256, Q) - fc[(size_t)s * 4] * LOG2E;
                if (s <= t) {
                    const float mn = fmaxf(mx, d), al = fast_exp2(mx - mn), w = fast_exp2(d - mn);
                    l = l * al + w; mx = mn;
#pragma unroll
                    for (int i = 0; i < 64; ++i) o[i] *= al;
                    axpy_row64(V + (size_t)s * 256, w, o);
                }
            }
            const float il = 1.0f / l;
#pragma unroll
            for (int i = 0; i < 64; ++i) o[i] *= il;
            head_norm_store(o, false, nullptr, y);
        } else if (kind == 2) {
            const bf16_t* Q = (const bf16_t*)(ws + WS_SQ) + row * 256 + h * 64; const bf16_t* K = (const bf16_t*)(ws + WS_SK) + (size_t)b * SEQ * 256 + h * 64; const bf16_t* V = (const bf16_t*)(ws + WS_SV) + (size_t)b * SEQ * 256 + h * 64;
            float R = 0.f;
            for (int s = tmax - 1; s >= 0; --s) {
                const float z = dot_rows<8>(K + (size_t)s * 256, Q);
                const float sp = fmaxf(z, 0.f) + fast_log2(1.0f + fast_exp2(-fabsf(z)));
                if (s < t) {
                    const float w = fast_exp2(z - sp + R); R -= sp;
                    axpy_row64(V + (size_t)s * 256, w, o);
                }
            }
            head_norm_store(o, false, nullptr, y);
        } else {
            const bf16_t* Q = (const bf16_t*)(ws + WS_QD) + row * 384 + h * 96; const bf16_t* K = (const bf16_t*)(ws + WS_KD) + (size_t)b * SEQ * 384 + h * 96; const bf16_t* V = (const bf16_t*)(ws + WS_VD) + (size_t)b * SEQ * 256 + h * 64;
            float mx = -INFINITY, l = 0.f;
            for (int s = 0; s <= tmax; ++s) {
                const float d = dot_rows<12>(K + (size_t)s * 384, Q);
                if (s <= t) {
                    const float mn = fmaxf(mx, d), al = fast_exp2(mx - mn), w = fast_exp2(d - mn);
                    l = l * al + w; mx = mn;
#pragma unroll
                    for (int i = 0; i < 64; ++i) o[i] *= al;
                    axpy_row64(V + (size_t)s * 256, w, o);
                }
            }
            const float il = 1.0f / l;
#pragma unroll
            for (int i = 0; i < 64; ++i) o[i] *= il;
            head_norm_store(o, false, nullptr, y);
        }
    }
}


typedef float f32x16 __attribute__((ext_vector_type(16)));
typedef float f32x2_t __attribute__((ext_vector_type(2)));
typedef __bf16 bf16x2_t __attribute__((ext_vector_type(2)));
typedef short s16x4 __attribute__((ext_vector_type(4)));
typedef _Float16 h16x2 __attribute__((ext_vector_type(2)));
typedef _Float16 h16x4 __attribute__((ext_vector_type(4)));
#define MFMA32(a, b, c) __builtin_amdgcn_mfma_f32_32x32x16_bf16(a, b, c, 0, 0, 0)
__device__ __forceinline__ unsigned cvtpk(float lo, float hi) { f32x2_t v = {lo, hi}; bf16x2_t b = __builtin_convertvector(v, bf16x2_t); return __builtin_bit_cast(unsigned, b); }
__device__ __forceinline__ int crow(int r, int hi) { return (r & 3) + 8 * (r >> 2) + 4 * hi; }
__device__ __forceinline__ void swap32(float x, float& lo, float& hi) {
    unsigned a = __builtin_bit_cast(unsigned, x), b = a; asm volatile("" : "+v"(b));
    const auto r = __builtin_amdgcn_permlane32_swap(a, b, false, false);
    lo = __builtin_bit_cast(float, (unsigned)r[0]); hi = __builtin_bit_cast(float, (unsigned)r[1]);
}
__device__ __forceinline__ float pair_sum(float x) { float lo, hi; swap32(x, lo, hi); return lo + hi; }
__device__ __forceinline__ float pair_max(float x) { float lo, hi; swap32(x, lo, hi); return __builtin_fmaxf(lo, hi); }
__device__ __forceinline__ s16x4 vtr_read(const LAS unsigned char* p) {
    typedef short v4i16_t __attribute__((ext_vector_type(4)));
    return __builtin_bit_cast(s16x4, __builtin_amdgcn_ds_read_tr16_b64_v4i16((LAS v4i16_t*)p));
}
constexpr int MX_KB = 12288, MX_VB = 8192, MX_STAGE = MX_KB + MX_VB + 256, MX_CTL = 2 * MX_STAGE;
constexpr int MIX_UNITS = 1024;


struct CvtCtx { const float* eu; const float* ev; const float* gain; unsigned char* ws; size_t g0, gs; int j; f32x4 v[4]; };
constexpr int CVT_NJ = 32;
constexpr size_t CVT_NU = (size_t)DEPTH * 16384 * 1024 / 16;
__device__ __forceinline__ void cvt_issue(CvtCtx& c) {
    if (c.j < CVT_NJ) { const size_t g = c.g0 + (size_t)c.j * c.gs; const float* src = (g < CVT_NU) ? c.eu + g * 16 : c.ev + (g - CVT_NU) * 16;
        const GAS f32x4* sp = (const GAS f32x4*)src;
#pragma unroll
        for (int q = 0; q < 4; ++q) c.v[q] = sp[q]; }
}
__device__ __forceinline__ void cvt_finish(CvtCtx& c) {
    asm volatile("" :: "v"(c.v[0]), "v"(c.v[1]), "v"(c.v[2]), "v"(c.v[3]));
    if (c.j < CVT_NJ) {
        const size_t g = c.g0 + (size_t)c.j * c.gs; const bool isu = g < CVT_NU; const size_t gl = isu ? g : g - CVT_NU;
        f32x4 a = c.v[0], b = c.v[1], cc = c.v[2], d = c.v[3];
        float sc = EV_SCALE;
        if (isu) sc = EU_SCALE;
        u32x4 o;
        o.x = pk4_i8(a.x * sc, a.y * sc, a.z * sc, a.w * sc); o.y = pk4_i8(b.x * sc, b.y * sc, b.z * sc, b.w * sc); o.z = pk4_i8(cc.x * sc, cc.y * sc, cc.z * sc, cc.w * sc); o.w = pk4_i8(d.x * sc, d.y * sc, d.z * sc, d.w * sc);
        const size_t row = gl >> 6, c16 = gl & 63, lay = row >> 14, e = row & 16383;
        *(u32x4*)(c.ws + (isu ? WS_EU : WS_EV) + (((lay * 8 + (c16 >> 3)) * 16384 + e) * 128 + (c16 & 7) * 16)) = o;
        ++c.j;
    }
}

constexpr int MX_OST = 24576, MX_OROW = 144;
__device__ __forceinline__ void mix_store_rows(const f32x16& o0, const f32x16& o1, float rn, LAS unsigned char* lds, bf16_t* ybase  ,
                                               const bf16_t* gbase  , int lane, int wave, int r32, int hh) {
    LAS unsigned char* stg = lds + MX_OST + wave * (32 * MX_OROW);
#pragma unroll
    for (int q4 = 0; q4 < 4; ++q4) {
        u32x2 w0, w1; w0.x = cvtpk(o0[4 * q4] * rn, o0[4 * q4 + 1] * rn); w0.y = cvtpk(o0[4 * q4 + 2] * rn, o0[4 * q4 + 3] * rn);
        w1.x = cvtpk(o1[4 * q4] * rn, o1[4 * q4 + 1] * rn); w1.y = cvtpk(o1[4 * q4 + 2] * rn, o1[4 * q4 + 3] * rn);
        *(LAS u32x2*)(stg + r32 * MX_OROW + (8 * q4 + 4 * hh) * 2) = w0; *(LAS u32x2*)(stg + r32 * MX_OROW + 64 + (8 * q4 + 4 * hh) * 2) = w1;
    }
    asm volatile("s_waitcnt lgkmcnt(0)" ::: "memory");
#pragma unroll
    for (int i = 0; i < 4; ++i) {
        const int row = 8 * i + (lane >> 3), ch = lane & 7;
        u32x4 v = *(const LAS u32x4*)(stg + row * MX_OROW + ch * 16);
        if (gbase) { const u32x4 g = *(const u32x4*)(gbase + (size_t)row * 256 + ch * 8); float a[8], b[8]; unpack8(v, a); unpack8(g, b);
            v.x = cvtpk(a[0] * b[0], a[1] * b[1]); v.y = cvtpk(a[2] * b[2], a[3] * b[3]); v.z = cvtpk(a[4] * b[4], a[5] * b[5]); v.w = cvtpk(a[6] * b[6], a[7] * b[7]); }
        *(u32x4*)(ybase + (size_t)row * DM + ch * 8) = v;
    }
}
template <int KIND>
__device__ __forceinline__ void mix_unit(unsigned char* ws, int b, int h, int qb, LAS unsigned char* lds, int tid, CvtCtx& cv) {
    constexpr int DK = (KIND == 3) ? 96 : 64, ND0 = DK / 16;
    asm volatile("" : "+v"(tid));
    const int lane = tid & 63, wave = __builtin_amdgcn_readfirstlane(tid >> 6), r32 = lane & 31, hh = lane >> 5;
    const int q0 = qb * 256, qw0 = q0 + 32 * wave, qpos = qw0 + r32;
    const size_t rowb = (size_t)b * SEQ;
    const bf16_t *Qg, *Kg, *Vg; int ldq, ldk, ldv;
    if (KIND == 0) { Qg = (const bf16_t*)(ws + WS_RQ); Kg = (const bf16_t*)(ws + WS_RK); Vg = (const bf16_t*)(ws + WS_RV); ldq = 256; ldk = 256; ldv = 256; }
    else if (KIND == 1) { Qg = (const bf16_t*)(ws + WS_FQ); Kg = (const bf16_t*)(ws + WS_FK); Vg = (const bf16_t*)(ws + WS_FV); ldq = 256; ldk = 256; ldv = 256; }
    else if (KIND == 2) { Qg = (const bf16_t*)(ws + WS_SQ); Kg = (const bf16_t*)(ws + WS_SK); Vg = (const bf16_t*)(ws + WS_SV); ldq = 256; ldk = 256; ldv = 256; }
    else { Qg = (const bf16_t*)(ws + WS_QD); Kg = (const bf16_t*)(ws + WS_KD); Vg = (const bf16_t*)(ws + WS_VD); ldq = 384; ldk = 384; ldv = 256; }
    Qg += rowb * ldq + h * DK; Kg += rowb * ldk + h * DK; Vg += rowb * ldv + h * 64;
    const float* fcg = (const float*)(ws + WS_FCUM) + rowb * 4 + h;
    bf16x8 qf[ND0];
#pragma unroll
    for (int d0 = 0; d0 < ND0; ++d0) qf[d0] = *(const bf16x8*)(Qg + (size_t)qpos * ldq + 16 * d0 + 8 * hh);
    f32x16 o0, o1;
#pragma unroll
    for (int r = 0; r < 16; ++r) { o0[r] = 0.f; o1[r] = 0.f; }
    float m_run = -INFINITY, R_run = 0.f;
    f32x4 ol = {0.f, 0.f, 0.f, 0.f};
    const short one_ = (r32 == 0 || r32 == 8 || r32 == 20 || r32 == 28) ? (short)0x3F80 : (short)0;
    const bf16x8 ones_frag = (bf16x8){one_, one_, one_, one_, one_, one_, one_, one_};
    float lg = 0.f;
    if (KIND == 0) lg = log2f(1.0f - exp2f(-5.0f - (float)h));
    const int NT = (q0 + 256) / 64;
    u32x4 kst0, kst1, vst; float bst = 0.f;
#define MX_LOAD(t_) do { const int k0_ = (t_) * 64; \
        kst0 = *(const u32x4*)(Kg + (size_t)(k0_ + lane) * ldk + wave * 8); \
        if (KIND == 3) { if (wave < 4) kst1 = *(const u32x4*)(Kg + (size_t)(k0_ + lane) * ldk + (8 + wave) * 8); } \
        vst = *(const u32x4*)(Vg + (size_t)(k0_ + 16 * (wave & 3) + (lane >> 2)) * ldv + (wave >> 2) * 32 + (lane & 3) * 8); \
        if (KIND == 1) { if (tid < 64) bst = fcg[(size_t)(k0_ + tid) * 4]; } } while (0)
#define MX_STORE(st_) do { LAS unsigned char* sb_ = lds + (st_) * MX_STAGE; \
        *(LAS u32x4*)(sb_ + wave * 1024 + lane * 16) = kst0; \
        if (KIND == 3) { if (wave < 4) *(LAS u32x4*)(sb_ + (8 + wave) * 1024 + lane * 16) = kst1; } \
        *(LAS u32x4*)(sb_ + MX_KB + (wave >> 2) * 4096 + (wave & 3) * 1024 + lane * 16) = vst; \
        if (KIND == 1) { if (tid < 64) *(LAS float*)(sb_ + MX_KB + MX_VB + tid * 4) = -bst * LOG2E; } } while (0)
    MX_LOAD(NT - 1); MX_STORE(0);
    __syncthreads();
    volatile LAS unsigned* ctl = (volatile LAS unsigned*)(lds + MX_CTL);
    for (int it = 0; it < NT; ++it) {
        const int t = NT - 1 - it, st = it & 1, k0 = t * 64;
        if (it + 1 < NT) MX_LOAD(t - 1);
        if (KIND == 1 || KIND == 3) cvt_issue(cv);
        if (k0 <= qw0 + 31) {
            const LAS unsigned char* sb = lds + st * MX_STAGE;
            const LAS unsigned char* kp = sb + hh * 1024 + r32 * 16;
            f32x16 p0, p1;
            if (KIND == 1) {
                const LAS float* bp = (const LAS float*)(sb + MX_KB + MX_VB) + 4 * hh;
#pragma unroll
                for (int q4 = 0; q4 < 4; ++q4) { const f32x4 b0 = *(const LAS f32x4*)(bp + 8 * q4), b1 = *(const LAS f32x4*)(bp + 32 + 8 * q4);
                    p0[4 * q4] = b0.x; p0[4 * q4 + 1] = b0.y; p0[4 * q4 + 2] = b0.z; p0[4 * q4 + 3] = b0.w; p1[4 * q4] = b1.x; p1[4 * q4 + 1] = b1.y; p1[4 * q4 + 2] = b1.z; p1[4 * q4 + 3] = b1.w; }
            } else {
#pragma unroll
                for (int r = 0; r < 16; ++r) { p0[r] = 0.f; p1[r] = 0.f; }
            }
            s16x4 vlo[8], vhi[8]; bf16x8 kf0[ND0], kf1[ND0];
            if (KIND == 1) {
#pragma unroll
                for (int d0 = 0; d0 < ND0; ++d0) { kf0[d0] = *(const LAS bf16x8*)(kp + d0 * 2048); kf1[d0] = *(const LAS bf16x8*)(kp + d0 * 2048 + 512); }
            }
            { const LAS unsigned char* vp = sb + MX_KB + ((lane >> 4) & 1) * 32 + (lane & 3) * 8 + (4 * hh + ((lane & 15) >> 2)) * 64;
#pragma unroll
              for (int ks = 0; ks < 4; ++ks) { vlo[ks] = vtr_read(vp + ks * 1024); vhi[ks] = vtr_read(vp + ks * 1024 + 512); vlo[4 + ks] = vtr_read(vp + 4096 + ks * 1024); vhi[4 + ks] = vtr_read(vp + 4096 + ks * 1024 + 512); } }
            if (KIND == 1) {
                __builtin_amdgcn_sched_barrier(0);
#pragma unroll
                for (int d0 = 0; d0 < ND0; ++d0) { p0 = MFMA32(kf0[d0], qf[d0], p0); p1 = MFMA32(kf1[d0], qf[d0], p1); }
            } else {
#pragma unroll
                for (int d0 = 0; d0 < ND0; ++d0) { const bf16x8 a0 = *(const LAS bf16x8*)(kp + d0 * 2048), a1 = *(const LAS bf16x8*)(kp + d0 * 2048 + 512); p0 = MFMA32(a0, qf[d0], p0); p1 = MFMA32(a1, qf[d0], p1); }
            }
            const bool band = (k0 + 63 > qw0);
            if (KIND == 1 || KIND == 3) {
                if (band) {
#pragma unroll
                    for (int r = 0; r < 16; ++r) { const int kp0 = k0 + crow(r, hh); if (kp0 > qpos) p0[r] = -INFINITY; if (kp0 + 32 > qpos) p1[r] = -INFINITY; }
                }
                float tm = __builtin_fmaxf(__builtin_fmaxf(p0[0], p0[1]), p1[0]), tm2 = __builtin_fmaxf(__builtin_fmaxf(p0[2], p0[3]), p1[1]);
                tm = __builtin_fmaxf(__builtin_fmaxf(tm, p1[2]), p1[3]);
#pragma unroll
                for (int r = 4; r < 16; r += 4) { tm = __builtin_fmaxf(__builtin_fmaxf(tm, p0[r]), p0[r + 1]); tm2 = __builtin_fmaxf(__builtin_fmaxf(tm2, p0[r + 2]), p0[r + 3]);
                    tm = __builtin_fmaxf(__builtin_fmaxf(tm, p1[r]), p1[r + 1]); tm2 = __builtin_fmaxf(__builtin_fmaxf(tm2, p1[r + 2]), p1[r + 3]); }
                tm = pair_max(__builtin_fmaxf(tm, tm2));
                if (__any(tm > m_run + 8.0f)) {
                    const float mn = fmaxf(m_run, tm), al = fast_exp2(m_run - mn);
                    ol[0] *= al; m_run = mn;
#pragma unroll
                    for (int r = 0; r < 16; ++r) { o0[r] *= al; o1[r] *= al; }
                }
#pragma unroll
                for (int r = 0; r < 16; ++r) { p0[r] = fast_exp2(p0[r] - m_run); p1[r] = fast_exp2(p1[r] - m_run); }
            } else if (KIND == 0) {
                const float base = lg * (float)(qpos - k0 - 4 * hh);
#pragma unroll
                for (int r = 0; r < 16; ++r) {
                    const float c0 = (float)((r & 3) + 8 * (r >> 2));
                    float w0 = fast_exp2(base - lg * c0), w1 = fast_exp2(base - lg * (c0 + 32.0f));
                    if (band) { const int kp0 = k0 + crow(r, hh); if (kp0 > qpos) w0 = 0.f; if (kp0 + 32 > qpos) w1 = 0.f; }
                    p0[r] *= w0; p1[r] *= w1;
                }
            } else {
                float sp0[16], sp1[16];
#pragma unroll
                for (int r = 0; r < 16; ++r) {
                    const float z0 = p0[r], z1 = p1[r];
                    float s0 = fmaxf(z0, 0.f) + fast_log2(1.0f + fast_exp2(-fabsf(z0))), s1 = fmaxf(z1, 0.f) + fast_log2(1.0f + fast_exp2(-fabsf(z1)));
                    if (band) { const int kp0 = k0 + crow(r, hh); if (kp0 >= qpos) s0 = 0.f; if (kp0 + 32 >= qpos) s1 = 0.f; }
                    sp0[r] = s0; sp1[r] = s1;
                }
                float glo[8], ghi[8];
#pragma unroll
                for (int q4 = 0; q4 < 4; ++q4) {
                    swap32((sp0[4 * q4] + sp0[4 * q4 + 1]) + (sp0[4 * q4 + 2] + sp0[4 * q4 + 3]), glo[q4], ghi[q4]);
                    swap32((sp1[4 * q4] + sp1[4 * q4 + 1]) + (sp1[4 * q4 + 2] + sp1[4 * q4 + 3]), glo[4 + q4], ghi[4 + q4]);
                }
                float suf[16]; float run = 0.f;
#pragma unroll
                for (int i = 7; i >= 0; --i) { suf[2 * i + 1] = run; run += ghi[i]; suf[2 * i] = run; run += glo[i]; }
#pragma unroll
                for (int r = 0; r < 16; ++r) {
                    const int q4 = r >> 2, e = r & 3;
                    float in0 = 0.f, in1 = 0.f;
#pragma unroll
                    for (int e2 = 3; e2 > e; --e2) { in0 += sp0[4 * q4 + e2]; in1 += sp1[4 * q4 + e2]; }
                    const float a0 = R_run - (hh ? suf[2 * q4 + 1] : suf[2 * q4]) - in0;
                    const float a1 = R_run - (hh ? suf[2 * (4 + q4) + 1] : suf[2 * (4 + q4)]) - in1;
                    float w0 = fast_exp2(p0[r] - sp0[r] + a0), w1 = fast_exp2(p1[r] - sp1[r] + a1);
                    if (band) { const int kp0 = k0 + crow(r, hh); if (kp0 >= qpos) w0 = 0.f; if (kp0 + 32 >= qpos) w1 = 0.f; }
                    p0[r] = w0; p1[r] = w1;
                }
                R_run -= run;
            }
            bf16x8 pf[4];
            { u32x4 w;
              w.x = cvtpk(p0[0], p0[1]); w.y = cvtpk(p0[2], p0[3]); w.z = cvtpk(p0[4], p0[5]); w.w = cvtpk(p0[6], p0[7]); pf[0] = __builtin_bit_cast(bf16x8, w);
              w.x = cvtpk(p0[8], p0[9]); w.y = cvtpk(p0[10], p0[11]); w.z = cvtpk(p0[12], p0[13]); w.w = cvtpk(p0[14], p0[15]); pf[1] = __builtin_bit_cast(bf16x8, w);
              w.x = cvtpk(p1[0], p1[1]); w.y = cvtpk(p1[2], p1[3]); w.z = cvtpk(p1[4], p1[5]); w.w = cvtpk(p1[6], p1[7]); pf[2] = __builtin_bit_cast(bf16x8, w);
              w.x = cvtpk(p1[8], p1[9]); w.y = cvtpk(p1[10], p1[11]); w.z = cvtpk(p1[12], p1[13]); w.w = cvtpk(p1[14], p1[15]); pf[3] = __builtin_bit_cast(bf16x8, w); }
#pragma unroll
            for (int ks = 0; ks < 4; ++ks) {
                const bf16x8 va = (bf16x8){vlo[ks][0], vlo[ks][1], vlo[ks][2], vlo[ks][3], vhi[ks][0], vhi[ks][1], vhi[ks][2], vhi[ks][3]};
                const bf16x8 vb = (bf16x8){vlo[4 + ks][0], vlo[4 + ks][1], vlo[4 + ks][2], vlo[4 + ks][3], vhi[4 + ks][0], vhi[4 + ks][1], vhi[4 + ks][2], vhi[4 + ks][3]};
                o0 = MFMA32(va, pf[ks], o0); o1 = MFMA32(vb, pf[ks], o1);
                if (KIND == 1 || KIND == 3) ol = __builtin_amdgcn_mfma_f32_16x16x32_bf16(ones_frag, pf[ks], ol, 0, 0, 0);
            }
        }
        if (KIND == 1 || KIND == 3) { __builtin_amdgcn_sched_barrier(0); cvt_finish(cv); }
        if (it + 1 < NT) MX_STORE(st ^ 1);
        if (KIND == 2) { const bool done = (k0 <= qw0 + 31) && !__any(R_run > -64.0f); if (lane == 0) ctl[8 + 8 * (it & 1) + wave] = done ? 1u : 0u; }
        asm volatile("s_waitcnt lgkmcnt(0)\n\ts_barrier" ::: "memory");
        if (KIND == 2) {
            unsigned alld = 1u;
#pragma unroll
            for (int w = 0; w < 8; ++w) alld &= ctl[8 + 8 * (it & 1) + w];
            if (alld) break;
        }
    }
#undef MX_LOAD
#undef MX_STORE
    if (KIND == 1 || KIND == 3) {
        const float inv = 1.0f / ol[0];
#pragma unroll
        for (int r = 0; r < 16; ++r) { o0[r] *= inv; o1[r] *= inv; }
    }
    if (KIND == 0) {
        float sm = 0.f;
#pragma unroll
        for (int r = 0; r < 16; ++r) sm += o0[r] + o1[r];
        const float mean = pair_sum(sm) * (1.0f / 64.0f);
#pragma unroll
        for (int r = 0; r < 16; ++r) { o0[r] -= mean; o1[r] -= mean; }
    }
    float ss = 0.f;
#pragma unroll
    for (int r = 0; r < 16; ++r) ss += o0[r] * o0[r] + o1[r] * o1[r];
    const float rn = 1.0f / sqrtf(pair_sum(ss) * (1.0f / 64.0f) + EPS);
    mix_store_rows(o0, o1, rn, lds, (bf16_t*)(ws + WS_Y) + (rowb + qw0) * DM + KIND * 256 + h * 64, (const bf16_t*)nullptr, lane, wave, r32, hh);
    __syncthreads();
}

__device__ __forceinline__ void mix_unit_ret(unsigned char* ws, int b, int h, int qb, LAS unsigned char* lds, int tid, CvtCtx& cv) {
    constexpr int ND0 = 4;
    asm volatile("" : "+v"(tid));
    const int lane = tid & 63, wave = __builtin_amdgcn_readfirstlane(tid >> 6), r32 = lane & 31, hh = lane >> 5;
    const int q0 = qb * 256, qw0 = q0 + 32 * wave, qpos = qw0 + r32;
    const size_t rowb = (size_t)b * SEQ;
    const bf16_t* Qg = (const bf16_t*)(ws + WS_RQ) + rowb * 256 + h * 64; const bf16_t* Kg = (const bf16_t*)(ws + WS_RK) + rowb * 256 + h * 64; const bf16_t* Vg = (const bf16_t*)(ws + WS_RV) + rowb * 256 + h * 64;
    bf16x8 qf[ND0];
#pragma unroll
    for (int d0 = 0; d0 < ND0; ++d0) qf[d0] = *(const bf16x8*)(Qg + (size_t)qpos * 256 + 16 * d0 + 8 * hh);
    f32x16 o0, o1, sacc;
#pragma unroll
    for (int r = 0; r < 16; ++r) { o0[r] = 0.f; o1[r] = 0.f; sacc[r] = 0.f; }
    const float lg = log2f(1.0f - exp2f(-5.0f - (float)h));
    const int NT = (q0 + 256) / 64;
    const int vrow = 16 * (wave & 3) + (lane >> 2), vcol = (wave >> 2) * 32 + (lane & 3) * 8, voff = (wave >> 2) * 4096 + (wave & 3) * 1024 + lane * 16;
    const int troff = ((lane >> 4) & 1) * 32 + (lane & 3) * 8 + (4 * hh + ((lane & 15) >> 2)) * 64;
    u32x4 kst0, vst;
#define RT_LOAD(it_) do { const int k0_ = (NT - 1 - (it_)) * 64; \
        if ((it_) < 4) kst0 = *(const u32x4*)(Kg + (size_t)(k0_ + lane) * 256 + wave * 8); \
        else kst0 = *(const u32x4*)(Kg + (size_t)(k0_ + vrow) * 256 + vcol); \
        vst = *(const u32x4*)(Vg + (size_t)(k0_ + vrow) * 256 + vcol); } while (0)
#define RT_STORE(st_, it_) do { LAS unsigned char* sb_ = lds + (st_) * MX_STAGE; \
        if ((it_) < 4) *(LAS u32x4*)(sb_ + wave * 1024 + lane * 16) = kst0; \
        else { const float dc = fast_exp2(lg * (float)(q0 - 1 - ((NT - 1 - (it_)) * 64 + vrow))); float f_[8]; unpack8(kst0, f_); \
               u32x4 w_; w_.x = cvtpk(f_[0] * dc, f_[1] * dc); w_.y = cvtpk(f_[2] * dc, f_[3] * dc); w_.z = cvtpk(f_[4] * dc, f_[5] * dc); w_.w = cvtpk(f_[6] * dc, f_[7] * dc); \
               *(LAS u32x4*)(sb_ + voff) = w_; } \
        *(LAS u32x4*)(sb_ + MX_KB + voff) = vst; } while (0)
    RT_LOAD(0); RT_STORE(0, 0);
    __syncthreads();
    for (int it = 0; it < NT; ++it) {
        const int st = it & 1, k0 = (NT - 1 - it) * 64;
        if (it + 1 < NT) RT_LOAD(it + 1);
        const LAS unsigned char* sb = lds + st * MX_STAGE;
        if (it < 4) {
            if (k0 <= qw0 + 31) {
                const LAS unsigned char* kp = sb + hh * 1024 + r32 * 16;
                f32x16 p0, p1;
#pragma unroll
                for (int r = 0; r < 16; ++r) { p0[r] = 0.f; p1[r] = 0.f; }
#pragma unroll
                for (int d0 = 0; d0 < ND0; ++d0) { const bf16x8 a0 = *(const LAS bf16x8*)(kp + d0 * 2048), a1 = *(const LAS bf16x8*)(kp + d0 * 2048 + 512); p0 = MFMA32(a0, qf[d0], p0); p1 = MFMA32(a1, qf[d0], p1); }
                float lgi = lg; asm volatile("" : "+v"(lgi));
                const float base = lgi * (float)(qpos - k0 - 4 * hh);
#pragma unroll
                for (int r = 0; r < 16; ++r) {
                    const float c0 = (float)((r & 3) + 8 * (r >> 2));
                    float w0 = fast_exp2(base - lgi * c0), w1 = fast_exp2(base - lgi * (c0 + 32.0f));
                    const int kp0 = k0 + crow(r, hh); if (kp0 > qpos) w0 = 0.f; if (kp0 + 32 > qpos) w1 = 0.f;
                    p0[r] *= w0; p1[r] *= w1;
                }
                bf16x8 pf[4];
                { u32x4 w;
                  w.x = cvtpk(p0[0], p0[1]); w.y = cvtpk(p0[2], p0[3]); w.z = cvtpk(p0[4], p0[5]); w.w = cvtpk(p0[6], p0[7]); pf[0] = __builtin_bit_cast(bf16x8, w);
                  w.x = cvtpk(p0[8], p0[9]); w.y = cvtpk(p0[10], p0[11]); w.z = cvtpk(p0[12], p0[13]); w.w = cvtpk(p0[14], p0[15]); pf[1] = __builtin_bit_cast(bf16x8, w);
                  w.x = cvtpk(p1[0], p1[1]); w.y = cvtpk(p1[2], p1[3]); w.z = cvtpk(p1[4], p1[5]); w.w = cvtpk(p1[6], p1[7]); pf[2] = __builtin_bit_cast(bf16x8, w);
                  w.x = cvtpk(p1[8], p1[9]); w.y = cvtpk(p1[10], p1[11]); w.z = cvtpk(p1[12], p1[13]); w.w = cvtpk(p1[14], p1[15]); pf[3] = __builtin_bit_cast(bf16x8, w); }
                const LAS unsigned char* vp = sb + MX_KB + troff;
#pragma unroll
                for (int ks = 0; ks < 4; ++ks) {
                    const s16x4 a_lo = vtr_read(vp + ks * 1024), a_hi = vtr_read(vp + ks * 1024 + 512), b_lo = vtr_read(vp + 4096 + ks * 1024), b_hi = vtr_read(vp + 4096 + ks * 1024 + 512);
                    const bf16x8 va = (bf16x8){a_lo[0], a_lo[1], a_lo[2], a_lo[3], a_hi[0], a_hi[1], a_hi[2], a_hi[3]};
                    const bf16x8 vb = (bf16x8){b_lo[0], b_lo[1], b_lo[2], b_lo[3], b_hi[0], b_hi[1], b_hi[2], b_hi[3]};
                    o0 = MFMA32(va, pf[ks], o0); o1 = MFMA32(vb, pf[ks], o1);
                }
            }
        } else {
            const int bd = (wave >> 1) & 1, bk = wave & 1, ks0 = 2 * (wave >> 2);
            const LAS unsigned char* vp = sb + MX_KB + troff + bd * 4096; const LAS unsigned char* kq = sb + troff + bk * 4096;
#pragma unroll
            for (int q = 0; q < 2; ++q) {
                const s16x4 a_lo = vtr_read(vp + (ks0 + q) * 1024), a_hi = vtr_read(vp + (ks0 + q) * 1024 + 512);
                const s16x4 b_lo = vtr_read(kq + (ks0 + q) * 1024), b_hi = vtr_read(kq + (ks0 + q) * 1024 + 512);
                const bf16x8 va = (bf16x8){a_lo[0], a_lo[1], a_lo[2], a_lo[3], a_hi[0], a_hi[1], a_hi[2], a_hi[3]};
                const bf16x8 kb = (bf16x8){b_lo[0], b_lo[1], b_lo[2], b_lo[3], b_hi[0], b_hi[1], b_hi[2], b_hi[3]};
                sacc = MFMA32(va, kb, sacc);
            }
        }
        if (it + 1 < NT) RT_STORE(st ^ 1, it + 1);
        asm volatile("s_waitcnt lgkmcnt(0)\n\ts_barrier" ::: "memory");
    }
#undef RT_LOAD
#undef RT_STORE
    if (NT > 4) {
        const int bd = (wave >> 1) & 1, bk = wave & 1;
        LAS float* sx = (LAS float*)lds + (bd * 2 + bk) * 1024 + lane;
        if (wave >= 4) {
#pragma unroll
            for (int r = 0; r < 16; ++r) sx[r * 64] = sacc[r];
        }
        __syncthreads();
        LAS unsigned char* ksb = lds + 16384;
        if (wave < 4) {
#pragma unroll
            for (int r = 0; r < 16; ++r) {
                const float v = sacc[r] + sx[r * 64];
                const int dv = 32 * bd + crow(r, hh), dk = 32 * bk + r32;
                *(LAS bf16_t*)(ksb + (dk >> 3) * 1024 + dv * 16 + (dk & 7) * 2) = (bf16_t)f2bf(v);
            }
        }
        __syncthreads();
        const LAS unsigned char* kp = ksb + hh * 1024 + r32 * 16;
        f32x16 p0, p1;
#pragma unroll
        for (int r = 0; r < 16; ++r) { p0[r] = 0.f; p1[r] = 0.f; }
#pragma unroll
        for (int d0 = 0; d0 < ND0; ++d0) { const bf16x8 a0 = *(const LAS bf16x8*)(kp + d0 * 2048), a1 = *(const LAS bf16x8*)(kp + d0 * 2048 + 512); p0 = MFMA32(a0, qf[d0], p0); p1 = MFMA32(a1, qf[d0], p1); }
        const float ff = fast_exp2(lg * (float)(qpos - q0 + 1));
#pragma unroll
        for (int r = 0; r < 16; ++r) { o0[r] += p0[r] * ff; o1[r] += p1[r] * ff; }
    }
    float sm = 0.f;
#pragma unroll
    for (int r = 0; r < 16; ++r) sm += o0[r] + o1[r];
    const float mean = pair_sum(sm) * (1.0f / 64.0f);
#pragma unroll
    for (int r = 0; r < 16; ++r) { o0[r] -= mean; o1[r] -= mean; }
    float ss = 0.f;
#pragma unroll
    for (int r = 0; r < 16; ++r) ss += o0[r] * o0[r] + o1[r] * o1[r];
    const float rn = 1.0f / sqrtf(pair_sum(ss) * (1.0f / 64.0f) + EPS);
    mix_store_rows(o0, o1, rn, lds, (bf16_t*)(ws + WS_Y) + (rowb + qw0) * DM + h * 64, (const bf16_t*)(ws + WS_RG) + (rowb + qw0) * 256 + h * 64, lane, wave, r32, hh);
    __syncthreads();
}
template <int SET>
__device__ __forceinline__ void mixers_mfma(const Params& p, unsigned char* ws, int layer, LAS unsigned char* lds) {
    const int tid = tid_();
    CvtCtx cv; cv.eu = p.expert_u; cv.ev = p.expert_v; cv.gain = p.norm_ffn; cv.ws = ws; cv.g0 = (size_t)bid_() * NTHREADS + tid; cv.gs = (size_t)gridDim.x * NTHREADS;
    cv.j = (SET == 1 && layer == 0) ? 0 : CVT_NJ;
#pragma unroll
    for (int q = 0; q < 4; ++q) cv.v[q] = (f32x4){0.f, 0.f, 0.f, 0.f};
    unsigned* qhead = (unsigned*)(ws + WS_CTL) + CW_QUEUE + 64 * (2 * layer + SET);
    volatile LAS unsigned* ctl = (volatile LAS unsigned*)(lds + MX_CTL);
    for (;;) {
        if (tid == 0) ctl[0] = atomicAdd(qhead, 1u);
        __syncthreads();
        const unsigned i = ctl[0];
        __syncthreads();
        if (i >= (unsigned)(MIX_UNITS / 2)) break;
        int kind, qb; const int bh = (int)(i & 15u);
        if (SET == 1) { qb = 15 - (int)(i >> 5); kind = (i & 16u) ? 3 : 1; }
        else if (i < 80u) { kind = 0; qb = 15 - (int)(i >> 4); }
        else if (i < 336u) { kind = 2; qb = 15 - (int)((i - 80u) >> 4); }
        else { kind = 0; qb = 10 - (int)((i - 336u) >> 4); }
        const int b = bh >> 2, h = bh & 3;
        if (SET == 1) { if (kind == 1) mix_unit<1>(ws, b, h, qb, lds, tid, cv); else mix_unit<3>(ws, b, h, qb, lds, tid, cv); }
        else { if (kind == 0) mix_unit_ret(ws, b, h, qb, lds, tid, cv); else mix_unit<2>(ws, b, h, qb, lds, tid, cv); }
    }
    if (SET == 1) { while (cv.j < CVT_NJ) { cvt_issue(cv); cvt_finish(cv); } }
}

#define TOPK_INSERT(tv, ti, vv, ii) do { float v_ = (vv); int i_ = (ii); \
    _Pragma("unroll") for (int j_ = 0; j_ < 16; ++j_) { const bool gt_ = v_ > tv[j_]; const float nv_ = gt_ ? tv[j_] : v_; const int ni_ = gt_ ? ti[j_] : i_; \
        tv[j_] = gt_ ? v_ : tv[j_]; ti[j_] = gt_ ? i_ : ti[j_]; v_ = nv_; i_ = ni_; } } while (0)
__device__ __forceinline__ void peer_score_naive(unsigned char* ws, int layer) {
    const int tid = tid_();
    const bf16_t* SK = (const bf16_t*)(ws + WS_SKEY) + (size_t)layer * 8 * 2 * 128 * 128;
    for (int u = bid_(); u < 256; u += gridDim.x) {
        const int h = u >> 5, t = (u & 31) * 512 + tid;
        const bf16_t* qp = (const bf16_t*)(ws + WS_QP) + (size_t)t * 2048 + h * 256;
        float sv[2][16]; int si[2][16];
#pragma unroll
        for (int p = 0; p < 2; ++p) {
#pragma unroll
            for (int j = 0; j < 16; ++j) { sv[p][j] = -INFINITY; si[p][j] = 0; }
            const bf16_t* kp = SK + (size_t)(h * 2 + p) * 128 * 128;
            for (int n = 0; n < 128; ++n) {
                const float s = dot_rows<16>(kp + (size_t)n * 128, qp + p * 128);
                TOPK_INSERT(sv[p], si[p], s, n);
            }
        }
        float bv[16]; int bi[16];
#pragma unroll
        for (int j = 0; j < 16; ++j) { bv[j] = -INFINITY; bi[j] = 0; }
#pragma unroll
        for (int a = 0; a < 16; ++a)
#pragma unroll
            for (int b = 0; b < 16; ++b) { TOPK_INSERT(bv, bi, sv[0][a] + sv[1][b], si[0][a] * 128 + si[1][b]); }
        float sum = 0.f; const float bmax = bv[0];
#pragma unroll
        for (int j = 0; j < 16; ++j) { bv[j] = __expf(bv[j] - bmax); sum += bv[j]; }
        const float inv = 1.0f / sum;
        int* eo = (int*)(ws + WS_EIDX) + (size_t)t * 128 + h * 16; float* go = (float*)(ws + WS_EGATE) + (size_t)t * 128 + h * 16;
#pragma unroll
        for (int j = 0; j < 16; ++j) { eo[(j & 7) * 16 + (j >> 3) - 14 * h] = bi[j]; go[(j & 7) * 16 + (j >> 3) - 14 * h] = bv[j] * inv; }
    }
}


__device__ __forceinline__ int fkey(float f) { const int i = __builtin_bit_cast(int, f); return i ^ ((i >> 31) & 0x7fffffff); }
__device__ __forceinline__ float keyf(int k) { const int i = k ^ ((k >> 31) & 0x7fffffff); return __builtin_bit_cast(float, i); }
#define KINS(t, x) do { int x_ = (x); _Pragma("unroll") for (int j_ = 0; j_ < 16; ++j_) { const int hi_ = max(t[j_], x_); x_ = min(t[j_], x_); t[j_] = hi_; } } while (0)
#define KCE(a, b) do { const int hi_ = max(a, b), lo_ = min(a, b); a = hi_; b = lo_; } while (0)
#define KC(i, j) KCE(a[i], a[j])
__device__ __forceinline__ void sort16_desc(int (&a)[16]) {
    KC(0, 13); KC(1, 12); KC(2, 15); KC(3, 14); KC(4, 8); KC(5, 6); KC(7, 11); KC(9, 10);
    KC(0, 5); KC(1, 7); KC(2, 9); KC(3, 4); KC(6, 13); KC(8, 14); KC(10, 15); KC(11, 12);
    KC(0, 1); KC(2, 3); KC(4, 5); KC(6, 8); KC(7, 9); KC(10, 11); KC(12, 13); KC(14, 15);
    KC(0, 2); KC(1, 3); KC(4, 10); KC(5, 11); KC(6, 7); KC(8, 9); KC(12, 14); KC(13, 15);
    KC(1, 2); KC(3, 12); KC(4, 6); KC(5, 7); KC(8, 10); KC(9, 11); KC(13, 14);
    KC(1, 4); KC(2, 6); KC(5, 8); KC(7, 10); KC(9, 13); KC(11, 14);
    KC(2, 4); KC(3, 6); KC(9, 12); KC(11, 13);
    KC(3, 5); KC(6, 8); KC(7, 9); KC(10, 12);
    KC(3, 4); KC(5, 6); KC(7, 8); KC(9, 10); KC(11, 12);
    KC(6, 7); KC(8, 9);
}
#undef KC
__device__ __forceinline__ void merge16_desc(int (&a)[16], const int (&b)[16]) {
#pragma unroll
    for (int i = 0; i < 16; ++i) a[i] = max(a[i], b[15 - i]);
#pragma unroll
    for (int j = 8; j > 0; j >>= 1)
#pragma unroll
        for (int i = 0; i < 16; ++i) { const int l = i ^ j; if (l > i) KCE(a[i], a[l]); }
}
constexpr int PS_UNITS = 512;
__device__ __forceinline__ void peer_score_mfma(unsigned char* ws, int layer, LAS unsigned char* lds) {
    const int tid = tid_(), lane = tid & 63, wave = __builtin_amdgcn_readfirstlane(tid >> 6), r32 = lane & 31, hh = lane >> 5;
    const bf16_t* SKg = (const bf16_t*)(ws + WS_SKEY) + (size_t)layer * 8 * 2 * 128 * 128;
    LAS unsigned char* slot = lds + 65536 + tid * 36;
    for (int u0 = 2 * bid_(); u0 < PS_UNITS; u0 += 2 * gridDim.x) {
        const int h = u0 >> 6;
#define PS_QROW(u_) ((const bf16_t*)(ws + WS_QP) + ((size_t)((((u_) & 63) * 256 + 32 * wave) >> 5) * 8 + h) * (2 * 8 * 2 * 32 * 8) + (size_t)(hh * 32 + r32) * 8)
        bf16x8 qf[8];
        { const bf16_t* q0_ = PS_QROW(u0);
#pragma unroll
          for (int k = 0; k < 8; ++k) qf[k] = *(const bf16x8*)(q0_ + k * (2 * 32 * 8)); }
#pragma unroll
        for (int i = 0; i < 8; ++i) {
            const int x = tid + 512 * i, pp = x >> 11, n = (x >> 4) & 127, c = x & 15;
            const u32x4 v = *(const u32x4*)(SKg + ((size_t)(h * 2 + pp) * 128 + n) * 128 + 8 * c);
            *(LAS u32x4*)(lds + pp * 32768 + c * 2048 + n * 16) = v;
        }
        __syncthreads();
      for (int rep = 0; rep < 2; ++rep) {
        const int u = u0 + rep, tok0 = (u & 63) * 256 + 32 * wave;
        const bf16_t* qrow = PS_QROW(u);
        const bf16_t* qnext = PS_QROW(u0 + 1);
        int fin0[16], fin1[16];
#pragma unroll
        for (int pp = 0; pp < 2; ++pp) {
            const LAS unsigned char* kp = lds + pp * 32768 + hh * 2048 + r32 * 16;
            int top[16];
#pragma unroll
            for (int half = 0; half < 2; ++half) {
                int ga[16], gb[16];
#pragma unroll
                for (int q = 0; q < 2; ++q) {
                    const int nb = 2 * half + q;
                    f32x16 acc;
#pragma unroll
                    for (int r = 0; r < 16; ++r) acc[r] = 0.f;
#pragma unroll
                    for (int k = 0; k < 8; ++k) { const bf16x8 a = *(const LAS bf16x8*)(kp + k * 4096 + nb * 512); acc = MFMA32(a, qf[k], acc); }
                    if (nb == 3) { const bf16_t* qn_ = (pp == 0) ? qrow + (8 * 2 * 32 * 8) : qnext;
#pragma unroll
                        for (int k = 0; k < 8; ++k) qf[k] = *(const bf16x8*)(qn_ + k * (2 * 32 * 8));
                    }
#pragma unroll
                    for (int r = 0; r < 16; ++r) { const int n = 32 * nb + crow(r, 0) + 4 * hh; const int key = (fkey(acc[r]) & ~127) | n; if (q == 0) ga[r] = key; else gb[r] = key; }
                }
                sort16_desc(ga); sort16_desc(gb); merge16_desc(ga, gb);
                if (half == 0) {
#pragma unroll
                    for (int j = 0; j < 16; ++j) top[j] = ga[j];
                } else merge16_desc(top, ga);
            }
            int oth[16];
#pragma unroll
            for (int j = 0; j < 16; ++j) { unsigned a_ = (unsigned)top[j], b_ = a_; asm volatile("" : "+v"(b_)); const auto r_ = __builtin_amdgcn_permlane32_swap(a_, b_, false, false); top[j] = (int)r_[0]; oth[j] = (int)r_[1]; }
            merge16_desc(top, oth);
#pragma unroll
            for (int j = 0; j < 16; ++j) { if (pp == 0) fin0[j] = top[j]; else fin1[j] = top[j]; }
        }
#pragma unroll
        for (int q = 0; q < 4; ++q) {
            *(LAS unsigned*)(slot + 4 * q) = (unsigned)(fin0[4 * q] & 127) | ((unsigned)(fin0[4 * q + 1] & 127) << 8) | ((unsigned)(fin0[4 * q + 2] & 127) << 16) | ((unsigned)(fin0[4 * q + 3] & 127) << 24);
            *(LAS unsigned*)(slot + 16 + 4 * q) = (unsigned)(fin1[4 * q] & 127) | ((unsigned)(fin1[4 * q + 1] & 127) << 8) | ((unsigned)(fin1[4 * q + 2] & 127) << 16) | ((unsigned)(fin1[4 * q + 3] & 127) << 24);
        }
        float v0[16], v1[16];
#pragma unroll
        for (int j = 0; j < 16; ++j) { v0[j] = keyf(fin0[j] & ~127); v1[j] = keyf(fin1[j] & ~127); }
#define CAND(a, b) ((fkey(v0[a] + v1[b]) & ~255) | ((a) * 16 + (b)))
        int best[16], c1[16], c2[16];
        best[0] = CAND(0, 0); best[1] = CAND(0, 1); best[2] = CAND(0, 2); best[3] = CAND(0, 3); best[4] = CAND(0, 4); best[5] = CAND(0, 5); best[6] = CAND(0, 6); best[7] = CAND(0, 7); best[8] = CAND(0, 8); best[9] = CAND(0, 9); best[10] = CAND(0, 10); best[11] = CAND(0, 11); best[12] = CAND(0, 12); best[13] = CAND(0, 13); best[14] = CAND(0, 14); best[15] = CAND(0, 15);
        c1[0] = CAND(1, 0); c1[1] = CAND(1, 1); c1[2] = CAND(1, 2); c1[3] = CAND(1, 3); c1[4] = CAND(1, 4); c1[5] = CAND(1, 5); c1[6] = CAND(1, 6); c1[7] = CAND(1, 7); c1[8] = CAND(2, 0); c1[9] = CAND(2, 1); c1[10] = CAND(2, 2); c1[11] = CAND(2, 3); c1[12] = CAND(2, 4); c1[13] = CAND(3, 0); c1[14] = CAND(3, 1); c1[15] = CAND(3, 2);
        c2[0] = CAND(3, 3); c2[1] = CAND(4, 0); c2[2] = CAND(4, 1); c2[3] = CAND(4, 2); c2[4] = CAND(5, 0); c2[5] = CAND(5, 1); c2[6] = CAND(6, 0); c2[7] = CAND(6, 1); c2[8] = CAND(7, 0); c2[9] = CAND(7, 1); c2[10] = CAND(8, 0); c2[11] = CAND(9, 0); c2[12] = CAND(10, 0); c2[13] = CAND(11, 0); c2[14] = CAND(12, 0); c2[15] = CAND(13, 0);
        sort16_desc(c1); sort16_desc(c2);
        merge16_desc(best, c1); merge16_desc(best, c2);
        KINS(best, CAND(14, 0)); KINS(best, CAND(15, 0));
#undef CAND
        float gv[16]; int eid[16];
        const float bmax = keyf(best[0] & ~255); float gsum = 0.f;
#pragma unroll
        for (int j = 0; j < 16; ++j) {
            const int ab = best[j] & 255;
            const int ia = *(const LAS unsigned char*)(slot + (ab >> 4)), ib = *(const LAS unsigned char*)(slot + 16 + (ab & 15));
            eid[j] = ia * 128 + ib;
            gv[j] = __expf(keyf(best[j] & ~255) - bmax); gsum += gv[j];
        }
        const float ginv = 1.0f / gsum;
        const size_t ob = (size_t)(tok0 + r32) * 128 + 2 * h;
        if (hh == 0) {
            int* eo = (int*)(ws + WS_EIDX) + ob;
#pragma unroll
            for (int g = 0; g < 8; ++g) *(u32x2*)(eo + g * 16) = (u32x2){(unsigned)eid[g], (unsigned)eid[g + 8]};
        } else {
            float* go = (float*)(ws + WS_EGATE) + ob;
#pragma unroll
            for (int g = 0; g < 8; ++g) *(f32x2*)(go + g * 16) = (f32x2){gv[g] * ginv, gv[g + 8] * ginv};
        }
      }
#undef PS_QROW
        __syncthreads();
    }
}

__device__ __forceinline__ void unpack16_fp8(const u32x4 w, float* d) {
    f32x2 t;
    t = __builtin_amdgcn_cvt_pk_f32_fp8((int)w.x, false); d[0] = t.x; d[1] = t.y; t = __builtin_amdgcn_cvt_pk_f32_fp8((int)w.x, true); d[2] = t.x; d[3] = t.y;
    t = __builtin_amdgcn_cvt_pk_f32_fp8((int)w.y, false); d[4] = t.x; d[5] = t.y; t = __builtin_amdgcn_cvt_pk_f32_fp8((int)w.y, true); d[6] = t.x; d[7] = t.y;
    t = __builtin_amdgcn_cvt_pk_f32_fp8((int)w.z, false); d[8] = t.x; d[9] = t.y; t = __builtin_amdgcn_cvt_pk_f32_fp8((int)w.z, true); d[10] = t.x; d[11] = t.y;
    t = __builtin_amdgcn_cvt_pk_f32_fp8((int)w.w, false); d[12] = t.x; d[13] = t.y; t = __builtin_amdgcn_cvt_pk_f32_fp8((int)w.w, true); d[14] = t.x; d[15] = t.y;
}
__device__ __forceinline__ void peer_gather(const Params& p, int layer, int dry = 0) {
    unsigned char* ws = launder(p.ws);
    const int tid = tid_(), lane = tid & 63, wave = tid >> 6;
    const int gw = bid_() * NWAVES + wave, NGW = gridDim.x * NWAVES;
    const unsigned char* EU = ws + WS_EU + (size_t)layer * 16384 * 1024; const unsigned char* EV = ws + WS_EV + (size_t)layer * 16384 * 1024;
    const float* gn = p.norm_ffn + layer * DM;
    const bool last = (layer == DEPTH - 1);
    for (int t = gw; t < NTOK; t += NGW) {
        float* xr = (float*)(ws + WS_XR) + (size_t)t * DM + 16 * lane;
        float x1[16], hh[16], acc[16];
#pragma unroll
        for (int i = 0; i < 4; ++i) { const f32x4 a = *(const f32x4*)(xr + 4 * i); x1[4 * i] = a.x; x1[4 * i + 1] = a.y; x1[4 * i + 2] = a.z; x1[4 * i + 3] = a.w; }
        const float rs = rstd2_of(ws, t);
#pragma unroll
        for (int i = 0; i < 4; ++i) { const f32x4 g = *(const f32x4*)(gn + 16 * lane + 4 * i); hh[4 * i] = x1[4 * i] * rs * g.x; hh[4 * i + 1] = x1[4 * i + 1] * rs * g.y; hh[4 * i + 2] = x1[4 * i + 2] * rs * g.z; hh[4 * i + 3] = x1[4 * i + 3] * rs * g.w; }
#pragma unroll
        for (int i = 0; i < 16; ++i) acc[i] = 0.f;
        const int* ei = (const int*)(ws + WS_EIDX) + (size_t)t * 128; const float* eg = (const float*)(ws + WS_EGATE) + (size_t)t * 128;
        for (int hd = 0; hd < 8; ++hd) {
            const int slot = (lane >> 2) & 15;
            const int e_l = ei[hd * 16 + slot]; const float g_l = eg[hd * 16 + slot];
            float part[16];
#pragma unroll
            for (int j = 0; j < 16; ++j) {
                const int e = __builtin_amdgcn_readlane(e_l, 4 * j);
                const u32x4 w0 = *(const u32x4*)(EU + (size_t)e * 1024 + 16 * lane);
                float f[16], s = 0.f;
                unpack16_fp8(w0, f);
#pragma unroll
                for (int i = 0; i < 16; ++i) s += hh[i] * f[i];
                part[j] = s;
            }
            float q8[8], q4[4], q2[2], q1;
            { const bool up = (lane & 32) != 0;
#pragma unroll
              for (int i = 0; i < 8; ++i) { const float mine = up ? part[i + 8] : part[i], theirs = up ? part[i] : part[i + 8]; q8[i] = mine + __shfl_xor(theirs, 32); } }
            { const bool up = (lane & 16) != 0;
#pragma unroll
              for (int i = 0; i < 4; ++i) { const float mine = up ? q8[i + 4] : q8[i], theirs = up ? q8[i] : q8[i + 4]; q4[i] = mine + __shfl_xor(theirs, 16); } }
            { const bool up = (lane & 8) != 0;
#pragma unroll
              for (int i = 0; i < 2; ++i) { const float mine = up ? q4[i + 2] : q4[i], theirs = up ? q4[i] : q4[i + 2]; q2[i] = mine + __shfl_xor(theirs, 8); } }
            { const bool up = (lane & 4) != 0; const float mine = up ? q2[1] : q2[0], theirs = up ? q2[0] : q2[1]; q1 = mine + __shfl_xor(theirs, 4); }
            q1 += __shfl_xor(q1, 2); q1 += __shfl_xor(q1, 1);
            q1 *= (1.0f / EU_SCALE);
            const float act = 0.5f * q1 * (1.0f + erff(q1 * 0.70710678118654752f));
            const float c_l = g_l * act;
#pragma unroll
            for (int j = 0; j < 16; ++j) {
                const int e = __builtin_amdgcn_readlane(e_l, 4 * j);
                const float c = __builtin_bit_cast(float, __builtin_amdgcn_readlane(__builtin_bit_cast(int, c_l), 4 * j));
                const u32x4 w0 = *(const u32x4*)(EV + (size_t)e * 1024 + 16 * lane);
                float f[16];
                unpack16_fp8(w0, f);
#pragma unroll
                for (int i = 0; i < 16; ++i) acc[i] += c * f[i];
            }
        }
        float s = 0.f;
#pragma unroll
        for (int i = 0; i < 16; ++i) { x1[i] += acc[i] * (1.0f / EV_SCALE); s += x1[i] * x1[i]; }
        s = wave_sum(s);
        if (dry) continue;
        if (!last) {
#pragma unroll
            for (int i = 0; i < 4; ++i) *(f32x4*)(xr + 4 * i) = (f32x4){x1[4 * i], x1[4 * i + 1], x1[4 * i + 2], x1[4 * i + 3]};
            bf16_t* xb = (bf16_t*)(ws + WS_XB) + (size_t)t * DM + 16 * lane;
            store8_bf16(xb, x1); store8_bf16(xb + 8, x1 + 8);
            if (lane == 0) ((float*)(ws + WS_SS1))[t] = s;
        } else {
            const float r = 1.0f / sqrtf(s * (1.0f / DM) + EPS);
            float* o = p.out + (size_t)t * DM + 16 * lane; const float* gf = p.norm_final + 16 * lane;
#pragma unroll
            for (int i = 0; i < 4; ++i) { const f32x4 g = *(const f32x4*)(gf + 4 * i); *(f32x4*)(o + 4 * i) = (f32x4){x1[4 * i] * r * g.x, x1[4 * i + 1] * r * g.y, x1[4 * i + 2] * r * g.z, x1[4 * i + 3] * r * g.w}; }
        }
    }
}


__device__ __forceinline__ float dot16_fp8(const u32x4 w, const float* h) {
    float f[16]; unpack16_fp8(w, f); float s = 0.f;
#pragma unroll
    for (int i = 0; i < 16; ++i) s += h[i] * f[i];
    return s;
}
__device__ __forceinline__ void gather_u(const Params& p, int layer, LAS unsigned char* lds) {
    unsigned char* ws = launder(p.ws);
    const int tid = tid_(), lane = tid & 63, wave = __builtin_amdgcn_readfirstlane(tid >> 6), sl = lane & 7, eg = lane >> 3;
    const unsigned char* EU = ws + WS_EU + (size_t)layer * 16384 * 1024;
    const unsigned sl16 = 16u * sl, eg64 = 64u * eg, pdo = (16u * eg + 2u * sl) * 2u;
    for (int unit = bid_(); unit < 256; unit += gridDim.x) {
        const int x = unit & 7, j = unit >> 3;
        unsigned char* pd = ws + WS_PD + (size_t)x * NTOK * 128 * 2;
        const int tb = 512 * j + 64 * wave;
        const unsigned char* eub = EU + (size_t)x * 16384 * 128;
        const unsigned char* eib = ws + WS_EIDX;
        const unsigned char* hqb = ws + WS_HQ + 128 * x;
        u32x4 wA[16], wB[16]; u32x4 idg, hqg; float hsg;
        LAS unsigned char* wl = lds + wave * 2048;
#define GU_GLD_IDS(t_) do { if (lane < 32) idg = *(const u32x4*)(eib + (size_t)(t_) * 512 + 16u * lane); } while (0)
#define GU_GLD_X(t_) do { if (lane < 8) hqg = *(const u32x4*)(hqb + (size_t)(t_) * DM + 16u * lane); if (lane == 0) hsg = ((const float*)(ws + WS_HS))[(size_t)(t_) * 8 + x]; } while (0)
#define GU_LST_IDS(s_) do { if (lane < 32) *(LAS u32x4*)(wl + (s_) * 512 + 16 * lane) = idg; } while (0)
#define GU_LST_X(s_) do { if (lane < 8) *(LAS u32x4*)(wl + 1024 + (s_) * 160 + 16 * lane) = hqg; if (lane == 0) *(LAS float*)(wl + 1024 + (s_) * 160 + 128) = hsg; } while (0)
#define GU_LLD_IDS(dst, s_) do { const LAS u32x4* ei_ = (const LAS u32x4*)(wl + (s_) * 512 + eg64); _Pragma("unroll") for (int i = 0; i < 4; ++i) { const u32x4 e4_ = ei_[i]; dst[4 * i] = (int)e4_.x; dst[4 * i + 1] = (int)e4_.y; dst[4 * i + 2] = (int)e4_.z; dst[4 * i + 3] = (int)e4_.w; } } while (0)
#define GU_IDS(dst, t_) do { const u32x4* ei_ = (const u32x4*)(eib + (size_t)(t_) * 512 + eg64); _Pragma("unroll") for (int i = 0; i < 4; ++i) { const u32x4 e4_ = ei_[i]; dst[4 * i] = (int)e4_.x; dst[4 * i + 1] = (int)e4_.y; dst[4 * i + 2] = (int)e4_.z; dst[4 * i + 3] = (int)e4_.w; } } while (0)
#define GU_PCS(wd, ids) do { _Pragma("unroll") for (int i = 0; i < 16; ++i) wd[i] = *(const u32x4*)(eub + (unsigned)(((unsigned)ids[i] << 7) + sl16)); } while (0)
#define GU_X(t_) do { hqn = *(const u32x4*)(hqb + (size_t)(t_) * DM + sl16); hsn = ((const float*)(ws + WS_HS))[(size_t)(t_) * 8 + x] * (1.0f / EU_SCALE); } while (0)
#define GU_TOKEN(W, WN, tt_) do { \
            const int t = tb + (tt_), tn2 = tb + ((tt_) + 2 < 64 ? (tt_) + 2 : 63), tn3 = tb + ((tt_) + 3 < 64 ? (tt_) + 3 : 63); \
              \
            int idn[16]; GU_LLD_IDS(idn, ((tt_) + 1) & 1); \
            const u32x4 hq = *(const LAS u32x4*)(wl + 1024 + ((tt_) & 1) * 160 + sl16); const float hs = *(const LAS float*)(wl + 1024 + ((tt_) & 1) * 160 + 128) * (1.0f / EU_SCALE); \
            GU_PCS(WN, idn);                  \
            GU_LST_IDS((tt_) & 1); GU_LST_X(((tt_) + 1) & 1); \
            GU_GLD_IDS(tn3); GU_GLD_X(tn2); \
            int part[16]; \
              \
            _Pragma("unroll") for (int i = 0; i < 16; ++i) { const u32x4 wp = W[i]; int a_ = __builtin_amdgcn_sdot4((int)wp.x, (int)hq.x, 0, true); a_ = __builtin_amdgcn_sdot4((int)wp.y, (int)hq.y, a_, false); \
                a_ = __builtin_amdgcn_sdot4((int)wp.z, (int)hq.z, a_, false); part[i] = __builtin_amdgcn_sdot4((int)wp.w, (int)hq.w, a_, false); } \
            int q8[8], q4[4], q2[2]; \
            { const bool up = (lane & 4) != 0; _Pragma("unroll") for (int m = 0; m < 8; ++m) { const int mine = up ? part[m + 8] : part[m]; q8[m] = mine + dpp_xor4(part[m], part[m + 8]); } } \
            { const bool up = (lane & 2) != 0; _Pragma("unroll") for (int m = 0; m < 4; ++m) { const int s1 = q8[m] + dpp_xor2(q8[m]), s2 = q8[m + 4] + dpp_xor2(q8[m + 4]); q4[m] = up ? s2 : s1; } } \
            { const bool up = (lane & 1) != 0; _Pragma("unroll") for (int m = 0; m < 2; ++m) { const int s1 = q4[m] + dpp_xor1(q4[m]), s2 = q4[m + 2] + dpp_xor1(q4[m + 2]); q2[m] = up ? s2 : s1; } } \
              \
            *(h16x2*)(pd + (size_t)t * 256 + pdo) = (h16x2){(_Float16)((float)q2[0] * hs), (_Float16)((float)q2[1] * hs)}; } while (0)
        GU_GLD_IDS(tb); GU_LST_IDS(0); GU_GLD_IDS(tb + 1); GU_LST_IDS(1); GU_GLD_X(tb); GU_LST_X(0);
        { int id0[16]; GU_LLD_IDS(id0, 0); GU_PCS(wA, id0); }
        GU_GLD_IDS(tb + 2); GU_GLD_X(tb + 1);
        for (int tt = 0; tt < 64; tt += 2) { GU_TOKEN(wA, wB, tt); GU_TOKEN(wB, wA, tt + 1); }
#undef GU_TOKEN
#undef GU_IDS
#undef GU_PCS
#undef GU_X
#undef GU_GLD_IDS
#undef GU_GLD_X
#undef GU_LST_IDS
#undef GU_LST_X
#undef GU_LLD_IDS
    }
}
__device__ __forceinline__ void gather_act(const Params& p) {
    unsigned char* ws = launder(p.ws);
    const size_t g0 = (size_t)bid_() * NTHREADS + tid_(), gs = (size_t)gridDim.x * NTHREADS;
    const h16x4* pd = (const h16x4*)(ws + WS_PD); const f32x4* gt = (const f32x4*)(ws + WS_EGATE); unsigned* c8 = (unsigned*)(ws + WS_C); float* csv = (float*)(ws + WS_CS);
    constexpr size_t N4 = (size_t)NTOK * 128 / 4;
    for (size_t i = g0; i < N4; i += gs) {
        h16x4 ph[8];
#pragma unroll
        for (int x = 0; x < 8; ++x) ph[x] = pd[i + (size_t)x * N4];
        f32x4 a = {0.f, 0.f, 0.f, 0.f};
#pragma unroll
        for (int x = 0; x < 8; ++x) { a[0] += (float)ph[x][0]; a[1] += (float)ph[x][1]; a[2] += (float)ph[x][2]; a[3] += (float)ph[x][3]; }
        const f32x4 g = gt[i]; f32x4 r;
#pragma unroll
        for (int q = 0; q < 4; ++q) { const float v = a[q]; r[q] = g[q] * (0.5f * v * (1.0f + erff(v * 0.70710678118654752f))); }
        float cam = fmaxf(fmaxf(fabsf(r[0]), fabsf(r[1])), fmaxf(fabsf(r[2]), fabsf(r[3])));
        cam = fmaxf(cam, dpp_xor1f(cam)); cam = fmaxf(cam, dpp_xor2f(cam)); cam = fmaxf(cam, dpp_xor4f(cam)); cam = fmaxf(cam, dpp_xor8f(cam)); cam = max_xor16(cam);
        const float csc = cam > 0.f ? 127.0f / cam : 0.f;
        c8[i] = pk4_i8(r[0] * csc, r[1] * csc, r[2] * csc, r[3] * csc);
        if ((i & 31) == 0) csv[i >> 5] = cam * (1.0f / (127.0f * EV_SCALE));
    }
}
__device__ __forceinline__ void gather_v(const Params& p, int layer) {
    unsigned char* ws = launder(p.ws);
    const int tid = tid_(), lane = tid & 63, wave = __builtin_amdgcn_readfirstlane(tid >> 6), sl = lane & 7, eg = lane >> 3;
    const unsigned char* EV = ws + WS_EV + (size_t)layer * 16384 * 1024;
    const bool last = (layer == DEPTH - 1);
    const unsigned sl16 = 16u * sl, eg64 = 64u * eg, eg16 = 16u * eg, eg4 = 4u * eg, xbo = 32u * sl + 4u * eg;
    for (int unit = bid_(); unit < 256; unit += gridDim.x) {
        const int x = unit & 7, j = unit >> 3;
        const int tb = 512 * j + 64 * wave;
        const unsigned char* evb = EV + (size_t)x * 16384 * 128;
        const unsigned char* eib = ws + WS_EIDX; const unsigned char* cib = ws + WS_C; const unsigned char* csb = ws + WS_CS;
        unsigned char* xbb = ws + WS_XB + 256 * x;
        u32x4 wA[16], wB[16]; int idn[16]; u32x4 cA, cB; float sA, sB; unsigned x1n;
#define GV_IDS(dst, t_) do { const u32x4* ei_ = (const u32x4*)(eib + (size_t)(t_) * 512 + eg64); _Pragma("unroll") for (int i = 0; i < 4; ++i) { const u32x4 e4_ = ei_[i]; dst[4 * i] = (int)e4_.x; dst[4 * i + 1] = (int)e4_.y; dst[4 * i + 2] = (int)e4_.z; dst[4 * i + 3] = (int)e4_.w; } } while (0)
#define GV_PCS(wd, ids, lo) do { _Pragma("unroll") for (int i = (lo); i < (lo) + 8; ++i) wd[i] = *(const u32x4*)(evb + (unsigned)(((unsigned)ids[i] << 7) + sl16)); } while (0)
#define GV_CF(cd, sd, t_) do { cd = *(const u32x4*)(cib + (size_t)(t_) * 128 + eg16); sd = *(const float*)(csb + (size_t)(t_) * 4); } while (0)
#define GV_ACC(W, lo) do { _Pragma("unroll") for (int g_ = (lo) / 4; g_ < (lo) / 4 + 2; ++g_) { \
                const u32x4 r0 = W[4 * g_], r1 = W[4 * g_ + 1], r2 = W[4 * g_ + 2], r3 = W[4 * g_ + 3]; \
                _Pragma("unroll") for (int d_ = 0; d_ < 4; ++d_) { \
                    const unsigned lo01 = __builtin_amdgcn_perm(r1[d_], r0[d_], 0x05010400u), hi01 = __builtin_amdgcn_perm(r1[d_], r0[d_], 0x07030602u); \
                    const unsigned lo23 = __builtin_amdgcn_perm(r3[d_], r2[d_], 0x05010400u), hi23 = __builtin_amdgcn_perm(r3[d_], r2[d_], 0x07030602u); \
                      \
                    acc[4 * d_ + 0] = (g_ == 0) ? __builtin_amdgcn_sdot4((int)__builtin_amdgcn_perm(lo23, lo01, 0x05040100u), cq[g_], 0, true) : __builtin_amdgcn_sdot4((int)__builtin_amdgcn_perm(lo23, lo01, 0x05040100u), cq[g_], acc[4 * d_ + 0], false); \
                    acc[4 * d_ + 1] = (g_ == 0) ? __builtin_amdgcn_sdot4((int)__builtin_amdgcn_perm(lo23, lo01, 0x07060302u), cq[g_], 0, true) : __builtin_amdgcn_sdot4((int)__builtin_amdgcn_perm(lo23, lo01, 0x07060302u), cq[g_], acc[4 * d_ + 1], false); \
                    acc[4 * d_ + 2] = (g_ == 0) ? __builtin_amdgcn_sdot4((int)__builtin_amdgcn_perm(hi23, hi01, 0x05040100u), cq[g_], 0, true) : __builtin_amdgcn_sdot4((int)__builtin_amdgcn_perm(hi23, hi01, 0x05040100u), cq[g_], acc[4 * d_ + 2], false); \
                    acc[4 * d_ + 3] = (g_ == 0) ? __builtin_amdgcn_sdot4((int)__builtin_amdgcn_perm(hi23, hi01, 0x07060302u), cq[g_], 0, true) : __builtin_amdgcn_sdot4((int)__builtin_amdgcn_perm(hi23, hi01, 0x07060302u), cq[g_], acc[4 * d_ + 3], false); } } } while (0)
#define GV_TOKEN(W, C, S, WN, CN, SN, tt_) do { \
            const int t = tb + (tt_), tn = tb + ((tt_) + 1 < 64 ? (tt_) + 1 : 63), tnn = tb + ((tt_) + 2 < 64 ? (tt_) + 2 : 63); \
            const unsigned x1 = x1n; \
            GV_PCS(WN, idn, 0);               \
            const float cs = S; int cq[4]; cq[0] = (int)C.x; cq[1] = (int)C.y; cq[2] = (int)C.z; cq[3] = (int)C.w; \
            int acc[16]; \
            _Pragma("unroll") for (int q = 0; q < 16; ++q) acc[q] = 0; \
            GV_ACC(W, 0); \
            GV_PCS(WN, idn, 8);               \
            GV_CF(CN, SN, tn); GV_IDS(idn, tnn); \
            x1n = *(const unsigned*)(xbb + (size_t)tn * (DM * 2) + xbo); \
            GV_ACC(W, 8); \
            int q8[8], q4[4]; float q2[2]; \
              \
              \
            _Pragma("unroll") for (int m = 0; m < 8; ++m) { \
                const auto r_ = __builtin_amdgcn_permlane32_swap((unsigned)acc[m], (unsigned)acc[m + 8], false, false); q8[m] = (int)r_[0] + (int)r_[1]; } \
            _Pragma("unroll") for (int m = 0; m < 4; ++m) { \
                const auto r_ = __builtin_amdgcn_permlane16_swap((unsigned)q8[m], (unsigned)q8[m + 4], false, false); q4[m] = (int)r_[0] + (int)r_[1]; } \
            { const bool up = (lane & 8) != 0; _Pragma("unroll") for (int m = 0; m < 2; ++m) { const int s1 = q4[m] + dpp_xor8(q4[m]), s2 = q4[m + 2] + dpp_xor8(q4[m + 2]); q2[m] = (float)(up ? s2 : s1) * cs; } } \
              \
            const float y0 = bflo(x1) + q2[0], y1 = bfhi(x1) + q2[1]; \
            *(unsigned*)(xbb + (size_t)t * (DM * 2) + xbo) = pk2(y0, y1); \
            const float ssq = wave_sum(y0 * y0 + y1 * y1); \
            if (lane == 0) ((float*)(ws + WS_PSS))[(size_t)t * 8 + x] = ssq; } while (0)
        GV_IDS(idn, tb);
        x1n = *(const unsigned*)(xbb + (size_t)tb * (DM * 2) + xbo);
        GV_PCS(wA, idn, 0); GV_PCS(wA, idn, 8); GV_CF(cA, sA, tb);
        GV_IDS(idn, tb + 1);
        for (int tt = 0; tt < 64; tt += 2) { GV_TOKEN(wA, cA, sA, wB, cB, sB, tt); GV_TOKEN(wB, cB, sB, wA, cA, sA, tt + 1); }
#undef GV_TOKEN
#undef GV_ACC
#undef GV_CF
#undef GV_IDS
#undef GV_PCS
    }
}
__device__ __forceinline__ void final_norm(const Params& p) {
    unsigned char* ws = launder(p.ws);
    const int tid = tid_(), lane = tid & 63, wave = tid >> 6;
    const int gw = bid_() * NWAVES + wave, NGW = gridDim.x * NWAVES;
    for (int m = gw; m < NTOK; m += NGW) {
        const f32x4 sa = *(const f32x4*)((const float*)(ws + WS_PSS) + (size_t)m * 8), sb = *(const f32x4*)((const float*)(ws + WS_PSS) + (size_t)m * 8 + 4);
        const float r = 1.0f / sqrtf((((sa.x + sa.y) + (sa.z + sa.w)) + ((sb.x + sb.y) + (sb.z + sb.w))) * (1.0f / DM) + EPS);
        const u32x2* xr = (const u32x2*)((const bf16_t*)(ws + WS_XB) + (size_t)m * DM) + lane; const f32x4* gf = (const f32x4*)p.norm_final + lane;
        f32x4* o = (f32x4*)(p.out + (size_t)m * DM) + lane;
#pragma unroll
        for (int q = 0; q < 4; ++q) { const u32x2 w = xr[64 * q]; const f32x4 g = gf[64 * q]; o[64 * q] = (f32x4){bflo(w.x) * r * g.x, bfhi(w.x) * r * g.y, bflo(w.y) * r * g.z, bfhi(w.y) * r * g.w}; }
    }
}

namespace pg8 {
#define PG8_LAS __attribute__((address_space(3)))
constexpr int BM = 256, BK = 64, HALF = 128, HTB = HALF * BK * 2, STAGE_BYTES = 8 * HTB, NXCD = 8, WGM = 8;
__host__ __device__ __forceinline__ int lds_byte(int r, int c) { const int st = (r >> 4) * 2 + (c >> 5), rr = r & 15, cc = c & 31, ob = rr * 64 + cc * 2; return st * 1024 + (ob ^ (((ob >> 9) & 1) << 5)); }
__host__ __device__ __forceinline__ void stage_rc(int b, int& R, int& C) { const int st = b / 1024, sb = b % 1024, swz = sb ^ (((sb >> 9) & 1) << 5); R = (st >> 1) * 16 + swz / 64; C = (st & 1) * 32 + (swz % 64) / 2; }
__host__ __device__ __forceinline__ int perm32(int rho) { const int n = rho >> 4, i = rho & 15; return 8 * (i >> 2) + 4 * n + (i & 3); }
struct Unit { int pm, pn, idx; };
typedef ::Gemm Gemm;
struct StaticOrder {
    int nM, nN, nwg, G, c;
    __host__ __device__ void init(int M, int N, int G_, int c_) { nM = M / BM; nN = N / BM; nwg = nM * nN; G = G_; c = c_; }
    __host__ __device__ bool next(int i, Unit& u) const {
        const long L = (long)i * G + c; if (L >= nwg) return false;
        int wgid = (int)L; { const int q = nwg / NXCD, r = nwg % NXCD, xcd = wgid % NXCD, off = wgid / NXCD; wgid = (xcd < r ? xcd * (q + 1) : r * (q + 1) + (xcd - r) * q) + off; }
        const int nig = WGM * nN, gid = wgid / nig, fm = gid * WGM, gsz = (nM - fm) < WGM ? (nM - fm) : WGM;
        u.pm = fm + ((wgid % nig) % gsz); u.pn = (wgid % nig) / gsz; u.idx = i; return true;
    }
    __device__ __forceinline__ void a_ready(const Unit&) const {}
    __device__ __forceinline__ void done(const Unit&) const {}
};
constexpr int RS_TAB_OFF = 131072 + 1024, RS_MAX_UNITS = 8;
template <class Epi> struct EpiAdapt {
    static constexpr bool PERM = true, AFTER_DRAIN = false;
    const Epi& e; PG8_LAS unsigned char* lds0;
    __device__ __forceinline__ void operator()(const f32x4 (&acc)[2][2][4][2], const Unit& u, int wr, int wc, int fr, int fq) const {
        const PG8_LAS float* rst = (const PG8_LAS float*)(lds0 + RS_TAB_OFF) + (u.idx & (RS_MAX_UNITS - 1)) * 256;
        const bool resid = (e.kind == 3);
        u32x4 rcur[2], rnxt[2];
        const int col0 = u.pn * BM + wc * 32 + 8 * fq;
#define EA_LOADRES(dst, g_) do { const GAS bf16_t* rr_ = (const GAS bf16_t*)e.aux + (size_t)(u.pm * BM + ((g_) >> 2) * HALF + wr * 64 + ((g_) & 3) * 16 + fr) * DM + col0; \
            dst[0] = *(const GAS u32x4*)rr_; dst[1] = *(const GAS u32x4*)(rr_ + HALF); } while (0)
        if (resid) EA_LOADRES(rcur, 0);
#pragma unroll
        for (int g = 0; g < 8; ++g) {
            const int ai = g >> 2, m = g & 3;
            const int rl = ai * HALF + wr * 64 + m * 16 + fr, row = u.pm * BM + rl;
            if (resid && g < 7) EA_LOADRES(rnxt, g + 1);
            const float rs = rst[rl];
            float v[2][8];
#pragma unroll
            for (int bj = 0; bj < 2; ++bj) { const f32x4 a = acc[ai][bj][m][0], b = acc[ai][bj][m][1]; v[bj][0] = a[0]; v[bj][1] = a[1]; v[bj][2] = a[2]; v[bj][3] = a[3]; v[bj][4] = b[0]; v[bj][5] = b[1]; v[bj][6] = b[2]; v[bj][7] = b[3]; }
            if (resid) {
#pragma unroll
                for (int bj = 0; bj < 2; ++bj) { float r8[8]; unpack8(rcur[bj], r8);
#pragma unroll
                    for (int e_ = 0; e_ < 8; ++e_) v[bj][e_] += r8[e_]; }
            }
            e.row16(row, u.pn, wc, fq, v, rs);
            asm volatile("" ::: "memory");
            if (resid && g < 7) { rcur[0] = rnxt[0]; rcur[1] = rnxt[1]; }
        }
#undef EA_LOADRES
    }
};
template <class Epi, class Sched, bool ALIGN_EPI = false, bool SP2 = false>
__device__ __forceinline__ void gemm_phase(PG8_LAS unsigned char* lds, const Gemm g, const Sched& S, const Epi& E) {
    const int tid = tid_(), wid = __builtin_amdgcn_readfirstlane(tid >> 6), lane = tid & 63, wr = wid >> 2, wc = wid & 3, fr = lane & 15, fq = lane >> 4;
    const int K = g.K, nt = K / BK; const int lda = g.lda, ldb = g.ldb;
    unsigned voffA[2], voffB[2];
#pragma unroll
    for (int i = 0; i < 2; ++i) { int R, C; stage_rc(tid * 16 + i * 8192, R, C); const int Rb = Epi::PERM ? ((R & ~31) + perm32(R & 31)) : R;
        voffA[i] = (unsigned)(R * lda + C) * 2u; voffB[i] = (unsigned)(Rb * ldb + C) * 2u; }
    const size_t kstep = (size_t)(BK * 2);
    const size_t hstepA = (size_t)HALF * lda * 2, hstepB = (size_t)HALF * ldb * 2;
    const size_t tstepA = 2 * hstepA, tstepB = 2 * hstepB;
    const unsigned ldsw = (unsigned)wid * 1024u;
    const int aoff = lds_byte(wr * 64 + fr, fq * 8), boff = lds_byte(wc * 32 + fr, fq * 8);
#define PG8_SA(b, h) (((b) * 2 + (h)) * HTB)
#define PG8_SB(b, h) ((4 + (b) * 2 + (h)) * HTB)
#define PG8_STAGE(bufoff, gbase, voff) do { _Pragma("unroll") for (int _i = 0; _i < 2; ++_i) \
        __builtin_amdgcn_global_load_lds((const unsigned*)((const char*)(gbase) + (voff)[_i]), (PG8_LAS unsigned*)(lds + (bufoff) + ldsw + _i * 8192), 16, 0, 0); } while (0)
#define PG8_LDA(dst, b, h) do { _Pragma("unroll") for (int m = 0; m < 4; ++m) _Pragma("unroll") for (int k = 0; k < 2; ++k) dst[m][k] = *(const PG8_LAS bf16x8*)(lds + PG8_SA(b, h) + aoff + m * 2048 + k * 1024); } while (0)
#define PG8_LDB(dst, b, h) do { _Pragma("unroll") for (int n = 0; n < 2; ++n) _Pragma("unroll") for (int k = 0; k < 2; ++k) dst[n][k] = *(const PG8_LAS bf16x8*)(lds + PG8_SB(b, h) + boff + n * 2048 + k * 1024); } while (0)
#define PG8_MMA(ai, bj, At, Bt) do { __builtin_amdgcn_s_setprio(1); _Pragma("unroll") for (int m = 0; m < 4; ++m) _Pragma("unroll") for (int n = 0; n < 2; ++n) _Pragma("unroll") for (int k = 0; k < 2; ++k) \
        acc[ai][bj][m][n] = __builtin_amdgcn_mfma_f32_16x16x32_bf16(Bt[n][k], At[m][k], acc[ai][bj][m][n], 0, 0, 0); __builtin_amdgcn_s_setprio(0); } while (0)
#define PG8_WAIT_V(n) asm volatile("s_waitcnt vmcnt(" #n ")" ::: "memory")
#define PG8_WAIT_L(n) asm volatile("s_waitcnt lgkmcnt(" #n ")" ::: "memory")
#define PG8_BAR __builtin_amdgcn_s_barrier()
#define PG8_SCHED __builtin_amdgcn_sched_barrier(0)
    Unit cur, nxt; int ui = 0;
    if (!S.next(0, cur)) return;
    float zero_ = 0.f; asm volatile("" : "+v"(zero_));
    f32x4 acc[2][2][4][2];
#pragma unroll
    for (int a = 0; a < 2; ++a)
#pragma unroll
        for (int b = 0; b < 2; ++b)
#pragma unroll
            for (int m = 0; m < 4; ++m)
#pragma unroll
                for (int n = 0; n < 2; ++n) acc[a][b][m][n] = (f32x4){zero_, zero_, zero_, zero_};
    bf16x8 At[4][2], B0[2][2], B1[2][2];
    const char* cA = (const char*)g.A + (size_t)cur.pm * tstepA; const char* cB = (const char*)g.Bt + (size_t)cur.pn * tstepB;
    S.a_ready(cur);
    if constexpr (SP2) {
        PG8_STAGE(PG8_SB(0, 0), cB, voffB); PG8_STAGE(PG8_SB(0, 1), cB + hstepB, voffB); PG8_STAGE(PG8_SA(0, 0), cA, voffA); PG8_STAGE(PG8_SA(0, 1), cA + hstepA, voffA);
        if (wr == 1) PG8_BAR;
        PG8_WAIT_V(2); PG8_BAR;
        PG8_STAGE(PG8_SB(1, 0), cB + kstep, voffB); PG8_STAGE(PG8_SA(1, 0), cA + kstep, voffA); PG8_STAGE(PG8_SB(1, 1), cB + hstepB + kstep, voffB);
        PG8_WAIT_V(6); PG8_BAR;
    } else {
        PG8_STAGE(PG8_SB(0, 0), cB, voffB); PG8_STAGE(PG8_SA(0, 0), cA, voffA); PG8_STAGE(PG8_SB(0, 1), cB + hstepB, voffB); PG8_STAGE(PG8_SA(0, 1), cA + hstepA, voffA);
        if (wr == 1) PG8_BAR;
        PG8_WAIT_V(4); PG8_BAR;
        PG8_STAGE(PG8_SB(1, 0), cB + kstep, voffB); PG8_STAGE(PG8_SA(1, 0), cA + kstep, voffA); PG8_STAGE(PG8_SB(1, 1), cB + hstepB + kstep, voffB);
        PG8_WAIT_V(6); PG8_BAR;
    }
    for (;;) {
        const bool has_next = S.next(ui + 1, nxt);
        const char* nA = has_next ? (const char*)g.A + (size_t)nxt.pm * tstepA : cA; const char* nB = has_next ? (const char*)g.Bt + (size_t)nxt.pn * tstepB : cB;
        for (int t = 0; t < nt; t += 2) {
            const bool last = (t == nt - 2);
            const char* a1 = cA + (size_t)(t + 1) * kstep;
            const char* a2 = last ? nA : cA + (size_t)(t + 2) * kstep; const char* b2 = last ? nB : cB + (size_t)(t + 2) * kstep;
            const char* a3 = a2 + kstep; const char* b3 = b2 + kstep;
            if (last && has_next) S.a_ready(nxt);
            if constexpr (SP2) {
            PG8_LDB(B0, 0, 0); PG8_LDB(B1, 0, 1); PG8_SCHED; PG8_LDA(At, 0, 0); PG8_STAGE(PG8_SA(1, 1), a1 + hstepA, voffA);
            PG8_WAIT_V(8); PG8_WAIT_L(0); PG8_BAR; PG8_MMA(0, 0, At, B0); PG8_MMA(0, 1, At, B1); PG8_BAR; PG8_SCHED;
            PG8_LDA(At, 0, 1); PG8_STAGE(PG8_SB(0, 0), b2, voffB); PG8_STAGE(PG8_SB(0, 1), b2 + hstepB, voffB); PG8_STAGE(PG8_SA(0, 0), a2, voffA);
            PG8_WAIT_V(8); PG8_WAIT_L(0); PG8_BAR; PG8_MMA(1, 0, At, B0); PG8_MMA(1, 1, At, B1); PG8_BAR; PG8_SCHED;
            PG8_LDB(B0, 1, 0); PG8_LDB(B1, 1, 1); PG8_SCHED; PG8_LDA(At, 1, 0); PG8_STAGE(PG8_SA(0, 1), a2 + hstepA, voffA);
            PG8_WAIT_V(8); PG8_WAIT_L(0); PG8_BAR; PG8_MMA(0, 0, At, B0); PG8_MMA(0, 1, At, B1); PG8_BAR; PG8_SCHED;
            PG8_LDA(At, 1, 1); PG8_STAGE(PG8_SB(1, 0), b3, voffB); PG8_STAGE(PG8_SB(1, 1), b3 + hstepB, voffB); PG8_STAGE(PG8_SA(1, 0), a3, voffA);
            PG8_WAIT_V(8); PG8_WAIT_L(0); PG8_BAR; PG8_MMA(1, 0, At, B0); PG8_MMA(1, 1, At, B1); PG8_BAR; PG8_SCHED;
            } else {
            PG8_LDB(B0, 0, 0); PG8_SCHED; PG8_LDA(At, 0, 0); PG8_STAGE(PG8_SA(1, 1), a1 + hstepA, voffA);
            PG8_WAIT_L(8); PG8_BAR; PG8_WAIT_L(0); PG8_MMA(0, 0, At, B0); PG8_BAR; PG8_SCHED;
            PG8_LDB(B1, 0, 1); PG8_STAGE(PG8_SB(0, 0), b2, voffB);
            PG8_BAR; PG8_WAIT_L(0); PG8_MMA(0, 1, At, B1); PG8_BAR;
            PG8_LDA(At, 0, 1); PG8_STAGE(PG8_SA(0, 0), a2, voffA);
            PG8_BAR; PG8_WAIT_L(0); PG8_MMA(1, 0, At, B0); PG8_BAR; PG8_SCHED;
            PG8_STAGE(PG8_SB(0, 1), b2 + hstepB, voffB);
            PG8_WAIT_V(6); PG8_BAR; PG8_MMA(1, 1, At, B1); PG8_BAR;
            PG8_LDB(B0, 1, 0); PG8_SCHED; PG8_LDA(At, 1, 0); PG8_STAGE(PG8_SA(0, 1), a2 + hstepA, voffA);
            PG8_WAIT_L(8); PG8_BAR; PG8_WAIT_L(0); PG8_MMA(0, 0, At, B0); PG8_BAR; PG8_SCHED;
            PG8_LDB(B1, 1, 1); PG8_STAGE(PG8_SB(1, 0), b3, voffB);
            PG8_BAR; PG8_WAIT_L(0); PG8_MMA(0, 1, At, B1); PG8_BAR;
            PG8_LDA(At, 1, 1); PG8_STAGE(PG8_SA(1, 0), a3, voffA);
            PG8_BAR; PG8_WAIT_L(0); PG8_MMA(1, 0, At, B0); PG8_BAR; PG8_SCHED;
            PG8_STAGE(PG8_SB(1, 1), b3 + hstepB, voffB);
            PG8_WAIT_V(6); PG8_BAR; PG8_MMA(1, 1, At, B1); PG8_BAR;
            }
        }
        if constexpr (ALIGN_EPI) { if (wr == 0) PG8_BAR; }
        if constexpr (!Epi::AFTER_DRAIN) { E(acc, cur, wr, wc, fr, fq); S.done(cur); }
        if (!has_next) break;
#pragma unroll
        for (int a = 0; a < 2; ++a)
#pragma unroll
            for (int b = 0; b < 2; ++b)
#pragma unroll
                for (int m = 0; m < 4; ++m)
#pragma unroll
                    for (int n = 0; n < 2; ++n) acc[a][b][m][n] = (f32x4){zero_, zero_, zero_, zero_};
        cur = nxt; cA = nA; cB = nB; ++ui;
        if constexpr (ALIGN_EPI) { if (wr == 1) PG8_BAR; }
    }
    PG8_WAIT_V(0);
    if constexpr (!ALIGN_EPI) { if (wr == 0) PG8_BAR; }
    PG8_BAR;
    if constexpr (Epi::AFTER_DRAIN) { E.fused(acc, cur, wr, wc, fr, fq, lds, wid, lane); S.done(cur); }
#undef PG8_SA
#undef PG8_SB
#undef PG8_STAGE
#undef PG8_LDA
#undef PG8_LDB
#undef PG8_MMA
#undef PG8_WAIT_V
#undef PG8_WAIT_L
#undef PG8_BAR
#undef PG8_SCHED
}
}

template <class Epi> __device__ __forceinline__ void run_gemm(LAS unsigned char* lds, const Gemm g, int c0, int G, const Epi& E) {
#if USE_MFMA_GEMM
    pg8::StaticOrder S; S.init(g.M, g.N, G, c0);
    {
        const int tid = tid_(); pg8::Unit u;
        if (tid < 256) { for (int i = 0; i < pg8::RS_MAX_UNITS && S.next(i, u); ++i) ((LAS float*)(lds + pg8::RS_TAB_OFF))[i * 256 + tid] = E.row_scale(u.pm * 256 + tid); }
        __syncthreads();
    }
    pg8::EpiAdapt<Epi> EA{E, lds};
    pg8::gemm_phase<pg8::EpiAdapt<Epi>, pg8::StaticOrder, true, true>(lds, g, S, EA);
#else
    gemm_naive<Epi>(g, c0, G, E);
#endif
}

__device__ __forceinline__ void hquant_rows(unsigned char* ws, const float* gain) {
    const int tid = tid_(), lane = tid & 63, wave = tid >> 6;
    const int gw = bid_() * NWAVES + wave, NGW = gridDim.x * NWAVES;
    f32x4 gv[4];
#pragma unroll
    for (int q = 0; q < 4; ++q) gv[q] = *(const GAS f32x4*)((const GAS float*)gain + 16 * lane + 4 * q);
    for (int m = gw; m < NTOK; m += NGW) {
        const u32x4* xr = (const u32x4*)((const bf16_t*)(ws + WS_XB) + (size_t)m * DM + 16 * lane);
        const float rs = rstd2_of(ws, m);
        float h[16]; float am = 0.f;
        { const u32x4 w0 = xr[0], w1 = xr[1]; unpack8(w0, h); unpack8(w1, h + 8); }
#pragma unroll
        for (int q = 0; q < 4; ++q) { const f32x4 g = gv[q]; h[4 * q] *= rs * g.x; h[4 * q + 1] *= rs * g.y; h[4 * q + 2] *= rs * g.z; h[4 * q + 3] *= rs * g.w; }
#pragma unroll
        for (int i = 0; i < 16; ++i) am = fmaxf(am, fabsf(h[i]));
        am = fmaxf(am, dpp_xor1f(am)); am = fmaxf(am, dpp_xor2f(am)); am = fmaxf(am, dpp_xor4f(am));
        const float sc = am > 0.f ? 127.0f / am : 0.f;
        u32x4 o; o.x = pk4_i8(h[0] * sc, h[1] * sc, h[2] * sc, h[3] * sc); o.y = pk4_i8(h[4] * sc, h[5] * sc, h[6] * sc, h[7] * sc); o.z = pk4_i8(h[8] * sc, h[9] * sc, h[10] * sc, h[11] * sc); o.w = pk4_i8(h[12] * sc, h[13] * sc, h[14] * sc, h[15] * sc);
        *(u32x4*)(ws + WS_HQ + (size_t)m * DM + 16 * lane) = o;
        if ((lane & 7) == 0) ((float*)(ws + WS_HS))[(size_t)m * 8 + (lane >> 3)] = am * (1.0f / 127.0f);
    }
}
__device__ __forceinline__ void gemm_phase_any(const Params& p, int sub, int layer, LAS unsigned char* lds) {
    unsigned char* ws = launder(p.ws);
    const int G = gridDim.x, bx = bid_();
    Gemm g; EpiAll E; E.ws = ws; E.aux = nullptr; int c0 = bx, Gs = G;
    g.M = NTOK;
    if (sub == 0) { g.A = (const bf16_t*)(ws + WS_XB); g.Bt = (const bf16_t*)(ws + WS_WIN) + (size_t)layer * DINP * DM; g.N = DINP; g.K = DM; E.kind = 0; E.aux = p.b_forget + layer * 4; }
    else if (sub == 1) {
        if (bx < 16) fcum_scan(ws, bx, tid_(), lds);
        const int G1 = G / 2; const bool first = bx < G1;
        g.A = first ? (const bf16_t*)(ws + WS_CQ) : (const bf16_t*)(ws + WS_CKV);
        g.Bt = first ? (const bf16_t*)(ws + WS_WUQ) + (size_t)layer * 512 * 256 : (const bf16_t*)(ws + WS_WUKV) + (size_t)layer * 512 * 128;
        g.N = 512; g.K = first ? 256 : 128; E.kind = first ? 1 : 2; c0 = first ? bx : bx - G1; Gs = first ? G1 : G - G1;
    }
    else if (sub == 3) { g.A = (const bf16_t*)(ws + WS_Y); g.Bt = (const bf16_t*)(ws + WS_WOUT) + (size_t)layer * DM * DM; g.N = DM; g.K = DM; E.kind = 3; E.aux = (const float*)(ws + WS_XB); }
    else { hquant_rows(ws, p.norm_ffn + layer * DM); g.A = (const bf16_t*)(ws + WS_XB); g.Bt = (const bf16_t*)(ws + WS_WQ) + (size_t)layer * 2048 * DM; g.N = 2048; g.K = DM; E.kind = 4; }
    g.lda = g.K; g.ldb = g.K;
    run_gemm(lds, g, c0, Gs, E);
    if (sub == 1) mixers_mfma<0>(p, ws, layer, lds);
}
template <int SUB>
__device__ __forceinline__ void run_phase(const Params& p, int layer, LAS unsigned char* lds) {
    unsigned char* ws = launder(p.ws);
    if constexpr (SUB == -1) { phase_prologue(p, lds); }
    else if constexpr (SUB == 0 || SUB == 1 || SUB == 3 || SUB == 4) { gemm_phase_any(p, SUB, layer, lds); }
    else if constexpr (SUB == 2) {
#if NAIVE_MIX || MIX_DEBUG
        mixers_naive(ws);
#else
        mixers_mfma<1>(p, ws, layer, lds);
#endif
    }
    else if constexpr (SUB == 17) { mixers_mfma<0>(p, ws, layer, lds); mixers_mfma<1>(p, ws, layer, lds); }
    else if constexpr (SUB == 5) {
#if NAIVE_SCORE
        peer_score_naive(ws, layer);
#else
        peer_score_mfma(ws, layer, lds);
#endif
    }
    else if constexpr (SUB == 6) { gather_u(p, layer, lds); }
    else if constexpr (SUB == 7) { gather_act(p); }
    else if constexpr (SUB == 8) { gather_v(p, layer); }
    else if constexpr (SUB == 9) { final_norm(p); }
}
template <int SUB>
__global__ void __launch_bounds__(NTHREADS, 2) phase_kernel(Params p, int layer) {
    extern __shared__ __attribute__((aligned(16))) unsigned char lds_raw[];
    run_phase<SUB>(p, layer, (LAS unsigned char*)lds_raw);
}


typedef GAS unsigned gu32;
#define XB_TMO      128
#define XB_XCNT(j)  (256  + 64 * (j))
#define XB_XSUB(j)  (1280 + 64 * (j))
#define XB_XGEN(j)  (2304 + 64 * (j))
#define XB_TOP      3328
#define XB_TOPGEN   3392
#define XCD_BAR_WORDS 3456
#define XB_SPIN_CAP (1u << 18)

__device__ __forceinline__ unsigned xb_ld(unsigned* p)              { return __hip_atomic_load(p, __ATOMIC_RELAXED, __HIP_MEMORY_SCOPE_AGENT); }
__device__ __forceinline__ unsigned xb_add(unsigned* p, unsigned v) { return __hip_atomic_fetch_add(p, v, __ATOMIC_RELAXED, __HIP_MEMORY_SCOPE_AGENT); }
__device__ __forceinline__ unsigned xb_xcc_id() { return (unsigned)__builtin_amdgcn_s_getreg((3 << 11) | 20) & 0xFu; }
#define XB_SPIN(cond, bar) do { unsigned _sp = 0; while (cond) { __builtin_amdgcn_s_sleep(1); \
    if ((++_sp & 255u) == 0u) { if (xb_ld(&(bar)[XB_TMO])) break; if (_sp > XB_SPIN_CAP) { atomicAdd(&(bar)[XB_TMO], 1u); break; } } } } while (0)

struct XcdBarrier {
    unsigned* bar; unsigned x;
    volatile LAS unsigned* st;
};

__device__ __forceinline__ XcdBarrier xcd_barrier_post(unsigned* bar, volatile LAS unsigned* st) {
    XcdBarrier b; b.bar = bar; b.x = xb_xcc_id(); b.st = st;
    if (threadIdx.x == 0) (void)xb_add(&bar[XB_XCNT(b.x)], 1u);
    return b;
}
__device__ __forceinline__ void xcd_barrier_complete(unsigned* bar, unsigned x, unsigned& nloc, unsigned& nx) {
    const unsigned G = gridDim.x * gridDim.y * gridDim.z;
    unsigned sum, cnt, mine, sp = 0u;
    for (;;) {
        sum = 0u; cnt = 0u; mine = 0u;
#pragma unroll
        for (unsigned j = 0; j < 16; ++j) { const unsigned c = xb_ld(&bar[XB_XCNT(j)]); sum += c; cnt += (c > 0u) ? 1u : 0u; mine = (j == x) ? c : mine; }
        if (sum == G) break;
        __builtin_amdgcn_s_sleep(1);
        if ((++sp & 255u) == 0u) { if (xb_ld(&bar[XB_TMO])) break; if (sp > XB_SPIN_CAP) { atomicAdd(&bar[XB_TMO], 1u); break; } }
    }
    nloc = mine > 0u ? mine : 1u; nx = cnt > 0u ? cnt : 1u;
}

__device__ __forceinline__ void xcd_barrier(const XcdBarrier& b) {
    asm volatile("s_waitcnt vmcnt(0)" ::: "memory");
    __syncthreads();
    if (threadIdx.x == 0) {
        unsigned* bar = b.bar;
        __builtin_amdgcn_s_waitcnt(0);
        unsigned nloc = b.st[0], nx = b.st[1];
        if (nloc == 0u) { xcd_barrier_complete(bar, b.x, nloc, nx); b.st[0] = nloc; b.st[1] = nx; }
        const unsigned old = xb_add(&bar[XB_XSUB(b.x)], 1u);
        const unsigned gen = old / nloc;
        if (old + 1u == (gen + 1u) * nloc) {
            __builtin_amdgcn_fence(__ATOMIC_RELEASE, "agent");
            asm volatile("s_waitcnt vmcnt(0)" ::: "memory");
            const unsigned og = xb_add(&bar[XB_TOP], 1u);
            const unsigned tg = og / nx;
            if (og + 1u == (tg + 1u) * nx) xb_add(&bar[XB_TOPGEN], 1u);
            else XB_SPIN(xb_ld(&bar[XB_TOPGEN]) == tg, bar);
            __builtin_amdgcn_fence(__ATOMIC_ACQUIRE, "agent");
            xb_add(&bar[XB_XGEN(b.x)], 1u);
            asm volatile("s_waitcnt vmcnt(0)" ::: "memory");
        } else {
            XB_SPIN(xb_ld(&bar[XB_XGEN(b.x)]) == gen, bar);
            __builtin_amdgcn_fence(__ATOMIC_ACQUIRE, "agent");
            asm volatile("s_waitcnt vmcnt(0)" ::: "memory");
        }
    }
    __syncthreads();
}


template <int PH>
__device__ __forceinline__ void one_phase(const Params& p, LAS unsigned char* lds) {
#if defined(__HIP_DEVICE_COMPILE__)
    typedef const __attribute__((address_space(4))) Params* KP;
    KP kp = (KP)__builtin_amdgcn_kernarg_segment_ptr(); asm volatile("" : "+s"(kp));
    Params q;
    { const __attribute__((address_space(4))) unsigned long long* src = (const __attribute__((address_space(4))) unsigned long long*)kp; unsigned long long* dst = (unsigned long long*)&q;
#pragma unroll
      for (int i = 0; i < (int)(sizeof(Params) / 8); ++i) dst[i] = src[i]; }
#else
    const Params q = p;
#endif
    if (!(q.ph_lo <= PH && PH < q.ph_hi)) return;
    if constexpr (PH == 0) run_phase<-1>(q, 0, lds);
    else if constexpr (PH == NPH - 1) run_phase<9>(q, 0, lds);
    else {
        constexpr int layer = (PH - 1) / NSUB, sub = (PH - 1) % NSUB;
        if constexpr (sub == 0 || sub == 1 || sub == 3 || sub == 4) gemm_phase_any(q, sub, layer, lds);
        else if constexpr (sub == 2) { if (!NAIVE_MIX && !MIX_DEBUG) run_phase<2>(q, layer, lds); }
        else if constexpr (sub == 5) { if (!NAIVE_SCORE) run_phase<5>(q, layer, lds); }
        else if constexpr (sub == 6) run_phase<6>(q, layer, lds);
        else if constexpr (sub == 7) run_phase<7>(q, layer, lds);
        else run_phase<8>(q, layer, lds);
    }
    if (PH + 1 < q.ph_hi) { XcdBarrier xb; xb.bar = (unsigned*)(launder(q.ws) + WS_CTL) + CW_BAR; xb.x = xb_xcc_id(); xb.st = (volatile LAS unsigned*)(lds + 131072 + 320) + 8; xcd_barrier(xb); }
}
__global__ void __launch_bounds__(NTHREADS, 2) fwd_kernel(Params p) {
    extern __shared__ __attribute__((aligned(16))) unsigned char lds_raw[];
    LAS unsigned char* lds = (LAS unsigned char*)lds_raw;
    volatile LAS unsigned* misc = (volatile LAS unsigned*)(lds + 131072 + 320);
    if (threadIdx.x < 32) misc[threadIdx.x] = 0u;
    __syncthreads();
    (void)xcd_barrier_post((unsigned*)(p.ws + WS_CTL) + CW_BAR, misc + 8);
    one_phase<0>(p, lds); one_phase<1>(p, lds); one_phase<2>(p, lds); one_phase<3>(p, lds); one_phase<4>(p, lds);
    one_phase<5>(p, lds); one_phase<6>(p, lds); one_phase<7>(p, lds); one_phase<8>(p, lds); one_phase<9>(p, lds);
    one_phase<10>(p, lds); one_phase<11>(p, lds); one_phase<12>(p, lds); one_phase<13>(p, lds); one_phase<14>(p, lds);
    one_phase<15>(p, lds); one_phase<16>(p, lds); one_phase<17>(p, lds); one_phase<18>(p, lds); one_phase<19>(p, lds);
    static_assert(NPH == 20, "phase list above");
}

constexpr int LDS_BYTES = 147456;

template <int SUB> static void launch_phase(const Params& p, int layer, int grid, hipStream_t stream) {
    static bool attr = false;
    if (!attr) { (void)hipFuncSetAttribute((const void*)phase_kernel<SUB>, hipFuncAttributeMaxDynamicSharedMemorySize, LDS_BYTES); attr = true; }
    hipLaunchKernelGGL(phase_kernel<SUB>, dim3(grid), dim3(NTHREADS), LDS_BYTES, stream, p, layer);
}
extern "C" void kernel_launch(void* const* d_in, const int* in_sizes, int n_in, void* d_out, int out_size, void* d_ws, size_t ws_size, hipStream_t stream) {
    static int grid = 0;
    if (grid == 0) {
        if (n_in != 16 || out_size != NTOK * DM || ws_size < WS_END) { fprintf(stderr, "kernel_launch: unexpected sizes (n_in %d out %d ws %zu)\n", n_in, out_size, ws_size); grid = -1; return; }
        int dev = 0, cus = 0, per_cu = 0;
        (void)hipGetDevice(&dev); (void)hipDeviceGetAttribute(&cus, hipDeviceAttributeMultiprocessorCount, dev);
        (void)hipFuncSetAttribute((const void*)fwd_kernel, hipFuncAttributeMaxDynamicSharedMemorySize, LDS_BYTES);
        if (hipOccupancyMaxActiveBlocksPerMultiprocessor(&per_cu, (const void*)fwd_kernel, NTHREADS, LDS_BYTES) != hipSuccess || per_cu < 1) { fprintf(stderr, "kernel_launch: occupancy query reports %d blocks per CU for the fused kernel\n", per_cu); per_cu = 1; }
        (void)hipGetLastError();
        grid = (cus > 0 ? cus : 256) * (per_cu < 1 ? per_cu : 1);
    }
    if (grid < 0) return;
    (void)hipMemsetAsync((char*)d_ws + WS_CTL, 0, CTL_BYTES, stream);
    Params p{};
    p.x = (const float*)d_in[0]; p.norm_mix = (const float*)d_in[1]; p.w_in = (const float*)d_in[2]; p.b_forget = (const float*)d_in[3]; p.norm_cq = (const float*)d_in[4]; p.norm_ckv = (const float*)d_in[5];
    p.w_uq = (const float*)d_in[6]; p.w_ukv = (const float*)d_in[7]; p.head_gain = (const float*)d_in[8]; p.w_out = (const float*)d_in[9]; p.norm_ffn = (const float*)d_in[10]; p.w_query = (const float*)d_in[11];
    p.sub_keys = (const float*)d_in[12]; p.expert_u = (const float*)d_in[13]; p.expert_v = (const float*)d_in[14]; p.norm_final = (const float*)d_in[15];
    p.out = (float*)d_out; p.ws = (unsigned char*)d_ws;
    static bool attr = false;
    if (!attr) { (void)hipFuncSetAttribute((const void*)fwd_kernel, hipFuncAttributeMaxDynamicSharedMemorySize, LDS_BYTES); attr = true; }
    int ph = 0;
    while (ph < NPH) {
        const int sub = (ph == 0 || ph == NPH - 1) ? -1 : (ph - 1) % NSUB, layer = (ph == 0 || ph == NPH - 1) ? 0 : (ph - 1) / NSUB;
        if ((NAIVE_MIX || MIX_DEBUG) && sub == 2) { launch_phase<2>(p, layer, grid, stream); if (MIX_DEBUG) launch_phase<17>(p, layer, grid, stream); ++ph; continue; }
        if (NAIVE_SCORE && sub == 5) { launch_phase<5>(p, layer, grid, stream); ++ph; continue; }
        int hi = ph + 1;
        while (hi < NPH) { const int s2 = (hi == NPH - 1) ? -1 : (hi - 1) % NSUB; if (((NAIVE_MIX || MIX_DEBUG) && s2 == 2) || (NAIVE_SCORE && s2 == 5)) break; ++hi; }
        p.ph_lo = ph; p.ph_hi = hi;
        void* args[] = {&p};
        hipError_t e = hipLaunchCooperativeKernel((const void*)fwd_kernel, dim3(grid), dim3(NTHREADS), args, LDS_BYTES, stream);
        if (e != hipSuccess) fprintf(stderr, "cooperative launch failed: %s (grid %d, phases %d..%d)\n", hipGetErrorString(e), grid, ph, hi);
        ph = hi;
    }
}
```

```cpp
#include <hip/hip_runtime.h>
#include <hip/hip_cooperative_groups.h>
#include <cstdio>
#include <cstdint>
namespace cg = cooperative_groups;

#ifndef MK_N_LAUNCHES
#define MK_N_LAUNCHES 15
#endif
#ifndef NAIVE_MIX
#define NAIVE_MIX 0
#endif
#ifndef NAIVE_SCORE
#define NAIVE_SCORE 0
#endif
#ifndef MIX_KIND_MASK
#define MIX_KIND_MASK 15
#endif
#ifndef MIX_DEBUG
#define MIX_DEBUG 0
#endif
#ifndef REP_KMASK
#define REP_KMASK 15
#endif
#ifndef REP_SUB
#define REP_SUB -2
#endif
#ifndef FULL_UNROLL
#define FULL_UNROLL 1
#endif
#ifndef USE_CG_SYNC
#define USE_CG_SYNC 0
#endif
#ifndef USE_MFMA_GEMM
#define USE_MFMA_GEMM 1
#endif

#define LAS __attribute__((address_space(3)))
#define GAS __attribute__((address_space(1)))
typedef unsigned short bf16_t;
typedef short bf16x8 __attribute__((ext_vector_type(8)));
typedef float f32x4 __attribute__((ext_vector_type(4)));
typedef float f32x2 __attribute__((ext_vector_type(2)));
typedef unsigned u32x4 __attribute__((ext_vector_type(4)));
typedef unsigned u32x2 __attribute__((ext_vector_type(2)));

constexpr int NTOK = 16384, DM = 1024, SEQ = 4096, NBATCH = 4, DEPTH = 2;
constexpr int DIN = 2980, DINP = 3072;
constexpr int NSUB = 9;
constexpr int NPH = 1 + NSUB * DEPTH + 1;
constexpr float EPS = 1e-6f;
constexpr float LOG2E = 1.4426950408889634f;
constexpr float L2_10000 = 13.287712379549449f;
constexpr int NTHREADS = 512, NWAVES = 8;
constexpr float EU_SCALE = 512.0f, EV_SCALE = 64.0f;

constexpr size_t MiB = 1u << 20;
constexpr size_t WS_CTL = 0, CTL_BYTES = 1 * MiB;
constexpr size_t WS_WIN = 2 * MiB;
constexpr size_t WS_WUQ = 14 * MiB;
constexpr size_t WS_WUKV = 14 * MiB + 512 * 1024;
constexpr size_t WS_SKEY = 15 * MiB;
constexpr size_t WS_WOUT = 16 * MiB;
constexpr size_t WS_WQ = 20 * MiB;
constexpr size_t WS_EU = 32 * MiB;
constexpr size_t WS_EV = 96 * MiB;
constexpr size_t WS_XB = 160 * MiB;
constexpr size_t WS_XR = 192 * MiB;
constexpr size_t WS_Y = 256 * MiB;
constexpr size_t WS_SS1 = 288 * MiB;
constexpr size_t WS_PART2 = WS_SS1 + 64 * 1024;
constexpr size_t WS_PARTQ = WS_PART2 + 1 * MiB;
constexpr size_t WS_PARTKV = WS_PARTQ + 256 * 1024;
constexpr size_t WS_LOGF = WS_PARTKV + 256 * 1024;
constexpr size_t WS_FCUM = WS_LOGF + 256 * 1024;
constexpr size_t WS_ROPE64 = WS_FCUM + 256 * 1024;
constexpr size_t WS_ROPE32 = WS_ROPE64 + 1 * MiB;
constexpr size_t WS_EIDX = 292 * MiB;
constexpr size_t WS_EGATE = 300 * MiB;
constexpr size_t WS_ACT = 308 * MiB;
constexpr size_t WS_RQ = WS_ACT + 0 * MiB, WS_RK = WS_ACT + 8 * MiB, WS_RV = WS_ACT + 16 * MiB, WS_RG = WS_ACT + 24 * MiB;
constexpr size_t WS_FQ = WS_ACT + 32 * MiB, WS_FK = WS_ACT + 40 * MiB, WS_FV = WS_ACT + 48 * MiB;
constexpr size_t WS_SQ = WS_ACT + 56 * MiB, WS_SK = WS_ACT + 64 * MiB, WS_SV = WS_ACT + 72 * MiB;
constexpr size_t WS_CQ = WS_ACT + 80 * MiB;
constexpr size_t WS_CKV = WS_ACT + 88 * MiB;
constexpr size_t WS_QD = WS_ACT + 92 * MiB;
constexpr size_t WS_KD = WS_ACT + 104 * MiB;
constexpr size_t WS_VD = WS_ACT + 116 * MiB;
constexpr size_t WS_QP = WS_ACT;
constexpr size_t WS_HQ = WS_Y;
constexpr size_t WS_HS = WS_Y + 16 * MiB;
constexpr size_t WS_PD = WS_ACT;
constexpr size_t WS_C = WS_ACT + 64 * MiB;
constexpr size_t WS_CS = WS_C + 4 * MiB;
constexpr size_t WS_PSS = WS_ACT + 124 * MiB;
constexpr size_t WS_END = WS_ACT + 125 * MiB;

constexpr int CW_QUEUE = 64;
constexpr int CW_BAR = 4096;

__device__ __forceinline__ unsigned f2bf(float f) { unsigned u = __builtin_bit_cast(unsigned, f); return (u + 0x7fffu + ((u >> 16) & 1u)) >> 16; }
typedef float f32x2_t_ __attribute__((ext_vector_type(2))); typedef __bf16 bf16x2_t_ __attribute__((ext_vector_type(2)));
__device__ __forceinline__ unsigned pk2(float lo, float hi) { f32x2_t_ v = {lo, hi}; bf16x2_t_ b = __builtin_convertvector(v, bf16x2_t_); return __builtin_bit_cast(unsigned, b); }
__device__ __forceinline__ float bflo(unsigned w) { return __builtin_bit_cast(float, w << 16); }
__device__ __forceinline__ float bfhi(unsigned w) { return __builtin_bit_cast(float, w & 0xffff0000u); }
__device__ __forceinline__ void unpack8(const u32x4 w, float* d) { d[0] = bflo(w.x); d[1] = bfhi(w.x); d[2] = bflo(w.y); d[3] = bfhi(w.y); d[4] = bflo(w.z); d[5] = bfhi(w.z); d[6] = bflo(w.w); d[7] = bfhi(w.w); }
__device__ __forceinline__ float bf2f(bf16_t h) { return __builtin_bit_cast(float, (unsigned)h << 16); }
__device__ __forceinline__ int dpp_xor1(int v) { return __builtin_amdgcn_update_dpp(0, v, 0xB1, 0xf, 0xf, false); }
__device__ __forceinline__ int dpp_xor2(int v) { return __builtin_amdgcn_update_dpp(0, v, 0x4E, 0xf, 0xf, false); }
__device__ __forceinline__ int dpp_xor8(int v) { return __builtin_amdgcn_update_dpp(0, v, 0x128, 0xf, 0xf, false); }
__device__ __forceinline__ int dpp_xor4(int lo_src  , int hi_src  ) {
    const int t = __builtin_amdgcn_update_dpp(0, lo_src, 0x104, 0xf, 0x5, false);
    return __builtin_amdgcn_update_dpp(t, hi_src, 0x114, 0xf, 0xa, false);
}
__device__ __forceinline__ float dpp_xor8f(float v) { return __builtin_bit_cast(float, dpp_xor8(__builtin_bit_cast(int, v))); }
__device__ __forceinline__ float dpp_xor1f(float v) { return __builtin_bit_cast(float, dpp_xor1(__builtin_bit_cast(int, v))); }
__device__ __forceinline__ float dpp_xor2f(float v) { return __builtin_bit_cast(float, dpp_xor2(__builtin_bit_cast(int, v))); }
__device__ __forceinline__ float dpp_xor4f(float v) { const int i = __builtin_bit_cast(int, v); return __builtin_bit_cast(float, dpp_xor4(i, i)); }
__device__ __forceinline__ float add_xor16(float x) { unsigned a = __builtin_bit_cast(unsigned, x), b = a; asm volatile("" : "+v"(b)); const auto r = __builtin_amdgcn_permlane16_swap(a, b, false, false);
    return __builtin_bit_cast(float, (unsigned)r[0]) + __builtin_bit_cast(float, (unsigned)r[1]); }
__device__ __forceinline__ float add_xor32(float x) { unsigned a = __builtin_bit_cast(unsigned, x), b = a; asm volatile("" : "+v"(b)); const auto r = __builtin_amdgcn_permlane32_swap(a, b, false, false);
    return __builtin_bit_cast(float, (unsigned)r[0]) + __builtin_bit_cast(float, (unsigned)r[1]); }
__device__ __forceinline__ float max_xor16(float x) { unsigned a = __builtin_bit_cast(unsigned, x), b = a; asm volatile("" : "+v"(b)); const auto r = __builtin_amdgcn_permlane16_swap(a, b, false, false);
    return fmaxf(__builtin_bit_cast(float, (unsigned)r[0]), __builtin_bit_cast(float, (unsigned)r[1])); }
__device__ __forceinline__ float wave_sum(float v) {
    v += dpp_xor1f(v); v += dpp_xor2f(v); v += dpp_xor4f(v); v += dpp_xor8f(v);
    return add_xor32(add_xor16(v));
}
__device__ __forceinline__ float fast_exp2(float x) { return __builtin_amdgcn_exp2f(x); }
__device__ __forceinline__ float fast_log2(float x) { return __builtin_amdgcn_logf(x); }
__device__ __forceinline__ float fast_rcp(float x) { return __builtin_amdgcn_rcpf(x); }
__device__ __forceinline__ void sincos_rev(float ang, float& s, float& c) {
    double rv = (double)ang * 0.15915494309189535; rv -= __builtin_floor(rv); const float fr = (float)rv;
    s = __builtin_amdgcn_sinf(fr); c = __builtin_amdgcn_cosf(fr);
}

__device__ __forceinline__ int tid_() { int t = threadIdx.x; asm volatile("" : "+v"(t)); return t; }
__device__ __forceinline__ int bid_() { int b = blockIdx.x; asm volatile("" : "+s"(b)); return b; }
template <class P> __device__ __forceinline__ P* launder(P* q) { GAS P* g = (GAS P*)q; asm volatile("" : "+s"(g)); return (P*)g; }

struct Params {
    const float* x; const float* norm_mix; const float* w_in; const float* b_forget; const float* norm_cq; const float* norm_ckv;
    const float* w_uq; const float* w_ukv; const float* head_gain; const float* w_out; const float* norm_ffn; const float* w_query;
    const float* sub_keys; const float* expert_u; const float* expert_v; const float* norm_final;
    float* out; unsigned char* ws; int ph_lo, ph_hi;
};

__device__ __forceinline__ int colmap_win(int n) {
    const int tile = n >> 8, c = n & 255;
    switch (tile) {
        case 0: case 1: { const int head = c >> 6, j = c & 63, d = (j >> 1) + 32 * (j & 1); return tile * 256 + head * 64 + d; }
        case 2: return 512 + c;
        case 3: return 768 + c;
        case 4: return 1024 + c;
        case 5: return 1280 + c;
        case 6: return 1536 + c;
        case 7: return 1796 + c;
        case 8: return 2052 + c;
        case 9: return 2308 + c;
        case 10: return 2564 + c;
        default:
            if (c < 128) return 2820 + c;
            if (c < 160) { const int j = c - 128, d = (j >> 1) + 16 * (j & 1); return 2948 + d; }
            if (c < 164) return 1792 + (c - 160);
            return -1;
    }
}
__device__ __forceinline__ int colmap_wuq(int n) {
    if (n >= 384) return -1;
    const int head = n / 96, j = n % 96;
    if (j < 64) return head * 96 + j;
    const int jj = j - 64, d = (jj >> 1) + 16 * (jj & 1);
    return head * 96 + 64 + d;
}
template <int MAPK>
__device__ __forceinline__ void transpose_item(const float* W, int K, int Nold, int Nnew, bf16_t* WT, const float* kscale, LAS float* scr, int item, int lane) {
    const int nblk = Nnew / 32, kb = item / nblk, nb = item % nblk, k0 = 64 * kb, n0 = 32 * nb;
    const int nn = n0 + (lane & 31);
    const int old = (MAPK == 0) ? colmap_win(nn) : (MAPK == 1) ? colmap_wuq(nn) : nn;
    const int oldA = __builtin_amdgcn_readlane(old, 0);
    if (oldA >= 0 && __all(old == oldA + (lane & 31))) {
        f32x4 v[8];
#pragma unroll
        for (int i = 0; i < 8; ++i) v[i] = *(const f32x4*)(W + (size_t)(k0 + 8 * i + (lane >> 3)) * Nold + oldA + 4 * (lane & 7));
#pragma unroll
        for (int i = 0; i < 8; ++i) { const int kk = 8 * i + (lane >> 3); const float ks = kscale ? kscale[k0 + kk] : 1.0f; LAS float* d = scr + kk * 33 + 4 * (lane & 7);
            d[0] = v[i].x * ks; d[1] = v[i].y * ks; d[2] = v[i].z * ks; d[3] = v[i].w * ks; }
    } else if (oldA >= 0 && __all(old == oldA + ((lane & 31) >> 1) + (__builtin_amdgcn_readlane(old, 1) - oldA) * (lane & 1))) {
        const int D = __builtin_amdgcn_readlane(old, 1) - oldA, run = (lane >> 2) & 1;
        f32x4 v[8];
#pragma unroll
        for (int i = 0; i < 8; ++i) v[i] = *(const f32x4*)(W + (size_t)(k0 + 8 * i + (lane >> 3)) * Nold + oldA + run * D + 4 * (lane & 3));
#pragma unroll
        for (int i = 0; i < 8; ++i) { const int kk = 8 * i + (lane >> 3); const float ks = kscale ? kscale[k0 + kk] : 1.0f; LAS float* d = scr + kk * 33 + 8 * (lane & 3) + run;
            d[0] = v[i].x * ks; d[2] = v[i].y * ks; d[4] = v[i].z * ks; d[6] = v[i].w * ks; }
    } else {
#pragma unroll 8
        for (int i = 0; i < 32; ++i) {
            const int kk = 2 * i + (lane >> 5);
            float v = 0.f;
            if (old >= 0) { v = W[(size_t)(k0 + kk) * Nold + old]; if (kscale) v *= kscale[k0 + kk]; }
            scr[kk * 33 + (lane & 31)] = v;
        }
    }
    asm volatile("s_waitcnt lgkmcnt(0)" ::: "memory");
    const int c = lane & 7;
#pragma unroll
    for (int j = 0; j < 4; ++j) {
        const int n = (lane >> 3) + 8 * j; const LAS float* s = scr + (8 * c) * 33 + n;
        u32x4 o; o.x = pk2(s[0 * 33], s[1 * 33]); o.y = pk2(s[2 * 33], s[3 * 33]); o.z = pk2(s[4 * 33], s[5 * 33]); o.w = pk2(s[6 * 33], s[7 * 33]);
        *(u32x4*)(WT + (size_t)(n0 + n) * K + k0 + 8 * c) = o;
    }
    asm volatile("s_waitcnt lgkmcnt(0)" ::: "memory");
}
__device__ __forceinline__ void cvt_stream(const float* src, bf16_t* dst, size_t n8, size_t g0, size_t gstride) {
    for (size_t g = g0; g < n8; g += gstride) {
        const f32x4 a = *(const f32x4*)(src + g * 8), b = *(const f32x4*)(src + g * 8 + 4);
        u32x4 o; o.x = pk2(a.x, a.y); o.y = pk2(a.z, a.w); o.z = pk2(b.x, b.y); o.w = pk2(b.z, b.w);
        *(u32x4*)(dst + g * 8) = o;
    }
}
__device__ __forceinline__ unsigned pk4_fp8(float a, float b, float c, float d) { int w = 0; w = __builtin_amdgcn_cvt_pk_fp8_f32(a, b, w, false); w = __builtin_amdgcn_cvt_pk_fp8_f32(c, d, w, true); return (unsigned)w; }
__device__ __forceinline__ unsigned pk4_i8(float a, float b, float c, float d) {
    const float M = 12582912.0f;
    const unsigned ua = __builtin_bit_cast(unsigned, fminf(fmaxf(a, -127.f), 127.f) + M), ub = __builtin_bit_cast(unsigned, fminf(fmaxf(b, -127.f), 127.f) + M);
    const unsigned uc = __builtin_bit_cast(unsigned, fminf(fmaxf(c, -127.f), 127.f) + M), ud = __builtin_bit_cast(unsigned, fminf(fmaxf(d, -127.f), 127.f) + M);
    const unsigned t01 = __builtin_amdgcn_perm(ub, ua, 0x0c0c0400u), t23 = __builtin_amdgcn_perm(ud, uc, 0x0c0c0400u);
    return __builtin_amdgcn_perm(t23, t01, 0x05040100u);
}
__device__ __forceinline__ void cvt_stream_fp8(const float* src, unsigned char* dst, size_t n16, size_t g0, size_t gstride, float sc, const float* colgain = nullptr) {
    for (size_t g = g0; g < n16; g += gstride) {
        f32x4 a = *(const f32x4*)(src + g * 16), b = *(const f32x4*)(src + g * 16 + 4), c = *(const f32x4*)(src + g * 16 + 8), d = *(const f32x4*)(src + g * 16 + 12);
        if (colgain) { const float* cg = colgain + ((g >> 20) * 1024 + (g & 63) * 16); a *= *(const f32x4*)cg; b *= *(const f32x4*)(cg + 4); c *= *(const f32x4*)(cg + 8); d *= *(const f32x4*)(cg + 12); }
        u32x4 o; o.x = pk4_fp8(a.x * sc, a.y * sc, a.z * sc, a.w * sc); o.y = pk4_fp8(b.x * sc, b.y * sc, b.z * sc, b.w * sc); o.z = pk4_fp8(c.x * sc, c.y * sc, c.z * sc, c.w * sc); o.w = pk4_fp8(d.x * sc, d.y * sc, d.z * sc, d.w * sc);
        const size_t row = g >> 6, c16 = g & 63, lay = row >> 14, e = row & 16383;
        *(u32x4*)(dst + (((lay * 8 + (c16 >> 3)) * 16384 + e) * 128 + (c16 & 7) * 16)) = o;
    }
}
__device__ __forceinline__ void experts_convert(const Params& p, unsigned char* ws, size_t g0, size_t gs) {
    cvt_stream_fp8(p.expert_u, ws + WS_EU, (size_t)DEPTH * 16384 * 1024 / 16, g0, gs, EU_SCALE, p.norm_ffn);
    cvt_stream_fp8(p.expert_v, ws + WS_EV, (size_t)DEPTH * 16384 * 1024 / 16, g0, gs, EV_SCALE);
}
__device__ __forceinline__ void phase_prologue(const Params& p, LAS unsigned char* lds) {
    const int tid = tid_(), lane = tid & 63, wave = tid >> 6;
    const int gw = bid_() * NWAVES + wave, NGW = gridDim.x * NWAVES;
    LAS float* scr = (LAS float*)(lds + wave * 16384);
    unsigned char* ws = launder(p.ws);
    constexpr int I_IN = (DM / 64) * (DINP / 32), I_UQ = (256 / 64) * (512 / 32), I_UKV = (128 / 64) * (512 / 32), I_OUT = (DM / 64) * (DM / 32), I_WQ = (DM / 64) * (2048 / 32);
    constexpr int I_L = I_IN + I_UQ + I_UKV + I_OUT + I_WQ;
    for (int it = gw; it < DEPTH * I_L; it += NGW) {
        const int l = it / I_L; int r = it % I_L;
        if (r < I_IN) { transpose_item<0>(p.w_in + (size_t)l * DM * DIN, DM, DIN, DINP, (bf16_t*)(ws + WS_WIN) + (size_t)l * DINP * DM, p.norm_mix + l * DM, scr, r, lane); continue; } r -= I_IN;
        if (r < I_UQ) { transpose_item<1>(p.w_uq + (size_t)l * 256 * 384, 256, 384, 512, (bf16_t*)(ws + WS_WUQ) + (size_t)l * 512 * 256, p.norm_cq + l * 256, scr, r, lane); continue; } r -= I_UQ;
        if (r < I_UKV) { transpose_item<2>(p.w_ukv + (size_t)l * 128 * 512, 128, 512, 512, (bf16_t*)(ws + WS_WUKV) + (size_t)l * 512 * 128, p.norm_ckv + l * 128, scr, r, lane); continue; } r -= I_UKV;
        if (r < I_OUT) { transpose_item<2>(p.w_out + (size_t)l * DM * DM, DM, DM, DM, (bf16_t*)(ws + WS_WOUT) + (size_t)l * DM * DM, p.head_gain + l * DM, scr, r, lane); continue; } r -= I_OUT;
        transpose_item<2>(p.w_query + (size_t)l * DM * 2048, DM, 2048, 2048, (bf16_t*)(ws + WS_WQ) + (size_t)l * 2048 * DM, p.norm_ffn + l * DM, scr, r, lane);
    }
    const size_t g0 = (size_t)bid_() * NTHREADS + tid, gs = (size_t)gridDim.x * NTHREADS;
    cvt_stream(p.sub_keys, (bf16_t*)(ws + WS_SKEY), (size_t)DEPTH * 8 * 2 * 128 * 128 / 8, g0, gs);
    float* pss = (float*)(ws + WS_PSS); bf16_t* xb = (bf16_t*)(ws + WS_XB);
    for (int m0 = gw * 4; m0 < NTOK; m0 += NGW * 4) {
        f32x4 v[4][4];
#pragma unroll
        for (int r = 0; r < 4; ++r) { const f32x4* xr = (const f32x4*)(p.x + (size_t)(m0 + r) * DM) + lane;
#pragma unroll
            for (int j = 0; j < 4; ++j) v[r][j] = xr[64 * j]; }
#pragma unroll
        for (int r = 0; r < 4; ++r) {
            float s = 0.f; u32x2* o8 = (u32x2*)(xb + (size_t)(m0 + r) * DM) + lane;
#pragma unroll
            for (int j = 0; j < 4; ++j) { const f32x4 w = v[r][j]; s += (w.x * w.x + w.y * w.y) + (w.z * w.z + w.w * w.w); u32x2 o; o.x = pk2(w.x, w.y); o.y = pk2(w.z, w.w); o8[64 * j] = o; }
            s = wave_sum(s);
            float z_ = 0.f; asm volatile("" : "+v"(z_));
            if (lane == 0) { *(f32x4*)(pss + (size_t)(m0 + r) * 8) = (f32x4){s, z_, z_, z_}; *(f32x4*)(pss + (size_t)(m0 + r) * 8 + 4) = (f32x4){z_, z_, z_, z_}; }
        }
    }
}

__device__ __forceinline__ void store8_bf16(bf16_t* dst, const float* v) {
    u32x4 o; o.x = pk2(v[0], v[1]); o.y = pk2(v[2], v[3]); o.z = pk2(v[4], v[5]); o.w = pk2(v[6], v[7]);
    *(u32x4*)dst = o;
}
__device__ __forceinline__ void rope8(float* v, const float* tab) {
    const f32x4 a = *(const f32x4*)tab, b = *(const f32x4*)(tab + 4);
    float t1, t2;
    t1 = v[0]; t2 = v[1]; v[0] = t1 * a.x - t2 * a.y; v[1] = t1 * a.y + t2 * a.x;
    t1 = v[2]; t2 = v[3]; v[2] = t1 * a.z - t2 * a.w; v[3] = t1 * a.w + t2 * a.z;
    t1 = v[4]; t2 = v[5]; v[4] = t1 * b.x - t2 * b.y; v[5] = t1 * b.y + t2 * b.x;
    t1 = v[6]; t2 = v[7]; v[6] = t1 * b.z - t2 * b.w; v[7] = t1 * b.w + t2 * b.z;
}

__device__ __forceinline__ void rope_angles(int pos, int i0, float l2step  , float (&cs)[4], float (&sn)[4]) {
    const float fp = (float)pos;
#pragma unroll
    for (int j = 0; j < 4; ++j) {
        const float fr = __builtin_amdgcn_fractf(fp * (fast_exp2(-(float)(i0 + j) * l2step) * 0.15915494309189535f));
        sn[j] = __builtin_amdgcn_sinf(fr); cs[j] = __builtin_amdgcn_cosf(fr);
    }
}
__device__ __forceinline__ void rope8r(float* v, const float (&cs)[4], const float (&sn)[4]) {
#pragma unroll
    for (int j = 0; j < 4; ++j) { const float t1 = v[2 * j], t2 = v[2 * j + 1]; v[2 * j] = t1 * cs[j] - t2 * sn[j]; v[2 * j + 1] = t1 * sn[j] + t2 * cs[j]; }
}

struct EpiInProj {
    unsigned char* ws; const float* b_forget;
    __device__ __forceinline__ void row16(int row, int pn, int wc, int fq, float (&v)[2][8], float rs) const {
        const int pos = row & (SEQ - 1);
#pragma unroll
        for (int bj = 0; bj < 2; ++bj)
#pragma unroll
            for (int e = 0; e < 8; ++e) v[bj][e] *= rs;
        const int cl0 = 32 * wc + 8 * fq;
        switch (pn) {
            case 0: case 1: {
                bf16_t* dst = (bf16_t*)(ws + (pn == 0 ? WS_RQ : WS_RK)) + (size_t)row * 256;
                float cs[4], sn[4]; rope_angles(pos, (cl0 & 63) >> 1, L2_10000 / 32.0f, cs, sn);
#pragma unroll
                for (int bj = 0; bj < 2; ++bj) { const int c = 128 * bj + cl0; rope8r(v[bj], cs, sn);
                    if (pn == 1) {
#pragma unroll
                        for (int e = 0; e < 8; ++e) v[bj][e] *= 0.125f; }
                    store8_bf16(dst + c, v[bj]); }
            } break;
            case 3: {
                bf16_t* dst = (bf16_t*)(ws + WS_RG) + (size_t)row * 256;
#pragma unroll
                for (int bj = 0; bj < 2; ++bj) {
#pragma unroll
                    for (int e = 0; e < 8; ++e) { const float g = v[bj][e]; v[bj][e] = g * fast_rcp(1.0f + __expf(-g)); }
                    store8_bf16(dst + 128 * bj + cl0, v[bj]); }
            } break;
            case 2: case 5: case 6: case 8: case 9: case 4: case 7: {
                const size_t off = pn == 2 ? WS_RV : pn == 4 ? WS_FQ : pn == 5 ? WS_FK : pn == 6 ? WS_FV : pn == 7 ? WS_SQ : pn == 8 ? WS_SK : WS_SV;
                const float sc = (pn == 4 || pn == 7) ? 0.125f * LOG2E : 1.0f;
                bf16_t* dst = (bf16_t*)(ws + off) + (size_t)row * 256;
#pragma unroll
                for (int bj = 0; bj < 2; ++bj) {
#pragma unroll
                    for (int e = 0; e < 8; ++e) v[bj][e] *= sc;
                    store8_bf16(dst + 128 * bj + cl0, v[bj]); }
            } break;
            case 10: {
                bf16_t* dst = (bf16_t*)(ws + WS_CQ) + (size_t)row * 256; float s = 0.f;
#pragma unroll
                for (int bj = 0; bj < 2; ++bj) {
#pragma unroll
                    for (int e = 0; e < 8; ++e) s += v[bj][e] * v[bj][e];
                    store8_bf16(dst + 128 * bj + cl0, v[bj]); }
                s = add_xor32(add_xor16(s));
                if (fq == 0) ((float*)(ws + WS_PARTQ))[row * 4 + wc] = s;
            } break;
            default: {
                float s = 0.f;
#pragma unroll
                for (int e = 0; e < 8; ++e) s += v[0][e] * v[0][e];
                store8_bf16((bf16_t*)(ws + WS_CKV) + (size_t)row * 128 + cl0, v[0]);
                s = add_xor32(add_xor16(s));
                if (fq == 0) ((float*)(ws + WS_PARTKV))[row * 4 + wc] = s;
                if (wc == 0) {
                    { float cs[4], sn[4]; rope_angles(pos, 4 * fq, L2_10000 / 16.0f, cs, sn); rope8r(v[1], cs, sn); }
                    bf16_t* kd = (bf16_t*)(ws + WS_KD) + (size_t)row * 384 + 64 + 8 * fq;
#pragma unroll
                    for (int h = 0; h < 4; ++h) store8_bf16(kd + 96 * h, v[1]);
                } else if (wc == 1 && fq == 0) {
                    f32x4 lf;
#pragma unroll
                    for (int h = 0; h < 4; ++h) { const float z = v[1][h] + ((const __attribute__((address_space(4))) float*)b_forget)[h]; lf[h] = fminf(z, 0.f) - fast_log2(1.0f + __expf(-fabsf(z))) * 0.6931471805599453f; }
                    *(f32x4*)((float*)(ws + WS_LOGF) + (size_t)row * 4) = lf;
                }
            } break;
        }
    }
};
struct EpiMla {
    unsigned char* ws; int which;
    __device__ __forceinline__ void row16(int row, int pn, int wc, int fq, float (&v)[2][8], float rs) const {
        if (which == 0) {
            const int pos = row & (SEQ - 1);
            bf16_t* dst = (bf16_t*)(ws + WS_QD) + (size_t)row * 384;
#pragma unroll
            for (int bj = 0; bj < 2; ++bj) {
                const int n = 256 * pn + 128 * bj + 32 * wc + 8 * fq;
                if (n < 384) {
                    const int j = n % 96;
                    if (j >= 64) { float cs[4], sn[4]; rope_angles(pos, (j - 64) >> 1, L2_10000 / 16.0f, cs, sn); rope8r(v[bj], cs, sn); }
#pragma unroll
                    for (int e = 0; e < 8; ++e) v[bj][e] *= rs;
                    store8_bf16(dst + n, v[bj]);
                }
            }
        } else {
#pragma unroll
            for (int bj = 0; bj < 2; ++bj) {
                const int head = 2 * pn + bj, j = 32 * wc + 8 * fq;
#pragma unroll
                for (int e = 0; e < 8; ++e) v[bj][e] *= rs;
                bf16_t* dst = (j < 64) ? (bf16_t*)(ws + WS_KD) + (size_t)row * 384 + head * 96 + j : (bf16_t*)(ws + WS_VD) + (size_t)row * 256 + head * 64 + (j - 64);
                store8_bf16(dst, v[bj]);
            }
        }
    }
};
struct EpiOutProj {
    unsigned char* ws; const float* resid;
    __device__ __forceinline__ void row16(int row, int pn, int wc, int fq, float (&v)[2][8]) const {
        bf16_t* xb = (bf16_t*)(ws + WS_XB) + (size_t)row * DM;
        float s = 0.f;
#pragma unroll
        for (int bj = 0; bj < 2; ++bj) {
            const int c = 256 * pn + 128 * bj + 32 * wc + 8 * fq;
#pragma unroll
            for (int e = 0; e < 8; ++e) s += v[bj][e] * v[bj][e];
            store8_bf16(xb + c, v[bj]);
        }
        s = add_xor32(add_xor16(s));
        if (fq == 0) ((float*)(ws + WS_PART2))[(size_t)row * 16 + pn * 4 + wc] = s;
    }
};
__device__ __forceinline__ float rstd2_of(const unsigned char* ws, int row) {
    const f32x4* pp = (const f32x4*)((const float*)(ws + WS_PART2) + (size_t)row * 16);
    const f32x4 a = pp[0], b = pp[1], c = pp[2], d = pp[3];
    const float s = (((a.x + a.y) + (a.z + a.w)) + ((b.x + b.y) + (b.z + b.w))) + (((c.x + c.y) + (c.z + c.w)) + ((d.x + d.y) + (d.z + d.w)));
    return __builtin_amdgcn_rsqf(s * (1.0f / DM) + EPS);
}
struct EpiQuery {
    unsigned char* ws;
    __device__ __forceinline__ void row16(int row, int pn, int wc, int fq, float (&v)[2][8], float rs) const {
        const int k = 2 * wc + (fq >> 1), hh = fq & 1;
        bf16_t* dst = (bf16_t*)(ws + WS_QP) + ((size_t)(row >> 5) * 8 + pn) * (2 * 8 * 2 * 32 * 8) + (size_t)((k * 2 + hh) * 32 + (row & 31)) * 8;
#pragma unroll
        for (int bj = 0; bj < 2; ++bj) {
#pragma unroll
            for (int e = 0; e < 8; ++e) v[bj][e] *= rs;
            store8_bf16(dst + bj * (8 * 2 * 32 * 8), v[bj]);
        }
    }
};

struct EpiAll {
    unsigned char* ws; const float* aux; int kind;
    __device__ __forceinline__ void row16(int row, int pn, int wc, int fq, float (&v)[2][8], float rs) const {
        unsigned char* w2 = launder(ws);
        if (kind == 0) { EpiInProj E{w2, aux}; E.row16(row, pn, wc, fq, v, rs); }
        else if (kind == 1 || kind == 2) { EpiMla E{w2, kind - 1}; E.row16(row, pn, wc, fq, v, rs); }
        else if (kind == 3) { EpiOutProj E{w2, aux}; E.row16(row, pn, wc, fq, v); }
        else { EpiQuery E{w2}; E.row16(row, pn, wc, fq, v, rs); }
    }
    __device__ __forceinline__ float row_scale(int row) const {
        if (kind == 0) { const f32x4 sa = *(const f32x4*)((const float*)(ws + WS_PSS) + (size_t)row * 8), sb = *(const f32x4*)((const float*)(ws + WS_PSS) + (size_t)row * 8 + 4);
            return __builtin_amdgcn_rsqf((((sa.x + sa.y) + (sa.z + sa.w)) + ((sb.x + sb.y) + (sb.z + sb.w))) * (1.0f / DM) + EPS); }
        if (kind == 1 || kind == 2) { const f32x4 pq = *(const f32x4*)((const float*)(ws + (kind == 1 ? WS_PARTQ : WS_PARTKV)) + (size_t)row * 4); const float ssum = (pq.x + pq.y) + (pq.z + pq.w);
            return kind == 1 ? __builtin_amdgcn_rsqf(ssum * (1.0f / 256.0f) + EPS) * (0.10206207261596575f * LOG2E) : __builtin_amdgcn_rsqf(ssum * (1.0f / 128.0f) + EPS); }
        if (kind == 4) return rstd2_of(ws, row);
        return 1.0f;
    }
};
struct Gemm { const bf16_t* A; const bf16_t* Bt; int M, N, K, lda, ldb; };

template <class Epi>
__device__ __forceinline__ void gemm_naive(const Gemm g, int c0, int G, const Epi& E) {
    const int tid = tid_(), wid = tid >> 6, lane = tid & 63, wr = wid >> 2, wc = wid & 3, fr = lane & 15, fq = lane >> 4;
    const int nM = g.M / 256, nN = g.N / 256;
    for (int u = c0; u < nM * nN; u += G) {
        const int pm = u / nN, pn = u % nN;
        for (int ai = 0; ai < 2; ++ai)
            for (int m = 0; m < 4; ++m) {
                const int row = pm * 256 + ai * 128 + wr * 64 + m * 16 + fr;
                float v[2][8];
#pragma unroll
                for (int bj = 0; bj < 2; ++bj)
#pragma unroll
                    for (int e = 0; e < 8; ++e) v[bj][e] = 0.f;
                const bf16_t* ap = g.A + (size_t)row * g.lda;
                for (int k = 0; k < g.K; k += 8) {
                    const u32x4 aw = *(const u32x4*)(ap + k);
                    const float a0 = bflo(aw.x), a1 = bfhi(aw.x), a2 = bflo(aw.y), a3 = bfhi(aw.y), a4 = bflo(aw.z), a5 = bfhi(aw.z), a6 = bflo(aw.w), a7 = bfhi(aw.w);
#pragma unroll
                    for (int bj = 0; bj < 2; ++bj)
#pragma unroll
                        for (int e = 0; e < 8; ++e) {
                            const int col = pn * 256 + bj * 128 + wc * 32 + fq * 8 + e;
                            const u32x4 bw = *(const u32x4*)(g.Bt + (size_t)col * g.ldb + k);
                            float s = v[bj][e];
                            s += a0 * bflo(bw.x); s += a1 * bfhi(bw.x); s += a2 * bflo(bw.y); s += a3 * bfhi(bw.y); s += a4 * bflo(bw.z); s += a5 * bfhi(bw.z); s += a6 * bflo(bw.w); s += a7 * bfhi(bw.w);
                            v[bj][e] = s;
                        }
                }
                E.row16(row, pn, wc, fq, v, 1.0f);
            }
    }
}

__device__ __forceinline__ void fcum_scan(unsigned char* ws, int seq  , int tid, LAS unsigned char* lds) {
    const int b = seq >> 2, h = seq & 3, lane = tid & 63, wave = tid >> 6;
    const float* lf = (const float*)(ws + WS_LOGF) + (size_t)b * SEQ * 4 + h + (size_t)(wave * 512 + lane * 8) * 4;
    float* fc = (float*)(ws + WS_FCUM) + (size_t)b * SEQ * 4 + h + (size_t)(wave * 512 + lane * 8) * 4;
    float v[8]; float loc = 0.f;
#pragma unroll
    for (int i = 0; i < 8; ++i) v[i] = lf[4 * i];
#pragma unroll
    for (int i = 0; i < 8; ++i) loc += v[i];
    float inc = loc;
#pragma unroll
    for (int o = 1; o < 64; o <<= 1) { const float t = __shfl_up(inc, o); if (lane >= o) inc += t; }
    volatile LAS float* tot = (volatile LAS float*)(lds + 131072 + 1024);
    if (lane == 63) tot[wave] = inc;
    __syncthreads();
    float run = inc - loc;
#pragma unroll
    for (int w = 0; w < 8; ++w) run += (w < wave) ? tot[w] : 0.f;
#pragma unroll
    for (int i = 0; i < 8; ++i) { run += v[i]; fc[4 * i] = run; }
    __syncthreads();
}

__device__ __forceinline__ void load_row64(const bf16_t* p, float* d) {
#pragma unroll
    for (int i = 0; i < 8; ++i) { const u32x4 w = *(const u32x4*)(p + 8 * i); d[8 * i] = bflo(w.x); d[8 * i + 1] = bfhi(w.x); d[8 * i + 2] = bflo(w.y); d[8 * i + 3] = bfhi(w.y); d[8 * i + 4] = bflo(w.z); d[8 * i + 5] = bfhi(w.z); d[8 * i + 6] = bflo(w.w); d[8 * i + 7] = bfhi(w.w); }
}
template <int NCH>
__device__ __forceinline__ float dot_row(const bf16_t* kp, const float* q) {
    float s = 0.f;
#pragma unroll
    for (int i = 0; i < NCH; ++i) { const u32x4 w = *(const u32x4*)(kp + 8 * i);
        s += q[8 * i] * bflo(w.x); s += q[8 * i + 1] * bfhi(w.x); s += q[8 * i + 2] * bflo(w.y); s += q[8 * i + 3] * bfhi(w.y); s += q[8 * i + 4] * bflo(w.z); s += q[8 * i + 5] * bfhi(w.z); s += q[8 * i + 6] * bflo(w.w); s += q[8 * i + 7] * bfhi(w.w); }
    return s;
}
template <int NCH>
__device__ __forceinline__ float dot_rows(const bf16_t* kp, const bf16_t* qp) {
    float s = 0.f;
#pragma unroll
    for (int i = 0; i < NCH; ++i) { const u32x4 w = *(const u32x4*)(kp + 8 * i); const u32x4 q = *(const u32x4*)(qp + 8 * i);
        s += bflo(q.x) * bflo(w.x); s += bfhi(q.x) * bfhi(w.x); s += bflo(q.y) * bflo(w.y); s += bfhi(q.y) * bfhi(w.y); s += bflo(q.z) * bflo(w.z); s += bfhi(q.z) * bfhi(w.z); s += bflo(q.w) * bflo(w.w); s += bfhi(q.w) * bfhi(w.w); }
    return s;
}
__device__ __forceinline__ void axpy_row64(const bf16_t* vp, float w, float* o) {
#pragma unroll
    for (int i = 0; i < 8; ++i) { const u32x4 x = *(const u32x4*)(vp + 8 * i);
        o[8 * i] += w * bflo(x.x); o[8 * i + 1] += w * bfhi(x.x); o[8 * i + 2] += w * bflo(x.y); o[8 * i + 3] += w * bfhi(x.y); o[8 * i + 4] += w * bflo(x.z); o[8 * i + 5] += w * bfhi(x.z); o[8 * i + 6] += w * bflo(x.w); o[8 * i + 7] += w * bfhi(x.w); }
}
__device__ __forceinline__ void head_norm_store(float* o, bool center, const bf16_t* gate, bf16_t* y) {
    if (center) { float m = 0.f;
#pragma unroll
        for (int i = 0; i < 64; ++i) m += o[i];
        m *= (1.0f / 64.0f);
#pragma unroll
        for (int i = 0; i < 64; ++i) o[i] -= m; }
    float s = 0.f;
#pragma unroll
    for (int i = 0; i < 64; ++i) s += o[i] * o[i];
    const float r = 1.0f / sqrtf(s * (1.0f / 64.0f) + EPS);
#pragma unroll
    for (int i = 0; i < 8; ++i) {
        float t[8];
#pragma unroll
        for (int e = 0; e < 8; ++e) t[e] = o[8 * i + e] * r;
        if (gate) { const u32x4 gw = *(const u32x4*)(gate + 8 * i); t[0] *= bflo(gw.x); t[1] *= bfhi(gw.x); t[2] *= bflo(gw.y); t[3] *= bfhi(gw.y); t[4] *= bflo(gw.z); t[5] *= bfhi(gw.z); t[6] *= bflo(gw.w); t[7] *= bfhi(gw.w); }
        store8_bf16(y + 8 * i, t);
    }
}
__device__ __forceinline__ void mixers_naive(unsigned char* ws) {
    const int tid = tid_();
    for (int u = bid_(); u < 512; u += gridDim.x) {
        const int kind = u >> 7, b = (u >> 5) & 3, h = (u >> 3) & 3, qb = u & 7;
        const int t = qb * 512 + tid; const size_t row = (size_t)b * SEQ + t;
        const int tmax = qb * 512 + (tid | 63);
        bf16_t* y = (bf16_t*)(ws + WS_Y) + row * DM + kind * 256 + h * 64;
        float o[64];
#pragma unroll
        for (int i = 0; i < 64; ++i) o[i] = 0.f;
        if (kind == 0) {
            const bf16_t* Q = (const bf16_t*)(ws + WS_RQ) + row * 256 + h * 64; const bf16_t* K = (const bf16_t*)(ws + WS_RK) + (size_t)b * SEQ * 256 + h * 64; const bf16_t* V = (const bf16_t*)(ws + WS_RV) + (size_t)b * SEQ * 256 + h * 64;
            const float lg = log2f(1.0f - exp2f(-5.0f - (float)h));
            for (int s = 0; s <= tmax; ++s) {
                const float d = dot_rows<8>(K + (size_t)s * 256, Q);
                const float w = (s <= t) ? d * fast_exp2(lg * (float)(t - s)) : 0.f;
                axpy_row64(V + (size_t)s * 256, w, o);
            }
            head_norm_store(o, true, (const bf16_t*)(ws + WS_RG) + row * 256 + h * 64, y);
        } else if (kind == 1) {
            const bf16_t* Q = (const bf16_t*)(ws + WS_FQ) + row * 256 + h * 64; const bf16_t* K = (const bf16_t*)(ws + WS_FK) + (size_t)b * SEQ * 256 + h * 64; const bf16_t* V = (const bf16_t*)(ws + WS_FV) + (size_t)b * SEQ * 256 + h * 64;
            const float* fc = (const float*)(ws + WS_FCUM) + (size_t)b * SEQ * 4 + h;
            float mx = -INFINITY, l = 0.f;
            for (int s = 0; s <= tmax; ++s) {
                const float d = dot_rows<8>(K + (size_t)s * 256, Q) - fc[(size_t)s * 4] * LOG2E;
                if (s <= t) {
                    const float mn = fmaxf(mx, d), al = fast_exp2(mx - mn), w = fast_exp2(d - mn);
                    l = l * al + w; mx = mn;
#pragma unroll
                    for (int i = 0; i < 64; ++i) o[i] *= al;
                    axpy_row64(V + (size_t)s * 256, w, o);
                }
            }
            const float il = 1.0f / l;
#pragma unroll
            for (int i = 0; i < 64; ++i) o[i] *= il;
            head_norm_store(o, false, nullptr, y);
        } else if (kind == 2) {
            const bf16_t* Q = (const bf16_t*)(ws + WS_SQ) + row * 256 + h * 64; const bf16_t* K = (const bf16_t*)(ws + WS_SK) + (size_t)b * SEQ * 256 + h * 64; const bf16_t* V = (const bf16_t*)(ws + WS_SV) + (size_t)b * SEQ * 256 + h * 64;
            float R = 0.f;
            for (int s = tmax - 1; s >= 0; --s) {
                const float z = dot_rows<8>(K + (size_t)s * 256, Q);
                const float sp = fmaxf(z, 0.f) + fast_log2(1.0f + fast_exp2(-fabsf(z)));
                if (s < t) {
                    const float w = fast_exp2(z - sp + R); R -= sp;
                    axpy_row64(V + (size_t)s * 256, w, o);
                }
            }
            head_norm_store(o, false, nullptr, y);
        } else {
            const bf16_t* Q = (const bf16_t*)(ws + WS_QD) + row * 384 + h * 96; const bf16_t* K = (const bf16_t*)(ws + WS_KD) + (size_t)b * SEQ * 384 + h * 96; const bf16_t* V = (const bf16_t*)(ws + WS_VD) + (size_t)b * SEQ * 256 + h * 64;
            float mx = -INFINITY, l = 0.f;
            for (int s = 0; s <= tmax; ++s) {
                const float d = dot_rows<12>(K + (size_t)s * 384, Q);
                if (s <= t) {
                    const float mn = fmaxf(mx, d), al = fast_exp2(mx - mn), w = fast_exp2(d - mn);
                    l = l * al + w; mx = mn;
#pragma unroll
                    for (int i = 0; i < 64; ++i) o[i] *= al;
                    axpy_row64(V + (size_t)s * 256, w, o);
                }
            }
            const float il = 1.0f / l;
#pragma unroll
            for (int i = 0; i < 64; ++i) o[i] *= il;
            head_norm_store(o, false, nullptr, y);
        }
    }
}


typedef float f32x16 __attribute__((ext_vector_type(16)));
typedef float f32x2_t __attribute__((ext_vector_type(2)));
typedef __bf16 bf16x2_t __attribute__((ext_vector_type(2)));
typedef short s16x4 __attribute__((ext_vector_type(4)));
typedef _Float16 h16x2 __attribute__((ext_vector_type(2)));
typedef _Float16 h16x4 __attribute__((ext_vector_type(4)));
#define MFMA32(a, b, c) __builtin_amdgcn_mfma_f32_32x32x16_bf16(a, b, c, 0, 0, 0)
__device__ __forceinline__ unsigned cvtpk(float lo, float hi) { f32x2_t v = {lo, hi}; bf16x2_t b = __builtin_convertvector(v, bf16x2_t); return __builtin_bit_cast(unsigned, b); }
__device__ __forceinline__ int crow(int r, int hi) { return (r & 3) + 8 * (r >> 2) + 4 * hi; }
__device__ __forceinline__ void swap32(float x, float& lo, float& hi) {
    unsigned a = __builtin_bit_cast(unsigned, x), b = a; asm volatile("" : "+v"(b));
    const auto r = __builtin_amdgcn_permlane32_swap(a, b, false, false);
    lo = __builtin_bit_cast(float, (unsigned)r[0]); hi = __builtin_bit_cast(float, (unsigned)r[1]);
}
__device__ __forceinline__ float pair_sum(float x) { float lo, hi; swap32(x, lo, hi); return lo + hi; }
__device__ __forceinline__ float pair_max(float x) { float lo, hi; swap32(x, lo, hi); return __builtin_fmaxf(lo, hi); }
__device__ __forceinline__ s16x4 vtr_read(const LAS unsigned char* p) {
    typedef short v4i16_t __attribute__((ext_vector_type(4)));
    return __builtin_bit_cast(s16x4, __builtin_amdgcn_ds_read_tr16_b64_v4i16((LAS v4i16_t*)p));
}
constexpr int MX_KB = 12288, MX_VB = 8192, MX_STAGE = MX_KB + MX_VB + 256, MX_CTL = 5 * MX_STAGE;
constexpr int MIX_UNITS = 1024;


struct CvtCtx { const float* eu; const float* ev; const float* gain; unsigned char* ws; size_t g0, gs; int j; f32x4 v[4]; };
constexpr int CVT_NJ = 32;
constexpr size_t CVT_NU = (size_t)DEPTH * 16384 * 1024 / 16;
__device__ __forceinline__ void cvt_issue(CvtCtx& c) {
    if (c.j < CVT_NJ) { const size_t g = c.g0 + (size_t)c.j * c.gs; const float* src = (g < CVT_NU) ? c.eu + g * 16 : c.ev + (g - CVT_NU) * 16;
        const GAS f32x4* sp = (const GAS f32x4*)src;
#pragma unroll
        for (int q = 0; q < 4; ++q) c.v[q] = sp[q]; }
}
__device__ __forceinline__ void cvt_finish(CvtCtx& c) {
    asm volatile("" :: "v"(c.v[0]), "v"(c.v[1]), "v"(c.v[2]), "v"(c.v[3]));
    if (c.j < CVT_NJ) {
        const size_t g = c.g0 + (size_t)c.j * c.gs; const bool isu = g < CVT_NU; const size_t gl = isu ? g : g - CVT_NU;
        f32x4 a = c.v[0], b = c.v[1], cc = c.v[2], d = c.v[3];
        float sc = EV_SCALE;
        if (isu) sc = EU_SCALE;
        u32x4 o;
        o.x = pk4_i8(a.x * sc, a.y * sc, a.z * sc, a.w * sc); o.y = pk4_i8(b.x * sc, b.y * sc, b.z * sc, b.w * sc); o.z = pk4_i8(cc.x * sc, cc.y * sc, cc.z * sc, cc.w * sc); o.w = pk4_i8(d.x * sc, d.y * sc, d.z * sc, d.w * sc);
        const size_t row = gl >> 6, c16 = gl & 63, lay = row >> 14, e = row & 16383;
        *(u32x4*)(c.ws + (isu ? WS_EU : WS_EV) + (((lay * 8 + (c16 >> 3)) * 16384 + e) * 128 + (c16 & 7) * 16)) = o;
        ++c.j;
    }
}

constexpr int MX_OST = 24576, MX_OROW = 144;
__device__ __forceinline__ void mix_store_rows(const f32x16& o0, const f32x16& o1, float rn, LAS unsigned char* lds, bf16_t* ybase  ,
                                               const bf16_t* gbase  , int lane, int wave, int r32, int hh) {
    LAS unsigned char* stg = lds + MX_OST + wave * (32 * MX_OROW);
#pragma unroll
    for (int q4 = 0; q4 < 4; ++q4) {
        u32x2 w0, w1; w0.x = cvtpk(o0[4 * q4] * rn, o0[4 * q4 + 1] * rn); w0.y = cvtpk(o0[4 * q4 + 2] * rn, o0[4 * q4 + 3] * rn);
        w1.x = cvtpk(o1[4 * q4] * rn, o1[4 * q4 + 1] * rn); w1.y = cvtpk(o1[4 * q4 + 2] * rn, o1[4 * q4 + 3] * rn);
        *(LAS u32x2*)(stg + r32 * MX_OROW + (8 * q4 + 4 * hh) * 2) = w0; *(LAS u32x2*)(stg + r32 * MX_OROW + 64 + (8 * q4 + 4 * hh) * 2) = w1;
    }
    asm volatile("s_waitcnt lgkmcnt(0)" ::: "memory");
#pragma unroll
    for (int i = 0; i < 4; ++i) {
        const int row = 8 * i + (lane >> 3), ch = lane & 7;
        u32x4 v = *(const LAS u32x4*)(stg + row * MX_OROW + ch * 16);
        if (gbase) { const u32x4 g = *(const u32x4*)(gbase + (size_t)row * 256 + ch * 8); float a[8], b[8]; unpack8(v, a); unpack8(g, b);
            v.x = cvtpk(a[0] * b[0], a[1] * b[1]); v.y = cvtpk(a[2] * b[2], a[3] * b[3]); v.z = cvtpk(a[4] * b[4], a[5] * b[5]); v.w = cvtpk(a[6] * b[6], a[7] * b[7]); }
        *(u32x4*)(ybase + (size_t)row * DM + ch * 8) = v;
    }
}
template <int KIND>
__device__ __forceinline__ void mix_unit(unsigned char* ws, int b, int h, int qb, LAS unsigned char* lds, int tid, CvtCtx& cv) {
    constexpr int DK = (KIND == 3) ? 96 : 64, ND0 = DK / 16;
    asm volatile("" : "+v"(tid));
    const int lane = tid & 63, wave = __builtin_amdgcn_readfirstlane(tid >> 6), r32 = lane & 31, hh = lane >> 5;
    const int q0 = qb * 256, qw0 = q0 + 32 * wave, qpos = qw0 + r32;
    const size_t rowb = (size_t)b * SEQ;
    const bf16_t *Qg, *Kg, *Vg; int ldq, ldk, ldv;
    if (KIND == 0) { Qg = (const bf16_t*)(ws + WS_RQ); Kg = (const bf16_t*)(ws + WS_RK); Vg = (const bf16_t*)(ws + WS_RV); ldq = 256; ldk = 256; ldv = 256; }
    else if (KIND == 1) { Qg = (const bf16_t*)(ws + WS_FQ); Kg = (const bf16_t*)(ws + WS_FK); Vg = (const bf16_t*)(ws + WS_FV); ldq = 256; ldk = 256; ldv = 256; }
    else if (KIND == 2) { Qg = (const bf16_t*)(ws + WS_SQ); Kg = (const bf16_t*)(ws + WS_SK); Vg = (const bf16_t*)(ws + WS_SV); ldq = 256; ldk = 256; ldv = 256; }
    else { Qg = (const bf16_t*)(ws + WS_QD); Kg = (const bf16_t*)(ws + WS_KD); Vg = (const bf16_t*)(ws + WS_VD); ldq = 384; ldk = 384; ldv = 256; }
    Qg += rowb * ldq + h * DK; Kg += rowb * ldk + h * DK; Vg += rowb * ldv + h * 64;
    const float* fcg = (const float*)(ws + WS_FCUM) + rowb * 4 + h;
    bf16x8 qf[ND0];
#pragma unroll
    for (int d0 = 0; d0 < ND0; ++d0) qf[d0] = *(const bf16x8*)(Qg + (size_t)qpos * ldq + 16 * d0 + 8 * hh);
    f32x16 o0, o1;
#pragma unroll
    for (int r = 0; r < 16; ++r) { o0[r] = 0.f; o1[r] = 0.f; }
    float m_run = -INFINITY, R_run = 0.f;
    f32x4 ol = {0.f, 0.f, 0.f, 0.f};
    const short one_ = (r32 == 0 || r32 == 8 || r32 == 20 || r32 == 28) ? (short)0x3F80 : (short)0;
    const bf16x8 ones_frag = (bf16x8){one_, one_, one_, one_, one_, one_, one_, one_};
    float lg = 0.f;
    if (KIND == 0) lg = log2f(1.0f - exp2f(-5.0f - (float)h));
    const int NT = (q0 + 256) / 64;
    u32x4 kst0, kst1, vst; float bst = 0.f;
#define MX_LOAD(t_) do { const int k0_ = (t_) * 64; \
        kst0 = *(const u32x4*)(Kg + (size_t)(k0_ + lane) * ldk + wave * 8); \
        if (KIND == 3) { if (wave < 4) kst1 = *(const u32x4*)(Kg + (size_t)(k0_ + lane) * ldk + (8 + wave) * 8); } \
        vst = *(const u32x4*)(Vg + (size_t)(k0_ + 16 * (wave & 3) + (lane >> 2)) * ldv + (wave >> 2) * 32 + (lane & 3) * 8); \
        if (KIND == 1) { if (tid < 64) bst = fcg[(size_t)(k0_ + tid) * 4]; } } while (0)
#define MX_STORE(st_) do { LAS unsigned char* sb_ = lds + (st_) * MX_STAGE; \
        *(LAS u32x4*)(sb_ + wave * 1024 + lane * 16) = kst0; \
        if (KIND == 3) { if (wave < 4) *(LAS u32x4*)(sb_ + (8 + wave) * 1024 + lane * 16) = kst1; } \
        *(LAS u32x4*)(sb_ + MX_KB + (wave >> 2) * 4096 + (wave & 3) * 1024 + lane * 16) = vst; \
        if (KIND == 1) { if (tid < 64) *(LAS float*)(sb_ + MX_KB + MX_VB + tid * 4) = -bst * LOG2E; } } while (0)
    if (KIND == 2) {
        u32x4 kq[4], vq[4];
#pragma unroll
        for (int j = 0; j < 4; ++j) { const int k0_ = (NT - 1 - j) * 64;
            kq[j] = *(const u32x4*)(Kg + (size_t)(k0_ + lane) * ldk + wave * 8);
            vq[j] = *(const u32x4*)(Vg + (size_t)(k0_ + 16 * (wave & 3) + (lane >> 2)) * ldv + (wave >> 2) * 32 + (lane & 3) * 8); }
#pragma unroll
        for (int j = 0; j < 4; ++j) { LAS unsigned char* sb_ = lds + ((NT - 1 - j) % 5) * MX_STAGE;
            *(LAS u32x4*)(sb_ + wave * 1024 + lane * 16) = kq[j];
            *(LAS u32x4*)(sb_ + MX_KB + (wave >> 2) * 4096 + (wave & 3) * 1024 + lane * 16) = vq[j]; }
    } else { MX_LOAD(NT - 1); MX_STORE(0); }
    __syncthreads();
    volatile LAS unsigned* ctl = (volatile LAS unsigned*)(lds + MX_CTL);
    for (int it = 0; it < NT; ++it) {
        const int tw2 = ((qw0 + 31) >> 6) - it;
        const int t = (KIND == 2) ? tw2 : NT - 1 - it, st = (KIND == 2) ? (tw2 >= 0 ? tw2 % 5 : 0) : (it & 1), k0 = t * 64;
        const int tpre = (KIND == 2) ? NT - 5 - it : t - 1;
        const bool pre = (KIND == 2) ? (tpre >= 0) : (it + 1 < NT);
        if (pre) MX_LOAD(tpre);
        if (KIND == 1 || KIND == 3) cvt_issue(cv);
        if ((KIND == 2) ? (tw2 >= 0) : (k0 <= qw0 + 31)) {
            const LAS unsigned char* sb = lds + st * MX_STAGE;
            const LAS unsigned char* kp = sb + hh * 1024 + r32 * 16;
            f32x16 p0, p1;
            if (KIND == 1) {
                const LAS float* bp = (const LAS float*)(sb + MX_KB + MX_VB) + 4 * hh;
#pragma unroll
                for (int q4 = 0; q4 < 4; ++q4) { const f32x4 b0 = *(const LAS f32x4*)(bp + 8 * q4), b1 = *(const LAS f32x4*)(bp + 32 + 8 * q4);
                    p0[4 * q4] = b0.x; p0[4 * q4 + 1] = b0.y; p0[4 * q4 + 2] = b0.z; p0[4 * q4 + 3] = b0.w; p1[4 * q4] = b1.x; p1[4 * q4 + 1] = b1.y; p1[4 * q4 + 2] = b1.z; p1[4 * q4 + 3] = b1.w; }
            } else {
#pragma unroll
                for (int r = 0; r < 16; ++r) { p0[r] = 0.f; p1[r] = 0.f; }
            }
            s16x4 vlo[8], vhi[8]; bf16x8 kf0[ND0], kf1[ND0];
            if (KIND == 1) {
#pragma unroll
                for (int d0 = 0; d0 < ND0; ++d0) { kf0[d0] = *(const LAS bf16x8*)(kp + d0 * 2048); kf1[d0] = *(const LAS bf16x8*)(kp + d0 * 2048 + 512); }
            }
            { const LAS unsigned char* vp = sb + MX_KB + ((lane >> 4) & 1) * 32 + (lane & 3) * 8 + (4 * hh + ((lane & 15) >> 2)) * 64;
#pragma unroll
              for (int ks = 0; ks < 4; ++ks) { vlo[ks] = vtr_read(vp + ks * 1024); vhi[ks] = vtr_read(vp + ks * 1024 + 512); vlo[4 + ks] = vtr_read(vp + 4096 + ks * 1024); vhi[4 + ks] = vtr_read(vp + 4096 + ks * 1024 + 512); } }
            if (KIND == 1) {
                __builtin_amdgcn_sched_barrier(0);
#pragma unroll
                for (int d0 = 0; d0 < ND0; ++d0) { p0 = MFMA32(kf0[d0], qf[d0], p0); p1 = MFMA32(kf1[d0], qf[d0], p1); }
            } else {
#pragma unroll
                for (int d0 = 0; d0 < ND0; ++d0) { const bf16x8 a0 = *(const LAS bf16x8*)(kp + d0 * 2048), a1 = *(const LAS bf16x8*)(kp + d0 * 2048 + 512); p0 = MFMA32(a0, qf[d0], p0); p1 = MFMA32(a1, qf[d0], p1); }
            }
            const bool band = (k0 + 63 > qw0);
            if (KIND == 1 || KIND == 3) {
                if (band) {
#pragma unroll
                    for (int r = 0; r < 16; ++r) { const int kp0 = k0 + crow(r, hh); if (kp0 > qpos) p0[r] = -INFINITY; if (kp0 + 32 > qpos) p1[r] = -INFINITY; }
                }
                float tm = __builtin_fmaxf(__builtin_fmaxf(p0[0], p0[1]), p1[0]), tm2 = __builtin_fmaxf(__builtin_fmaxf(p0[2], p0[3]), p1[1]);
                tm = __builtin_fmaxf(__builtin_fmaxf(tm, p1[2]), p1[3]);
#pragma unroll
                for (int r = 4; r < 16; r += 4) { tm = __builtin_fmaxf(__builtin_fmaxf(tm, p0[r]), p0[r + 1]); tm2 = __builtin_fmaxf(__builtin_fmaxf(tm2, p0[r + 2]), p0[r + 3]);
                    tm = __builtin_fmaxf(__builtin_fmaxf(tm, p1[r]), p1[r + 1]); tm2 = __builtin_fmaxf(__builtin_fmaxf(tm2, p1[r + 2]), p1[r + 3]); }
                tm = pair_max(__builtin_fmaxf(tm, tm2));
                if (__any(tm > m_run + 8.0f)) {
                    const float mn = fmaxf(m_run, tm), al = fast_exp2(m_run - mn);
                    ol[0] *= al; m_run = mn;
#pragma unroll
                    for (int r = 0; r < 16; ++r) { o0[r] *= al; o1[r] *= al; }
                }
#pragma unroll
                for (int r = 0; r < 16; ++r) { p0[r] = fast_exp2(p0[r] - m_run); p1[r] = fast_exp2(p1[r] - m_run); }
            } else if (KIND == 0) {
                const float base = lg * (float)(qpos - k0 - 4 * hh);
#pragma unroll
                for (int r = 0; r < 16; ++r) {
                    const float c0 = (float)((r & 3) + 8 * (r >> 2));
                    float w0 = fast_exp2(base - lg * c0), w1 = fast_exp2(base - lg * (c0 + 32.0f));
                    if (band) { const int kp0 = k0 + crow(r, hh); if (kp0 > qpos) w0 = 0.f; if (kp0 + 32 > qpos) w1 = 0.f; }
                    p0[r] *= w0; p1[r] *= w1;
                }
            } else {
                float sp0[16], sp1[16];
#pragma unroll
                for (int r = 0; r < 16; ++r) {
                    const float z0 = p0[r], z1 = p1[r];
                    float s0 = fmaxf(z0, 0.f) + fast_log2(1.0f + fast_exp2(-fabsf(z0))), s1 = fmaxf(z1, 0.f) + fast_log2(1.0f + fast_exp2(-fabsf(z1)));
                    if (band) { const int kp0 = k0 + crow(r, hh); if (kp0 >= qpos) s0 = 0.f; if (kp0 + 32 >= qpos) s1 = 0.f; }
                    sp0[r] = s0; sp1[r] = s1;
                }
                float glo[8], ghi[8];
#pragma unroll
                for (int q4 = 0; q4 < 4; ++q4) {
                    swap32((sp0[4 * q4] + sp0[4 * q4 + 1]) + (sp0[4 * q4 + 2] + sp0[4 * q4 + 3]), glo[q4], ghi[q4]);
                    swap32((sp1[4 * q4] + sp1[4 * q4 + 1]) + (sp1[4 * q4 + 2] + sp1[4 * q4 + 3]), glo[4 + q4], ghi[4 + q4]);
                }
                float suf[16]; float run = 0.f;
#pragma unroll
                for (int i = 7; i >= 0; --i) { suf[2 * i + 1] = run; run += ghi[i]; suf[2 * i] = run; run += glo[i]; }
#pragma unroll
                for (int r = 0; r < 16; ++r) {
                    const int q4 = r >> 2, e = r & 3;
                    float in0 = 0.f, in1 = 0.f;
#pragma unroll
                    for (int e2 = 3; e2 > e; --e2) { in0 += sp0[4 * q4 + e2]; in1 += sp1[4 * q4 + e2]; }
                    const float a0 = R_run - (hh ? suf[2 * q4 + 1] : suf[2 * q4]) - in0;
                    const float a1 = R_run - (hh ? suf[2 * (4 + q4) + 1] : suf[2 * (4 + q4)]) - in1;
                    float w0 = fast_exp2(p0[r] - sp0[r] + a0), w1 = fast_exp2(p1[r] - sp1[r] + a1);
                    if (band) { const int kp0 = k0 + crow(r, hh); if (kp0 >= qpos) w0 = 0.f; if (kp0 + 32 >= qpos) w1 = 0.f; }
                    p0[r] = w0; p1[r] = w1;
                }
                R_run -= run;
            }
            bf16x8 pf[4];
            { u32x4 w;
              w.x = cvtpk(p0[0], p0[1]); w.y = cvtpk(p0[2], p0[3]); w.z = cvtpk(p0[4], p0[5]); w.w = cvtpk(p0[6], p0[7]); pf[0] = __builtin_bit_cast(bf16x8, w);
              w.x = cvtpk(p0[8], p0[9]); w.y = cvtpk(p0[10], p0[11]); w.z = cvtpk(p0[12], p0[13]); w.w = cvtpk(p0[14], p0[15]); pf[1] = __builtin_bit_cast(bf16x8, w);
              w.x = cvtpk(p1[0], p1[1]); w.y = cvtpk(p1[2], p1[3]); w.z = cvtpk(p1[4], p1[5]); w.w = cvtpk(p1[6], p1[7]); pf[2] = __builtin_bit_cast(bf16x8, w);
              w.x = cvtpk(p1[8], p1[9]); w.y = cvtpk(p1[10], p1[11]); w.z = cvtpk(p1[12], p1[13]); w.w = cvtpk(p1[14], p1[15]); pf[3] = __builtin_bit_cast(bf16x8, w); }
#pragma unroll
            for (int ks = 0; ks < 4; ++ks) {
                const bf16x8 va = (bf16x8){vlo[ks][0], vlo[ks][1], vlo[ks][2], vlo[ks][3], vhi[ks][0], vhi[ks][1], vhi[ks][2], vhi[ks][3]};
                const bf16x8 vb = (bf16x8){vlo[4 + ks][0], vlo[4 + ks][1], vlo[4 + ks][2], vlo[4 + ks][3], vhi[4 + ks][0], vhi[4 + ks][1], vhi[4 + ks][2], vhi[4 + ks][3]};
                o0 = MFMA32(va, pf[ks], o0); o1 = MFMA32(vb, pf[ks], o1);
                if (KIND == 1 || KIND == 3) ol = __builtin_amdgcn_mfma_f32_16x16x32_bf16(ones_frag, pf[ks], ol, 0, 0, 0);
            }
        }
        if (KIND == 1 || KIND == 3) { __builtin_amdgcn_sched_barrier(0); cvt_finish(cv); }
        if (pre) MX_STORE((KIND == 2) ? tpre % 5 : (st ^ 1));
        if (KIND == 2) { const bool done = (tw2 < 0) || !__any(R_run > -64.0f); if (lane == 0) ctl[8 + 8 * (it & 1) + wave] = done ? 1u : 0u; }
        asm volatile("s_waitcnt lgkmcnt(0)\n\ts_barrier" ::: "memory");
        if (KIND == 2) {
            unsigned alld = 1u;
#pragma unroll
            for (int w = 0; w < 8; ++w) alld &= ctl[8 + 8 * (it & 1) + w];
            if (alld) break;
        }
    }
#undef MX_LOAD
#undef MX_STORE
    if (KIND == 1 || KIND == 3) {
        const float inv = fast_rcp(ol[0]);
#pragma unroll
        for (int r = 0; r < 16; ++r) { o0[r] *= inv; o1[r] *= inv; }
    }
    if (KIND == 0) {
        float sm = 0.f;
#pragma unroll
        for (int r = 0; r < 16; ++r) sm += o0[r] + o1[r];
        const float mean = pair_sum(sm) * (1.0f / 64.0f);
#pragma unroll
        for (int r = 0; r < 16; ++r) { o0[r] -= mean; o1[r] -= mean; }
    }
    float ss = 0.f;
#pragma unroll
    for (int r = 0; r < 16; ++r) ss += o0[r] * o0[r] + o1[r] * o1[r];
    const float rn = __builtin_amdgcn_rsqf(pair_sum(ss) * (1.0f / 64.0f) + EPS);
    mix_store_rows(o0, o1, rn, lds, (bf16_t*)(ws + WS_Y) + (rowb + qw0) * DM + KIND * 256 + h * 64, (const bf16_t*)nullptr, lane, wave, r32, hh);
    __syncthreads();
}

__device__ __forceinline__ void mix_unit_ret(unsigned char* ws, int b, int h, int qb, LAS unsigned char* lds, int tid, CvtCtx& cv) {
    constexpr int ND0 = 4;
    asm volatile("" : "+v"(tid));
    const int lane = tid & 63, wave = __builtin_amdgcn_readfirstlane(tid >> 6), r32 = lane & 31, hh = lane >> 5;
    const int q0 = qb * 256, qw0 = q0 + 32 * wave, qpos = qw0 + r32;
    const size_t rowb = (size_t)b * SEQ;
    const bf16_t* Qg = (const bf16_t*)(ws + WS_RQ) + rowb * 256 + h * 64; const bf16_t* Kg = (const bf16_t*)(ws + WS_RK) + rowb * 256 + h * 64; const bf16_t* Vg = (const bf16_t*)(ws + WS_RV) + rowb * 256 + h * 64;
    bf16x8 qf[ND0];
#pragma unroll
    for (int d0 = 0; d0 < ND0; ++d0) qf[d0] = *(const bf16x8*)(Qg + (size_t)qpos * 256 + 16 * d0 + 8 * hh);
    f32x16 o0, o1, sacc;
#pragma unroll
    for (int r = 0; r < 16; ++r) { o0[r] = 0.f; o1[r] = 0.f; sacc[r] = 0.f; }
    const float lg = log2f(1.0f - exp2f(-5.0f - (float)h));
    const int NT = (q0 + 256) / 64;
    const int vrow = 16 * (wave & 3) + (lane >> 2), vcol = (wave >> 2) * 32 + (lane & 3) * 8, voff = (wave >> 2) * 4096 + (wave & 3) * 1024 + lane * 16;
    const int troff = ((lane >> 4) & 1) * 32 + (lane & 3) * 8 + (4 * hh + ((lane & 15) >> 2)) * 64;
    u32x4 kst0, vst;
#define RT_LOAD(it_) do { const int k0_ = (NT - 1 - (it_)) * 64; \
        if ((it_) < 4) kst0 = *(const u32x4*)(Kg + (size_t)(k0_ + lane) * 256 + wave * 8); \
        else kst0 = *(const u32x4*)(Kg + (size_t)(k0_ + vrow) * 256 + vcol); \
        vst = *(const u32x4*)(Vg + (size_t)(k0_ + vrow) * 256 + vcol); } while (0)
#define RT_STORE(st_, it_) do { LAS unsigned char* sb_ = lds + (st_) * MX_STAGE; \
        if ((it_) < 4) *(LAS u32x4*)(sb_ + wave * 1024 + lane * 16) = kst0; \
        else { const float dc = fast_exp2(lg * (float)(q0 - 1 - ((NT - 1 - (it_)) * 64 + vrow))); float f_[8]; unpack8(kst0, f_); \
               u32x4 w_; w_.x = cvtpk(f_[0] * dc, f_[1] * dc); w_.y = cvtpk(f_[2] * dc, f_[3] * dc); w_.z = cvtpk(f_[4] * dc, f_[5] * dc); w_.w = cvtpk(f_[6] * dc, f_[7] * dc); \
               *(LAS u32x4*)(sb_ + voff) = w_; } \
        *(LAS u32x4*)(sb_ + MX_KB + voff) = vst; } while (0)
    RT_LOAD(0); RT_STORE(0, 0);
    __syncthreads();
    for (int it = 0; it < NT; ++it) {
        const int st = it & 1, k0 = (NT - 1 - it) * 64;
        if (it + 1 < NT) RT_LOAD(it + 1);
        const LAS unsigned char* sb = lds + st * MX_STAGE;
        if (it < 4) {
            if (k0 <= qw0 + 31) {
                const LAS unsigned char* kp = sb + hh * 1024 + r32 * 16;
                f32x16 p0, p1;
#pragma unroll
                for (int r = 0; r < 16; ++r) { p0[r] = 0.f; p1[r] = 0.f; }
#pragma unroll
                for (int d0 = 0; d0 < ND0; ++d0) { const bf16x8 a0 = *(const LAS bf16x8*)(kp + d0 * 2048), a1 = *(const LAS bf16x8*)(kp + d0 * 2048 + 512); p0 = MFMA32(a0, qf[d0], p0); p1 = MFMA32(a1, qf[d0], p1); }
                float lgi = lg; asm volatile("" : "+v"(lgi));
                const float base = lgi * (float)(qpos - k0 - 4 * hh);
#pragma unroll
                for (int r = 0; r < 16; ++r) {
                    const float c0 = (float)((r & 3) + 8 * (r >> 2));
                    float w0 = fast_exp2(base - lgi * c0), w1 = fast_exp2(base - lgi * (c0 + 32.0f));
                    const int kp0 = k0 + crow(r, hh); if (kp0 > qpos) w0 = 0.f; if (kp0 + 32 > qpos) w1 = 0.f;
                    p0[r] *= w0; p1[r] *= w1;
                }
                bf16x8 pf[4];
                { u32x4 w;
                  w.x = cvtpk(p0[0], p0[1]); w.y = cvtpk(p0[2], p0[3]); w.z = cvtpk(p0[4], p0[5]); w.w = cvtpk(p0[6], p0[7]); pf[0] = __builtin_bit_cast(bf16x8, w);
                  w.x = cvtpk(p0[8], p0[9]); w.y = cvtpk(p0[10], p0[11]); w.z = cvtpk(p0[12], p0[13]); w.w = cvtpk(p0[14], p0[15]); pf[1] = __builtin_bit_cast(bf16x8, w);
                  w.x = cvtpk(p1[0], p1[1]); w.y = cvtpk(p1[2], p1[3]); w.z = cvtpk(p1[4], p1[5]); w.w = cvtpk(p1[6], p1[7]); pf[2] = __builtin_bit_cast(bf16x8, w);
                  w.x = cvtpk(p1[8], p1[9]); w.y = cvtpk(p1[10], p1[11]); w.z = cvtpk(p1[12], p1[13]); w.w = cvtpk(p1[14], p1[15]); pf[3] = __builtin_bit_cast(bf16x8, w); }
                const LAS unsigned char* vp = sb + MX_KB + troff;
#pragma unroll
                for (int ks = 0; ks < 4; ++ks) {
                    const s16x4 a_lo = vtr_read(vp + ks * 1024), a_hi = vtr_read(vp + ks * 1024 + 512), b_lo = vtr_read(vp + 4096 + ks * 1024), b_hi = vtr_read(vp + 4096 + ks * 1024 + 512);
                    const bf16x8 va = (bf16x8){a_lo[0], a_lo[1], a_lo[2], a_lo[3], a_hi[0], a_hi[1], a_hi[2], a_hi[3]};
                    const bf16x8 vb = (bf16x8){b_lo[0], b_lo[1], b_lo[2], b_lo[3], b_hi[0], b_hi[1], b_hi[2], b_hi[3]};
                    o0 = MFMA32(va, pf[ks], o0); o1 = MFMA32(vb, pf[ks], o1);
                }
            }
        } else {
            const int bd = (wave >> 1) & 1, bk = wave & 1, ks0 = 2 * (wave >> 2);
            const LAS unsigned char* vp = sb + MX_KB + troff + bd * 4096; const LAS unsigned char* kq = sb + troff + bk * 4096;
#pragma unroll
            for (int q = 0; q < 2; ++q) {
                const s16x4 a_lo = vtr_read(vp + (ks0 + q) * 1024), a_hi = vtr_read(vp + (ks0 + q) * 1024 + 512);
                const s16x4 b_lo = vtr_read(kq + (ks0 + q) * 1024), b_hi = vtr_read(kq + (ks0 + q) * 1024 + 512);
                const bf16x8 va = (bf16x8){a_lo[0], a_lo[1], a_lo[2], a_lo[3], a_hi[0], a_hi[1], a_hi[2], a_hi[3]};
                const bf16x8 kb = (bf16x8){b_lo[0], b_lo[1], b_lo[2], b_lo[3], b_hi[0], b_hi[1], b_hi[2], b_hi[3]};
                sacc = MFMA32(va, kb, sacc);
            }
        }
        if (it + 1 < NT) RT_STORE(st ^ 1, it + 1);
        asm volatile("s_waitcnt lgkmcnt(0)\n\ts_barrier" ::: "memory");
    }
#undef RT_LOAD
#undef RT_STORE
    if (NT > 4) {
        const int bd = (wave >> 1) & 1, bk = wave & 1;
        LAS float* sx = (LAS float*)lds + (bd * 2 + bk) * 1024 + lane;
        if (wave >= 4) {
#pragma unroll
            for (int r = 0; r < 16; ++r) sx[r * 64] = sacc[r];
        }
        __syncthreads();
        LAS unsigned char* ksb = lds + 16384;
        if (wave < 4) {
#pragma unroll
            for (int r = 0; r < 16; ++r) {
                const float v = sacc[r] + sx[r * 64];
                const int dv = 32 * bd + crow(r, hh), dk = 32 * bk + r32;
                *(LAS bf16_t*)(ksb + (dk >> 3) * 1024 + dv * 16 + (dk & 7) * 2) = (bf16_t)f2bf(v);
            }
        }
        __syncthreads();
        const LAS unsigned char* kp = ksb + hh * 1024 + r32 * 16;
        f32x16 p0, p1;
#pragma unroll
        for (int r = 0; r < 16; ++r) { p0[r] = 0.f; p1[r] = 0.f; }
#pragma unroll
        for (int d0 = 0; d0 < ND0; ++d0) { const bf16x8 a0 = *(const LAS bf16x8*)(kp + d0 * 2048), a1 = *(const LAS bf16x8*)(kp + d0 * 2048 + 512); p0 = MFMA32(a0, qf[d0], p0); p1 = MFMA32(a1, qf[d0], p1); }
        const float ff = fast_exp2(lg * (float)(qpos - q0 + 1));
#pragma unroll
        for (int r = 0; r < 16; ++r) { o0[r] += p0[r] * ff; o1[r] += p1[r] * ff; }
    }
    float sm = 0.f;
#pragma unroll
    for (int r = 0; r < 16; ++r) sm += o0[r] + o1[r];
    const float mean = pair_sum(sm) * (1.0f / 64.0f);
#pragma unroll
    for (int r = 0; r < 16; ++r) { o0[r] -= mean; o1[r] -= mean; }
    float ss = 0.f;
#pragma unroll
    for (int r = 0; r < 16; ++r) ss += o0[r] * o0[r] + o1[r] * o1[r];
    const float rn = __builtin_amdgcn_rsqf(pair_sum(ss) * (1.0f / 64.0f) + EPS);
    mix_store_rows(o0, o1, rn, lds, (bf16_t*)(ws + WS_Y) + (rowb + qw0) * DM + h * 64, (const bf16_t*)(ws + WS_RG) + (rowb + qw0) * 256 + h * 64, lane, wave, r32, hh);
    __syncthreads();
}
template <int SET>
__device__ __forceinline__ void mixers_mfma(const Params& p, unsigned char* ws, int layer, LAS unsigned char* lds) {
    const int tid = tid_();
    CvtCtx cv; cv.eu = p.expert_u; cv.ev = p.expert_v; cv.gain = p.norm_ffn; cv.ws = ws; cv.g0 = (size_t)bid_() * NTHREADS + tid; cv.gs = (size_t)gridDim.x * NTHREADS;
    cv.j = (SET == 1 && layer == 0) ? 0 : CVT_NJ;
#pragma unroll
    for (int q = 0; q < 4; ++q) cv.v[q] = (f32x4){0.f, 0.f, 0.f, 0.f};
    unsigned* qhead = (unsigned*)(ws + WS_CTL) + CW_QUEUE + 64 * (2 * layer + SET);
    volatile LAS unsigned* ctl = (volatile LAS unsigned*)(lds + MX_CTL);
    for (;;) {
        if (tid == 0) ctl[0] = atomicAdd(qhead, 1u);
        __syncthreads();
        const unsigned i = ctl[0];
        __syncthreads();
        if (i >= (unsigned)(MIX_UNITS / 2)) break;
        int kind, qb; const int bh = (int)(i & 15u);
        if (SET == 1) { qb = 15 - (int)(i >> 5); kind = (i & 16u) ? 3 : 1; }
        else if (i < 80u) { kind = 0; qb = 15 - (int)(i >> 4); }
        else if (i < 336u) { kind = 2; qb = 15 - (int)((i - 80u) >> 4); }
        else { kind = 0; qb = 10 - (int)((i - 336u) >> 4); }
        const int b = bh >> 2, h = bh & 3;
        if (SET == 1) { if (kind == 1) mix_unit<1>(ws, b, h, qb, lds, tid, cv); else mix_unit<3>(ws, b, h, qb, lds, tid, cv); }
        else { if (kind == 0) mix_unit_ret(ws, b, h, qb, lds, tid, cv); else mix_unit<2>(ws, b, h, qb, lds, tid, cv); }
    }
    if (SET == 1) { while (cv.j < CVT_NJ) { cvt_issue(cv); cvt_finish(cv); } }
}

#define TOPK_INSERT(tv, ti, vv, ii) do { float v_ = (vv); int i_ = (ii); \
    _Pragma("unroll") for (int j_ = 0; j_ < 16; ++j_) { const bool gt_ = v_ > tv[j_]; const float nv_ = gt_ ? tv[j_] : v_; const int ni_ = gt_ ? ti[j_] : i_; \
        tv[j_] = gt_ ? v_ : tv[j_]; ti[j_] = gt_ ? i_ : ti[j_]; v_ = nv_; i_ = ni_; } } while (0)
__device__ __forceinline__ void peer_score_naive(unsigned char* ws, int layer) {
    const int tid = tid_();
    const bf16_t* SK = (const bf16_t*)(ws + WS_SKEY) + (size_t)layer * 8 * 2 * 128 * 128;
    for (int u = bid_(); u < 256; u += gridDim.x) {
        const int h = u >> 5, t = (u & 31) * 512 + tid;
        const bf16_t* qp = (const bf16_t*)(ws + WS_QP) + (size_t)t * 2048 + h * 256;
        float sv[2][16]; int si[2][16];
#pragma unroll
        for (int p = 0; p < 2; ++p) {
#pragma unroll
            for (int j = 0; j < 16; ++j) { sv[p][j] = -INFINITY; si[p][j] = 0; }
            const bf16_t* kp = SK + (size_t)(h * 2 + p) * 128 * 128;
            for (int n = 0; n < 128; ++n) {
                const float s = dot_rows<16>(kp + (size_t)n * 128, qp + p * 128);
                TOPK_INSERT(sv[p], si[p], s, n);
            }
        }
        float bv[16]; int bi[16];
#pragma unroll
        for (int j = 0; j < 16; ++j) { bv[j] = -INFINITY; bi[j] = 0; }
#pragma unroll
        for (int a = 0; a < 16; ++a)
#pragma unroll
            for (int b = 0; b < 16; ++b) { TOPK_INSERT(bv, bi, sv[0][a] + sv[1][b], si[0][a] * 128 + si[1][b]); }
        float sum = 0.f; const float bmax = bv[0];
#pragma unroll
        for (int j = 0; j < 16; ++j) { bv[j] = __expf(bv[j] - bmax); sum += bv[j]; }
        const float inv = 1.0f / sum;
        int* eo = (int*)(ws + WS_EIDX) + (size_t)t * 128 + h * 16; float* go = (float*)(ws + WS_EGATE) + (size_t)t * 128 + h * 16;
#pragma unroll
        for (int j = 0; j < 16; ++j) { eo[(j & 7) * 16 + (j >> 3) - 14 * h] = bi[j]; go[(j & 7) * 16 + (j >> 3) - 14 * h] = bv[j] * inv; }
    }
}


__device__ __forceinline__ int fkey(float f) { const int i = __builtin_bit_cast(int, f); return i ^ ((i >> 31) & 0x7fffffff); }
__device__ __forceinline__ float keyf(int k) { const int i = k ^ ((k >> 31) & 0x7fffffff); return __builtin_bit_cast(float, i); }
#define KINS(t, x) do { int x_ = (x); _Pragma("unroll") for (int j_ = 0; j_ < 16; ++j_) { const int hi_ = max(t[j_], x_); x_ = min(t[j_], x_); t[j_] = hi_; } } while (0)
#define KCE(a, b) do { const int hi_ = max(a, b), lo_ = min(a, b); a = hi_; b = lo_; } while (0)
#define KC(i, j) KCE(a[i], a[j])
__device__ __forceinline__ void sort16_desc(int (&a)[16]) {
    KC(0, 13); KC(1, 12); KC(2, 15); KC(3, 14); KC(4, 8); KC(5, 6); KC(7, 11); KC(9, 10);
    KC(0, 5); KC(1, 7); KC(2, 9); KC(3, 4); KC(6, 13); KC(8, 14); KC(10, 15); KC(11, 12);
    KC(0, 1); KC(2, 3); KC(4, 5); KC(6, 8); KC(7, 9); KC(10, 11); KC(12, 13); KC(14, 15);
    KC(0, 2); KC(1, 3); KC(4, 10); KC(5, 11); KC(6, 7); KC(8, 9); KC(12, 14); KC(13, 15);
    KC(1, 2); KC(3, 12); KC(4, 6); KC(5, 7); KC(8, 10); KC(9, 11); KC(13, 14);
    KC(1, 4); KC(2, 6); KC(5, 8); KC(7, 10); KC(9, 13); KC(11, 14);
    KC(2, 4); KC(3, 6); KC(9, 12); KC(11, 13);
    KC(3, 5); KC(6, 8); KC(7, 9); KC(10, 12);
    KC(3, 4); KC(5, 6); KC(7, 8); KC(9, 10); KC(11, 12);
    KC(6, 7); KC(8, 9);
}
#undef KC
__device__ __forceinline__ void merge16_desc(int (&a)[16], const int (&b)[16]) {
#pragma unroll
    for (int i = 0; i < 16; ++i) a[i] = max(a[i], b[15 - i]);
#pragma unroll
    for (int j = 8; j > 0; j >>= 1)
#pragma unroll
        for (int i = 0; i < 16; ++i) { const int l = i ^ j; if (l > i) KCE(a[i], a[l]); }
}
__device__ __forceinline__ void hquant_rows8(unsigned char* ws, const float* gain, int r0  , int lane) {
    const GAS float* pp = (const GAS float*)(ws + WS_PART2);
    float pa = pp[(size_t)(r0 + (lane >> 4)) * 16 + (lane & 15)], pb = pp[(size_t)(r0 + 4 + (lane >> 4)) * 16 + (lane & 15)];
    u32x4 w[8][2];
#pragma unroll
    for (int i = 0; i < 8; ++i) { const GAS u32x4* xr = (const GAS u32x4*)((const GAS bf16_t*)(ws + WS_XB) + (size_t)(r0 + i) * DM + 16 * lane); w[i][0] = xr[0]; w[i][1] = xr[1]; }
    f32x4 gv[4];
#pragma unroll
    for (int q = 0; q < 4; ++q) gv[q] = *(const GAS f32x4*)((const GAS float*)gain + 16 * lane + 4 * q);
    pa += dpp_xor1f(pa); pa += dpp_xor2f(pa); pa += dpp_xor4f(pa); pa += dpp_xor8f(pa);
    pb += dpp_xor1f(pb); pb += dpp_xor2f(pb); pb += dpp_xor4f(pb); pb += dpp_xor8f(pb);
#pragma unroll
    for (int i = 0; i < 8; ++i) {
        const float ssum = __builtin_bit_cast(float, __builtin_amdgcn_readlane(__builtin_bit_cast(int, i < 4 ? pa : pb), 16 * (i & 3)));
        const float rs = __builtin_amdgcn_rsqf(ssum * (1.0f / DM) + EPS);
        float h[16]; float am = 0.f;
        unpack8(w[i][0], h); unpack8(w[i][1], h + 8);
#pragma unroll
        for (int q = 0; q < 4; ++q) { const f32x4 g = gv[q]; h[4 * q] *= rs * g.x; h[4 * q + 1] *= rs * g.y; h[4 * q + 2] *= rs * g.z; h[4 * q + 3] *= rs * g.w; }
#pragma unroll
        for (int k = 0; k < 16; ++k) am = fmaxf(am, fabsf(h[k]));
        am = fmaxf(am, dpp_xor1f(am)); am = fmaxf(am, dpp_xor2f(am)); am = fmaxf(am, dpp_xor4f(am));
        const float sc = am > 0.f ? 127.0f / am : 0.f;
        u32x4 o; o.x = pk4_i8(h[0] * sc, h[1] * sc, h[2] * sc, h[3] * sc); o.y = pk4_i8(h[4] * sc, h[5] * sc, h[6] * sc, h[7] * sc); o.z = pk4_i8(h[8] * sc, h[9] * sc, h[10] * sc, h[11] * sc); o.w = pk4_i8(h[12] * sc, h[13] * sc, h[14] * sc, h[15] * sc);
        *(u32x4*)(ws + WS_HQ + (size_t)(r0 + i) * DM + 16 * lane) = o;
        if ((lane & 7) == 0) ((float*)(ws + WS_HS))[(size_t)(r0 + i) * 8 + (lane >> 3)] = am * (1.0f / 127.0f);
    }
}
constexpr int PS_UNITS = 512;
__device__ __forceinline__ void peer_score_mfma(unsigned char* ws, int layer, LAS unsigned char* lds, const float* hq_gain) {
    const int tid = tid_(), lane = tid & 63, wave = __builtin_amdgcn_readfirstlane(tid >> 6), r32 = lane & 31, hh = lane >> 5;
    const bf16_t* SKg = (const bf16_t*)(ws + WS_SKEY) + (size_t)layer * 8 * 2 * 128 * 128;
    LAS unsigned char* slot = lds + 65536 + tid * 36;
    for (int u0 = 2 * bid_(); u0 < PS_UNITS; u0 += 2 * gridDim.x) {
        const int h = u0 >> 6;
#define PS_QROW(u_) ((const bf16_t*)(ws + WS_QP) + ((size_t)((((u_) & 63) * 256 + 32 * wave) >> 5) * 8 + h) * (2 * 8 * 2 * 32 * 8) + (size_t)(hh * 32 + r32) * 8)
        bf16x8 qf[8];
        { const bf16_t* q0_ = PS_QROW(u0);
#pragma unroll
          for (int k = 0; k < 8; ++k) qf[k] = *(const bf16x8*)(q0_ + k * (2 * 32 * 8)); }
#pragma unroll
        for (int i = 0; i < 8; ++i) {
            const int x = tid + 512 * i, pp = x >> 11, n = (x >> 4) & 127, c = x & 15;
            const u32x4 v = *(const u32x4*)(SKg + ((size_t)(h * 2 + pp) * 128 + n) * 128 + 8 * c);
            *(LAS u32x4*)(lds + pp * 32768 + c * 2048 + n * 16) = v;
        }
        __syncthreads();
      int fin0[16], fin1[16];
      LAS int* park = (LAS int*)(lds + 65536) + tid;
#pragma unroll
      for (int rep = 0; rep < 2; ++rep) {
        const int u = u0 + rep;
        const bf16_t* qrow = PS_QROW(u);
        const bf16_t* qnext = PS_QROW(u0 + 1);
#pragma unroll
        for (int pp = 0; pp < 2; ++pp) {
            const LAS unsigned char* kp = lds + pp * 32768 + hh * 2048 + r32 * 16;
            int top[16];
#pragma unroll
            for (int half = 0; half < 2; ++half) {
                int ga[16], gb[16];
#pragma unroll
                for (int q = 0; q < 2; ++q) {
                    const int nb = 2 * half + q;
                    f32x16 acc;
#pragma unroll
                    for (int r = 0; r < 16; ++r) acc[r] = 0.f;
#pragma unroll
                    for (int k = 0; k < 8; ++k) { const bf16x8 a = *(const LAS bf16x8*)(kp + k * 4096 + nb * 512); acc = MFMA32(a, qf[k], acc); }
                    if (nb == 3) { const bf16_t* qn_ = (pp == 0) ? qrow + (8 * 2 * 32 * 8) : qnext;
#pragma unroll
                        for (int k = 0; k < 8; ++k) qf[k] = *(const bf16x8*)(qn_ + k * (2 * 32 * 8));
                    }
#pragma unroll
                    for (int r = 0; r < 16; ++r) { const int n = 32 * nb + crow(r, 0) + 4 * hh; const int key = (fkey(acc[r]) & ~127) | n; if (q == 0) ga[r] = key; else gb[r] = key; }
                }
                sort16_desc(ga); sort16_desc(gb); merge16_desc(ga, gb);
                if (half == 0) {
#pragma unroll
                    for (int j = 0; j < 16; ++j) top[j] = ga[j];
                } else merge16_desc(top, ga);
            }
            if (rep == 0) {
#pragma unroll
                for (int j = 0; j < 16; ++j) park[(pp * 16 + j) * NTHREADS] = top[j];
                if (pp == 1) hquant_rows8(ws, hq_gain, 64 * (u0 >> 1) + 8 * wave, lane);
            } else {
                int oth[16];
#pragma unroll
                for (int j = 0; j < 16; ++j) { const int a_ = park[(pp * 16 + j) * NTHREADS]; const auto r_ = __builtin_amdgcn_permlane32_swap((unsigned)a_, (unsigned)top[j], false, false); top[j] = (int)r_[0]; oth[j] = (int)r_[1]; }
                merge16_desc(top, oth);
#pragma unroll
                for (int j = 0; j < 16; ++j) { if (pp == 0) fin0[j] = top[j]; else fin1[j] = top[j]; }
            }
        }
      }
      {
        __syncthreads();
        const int tok0 = ((u0 + hh) & 63) * 256 + 32 * wave;
#pragma unroll
        for (int q = 0; q < 4; ++q) {
            *(LAS unsigned*)(slot + 4 * q) = (unsigned)(fin0[4 * q] & 127) | ((unsigned)(fin0[4 * q + 1] & 127) << 8) | ((unsigned)(fin0[4 * q + 2] & 127) << 16) | ((unsigned)(fin0[4 * q + 3] & 127) << 24);
            *(LAS unsigned*)(slot + 16 + 4 * q) = (unsigned)(fin1[4 * q] & 127) | ((unsigned)(fin1[4 * q + 1] & 127) << 8) | ((unsigned)(fin1[4 * q + 2] & 127) << 16) | ((unsigned)(fin1[4 * q + 3] & 127) << 24);
        }
        float v0[16], v1[16];
#pragma unroll
        for (int j = 0; j < 16; ++j) { v0[j] = keyf(fin0[j] & ~127); v1[j] = keyf(fin1[j] & ~127); }
#define CAND(a, b) ((fkey(v0[a] + v1[b]) & ~255) | ((a) * 16 + (b)))
        int best[16], c1[16], c2[16];
        best[0] = CAND(0, 0); best[1] = CAND(0, 1); best[2] = CAND(0, 2); best[3] = CAND(0, 3); best[4] = CAND(0, 4); best[5] = CAND(0, 5); best[6] = CAND(0, 6); best[7] = CAND(0, 7); best[8] = CAND(0, 8); best[9] = CAND(0, 9); best[10] = CAND(0, 10); best[11] = CAND(0, 11); best[12] = CAND(0, 12); best[13] = CAND(0, 13); best[14] = CAND(0, 14); best[15] = CAND(0, 15);
        c1[0] = CAND(1, 0); c1[1] = CAND(1, 1); c1[2] = CAND(1, 2); c1[3] = CAND(1, 3); c1[4] = CAND(1, 4); c1[5] = CAND(1, 5); c1[6] = CAND(1, 6); c1[7] = CAND(1, 7); c1[8] = CAND(2, 0); c1[9] = CAND(2, 1); c1[10] = CAND(2, 2); c1[11] = CAND(2, 3); c1[12] = CAND(2, 4); c1[13] = CAND(3, 0); c1[14] = CAND(3, 1); c1[15] = CAND(3, 2);
        c2[0] = CAND(3, 3); c2[1] = CAND(4, 0); c2[2] = CAND(4, 1); c2[3] = CAND(4, 2); c2[4] = CAND(5, 0); c2[5] = CAND(5, 1); c2[6] = CAND(6, 0); c2[7] = CAND(6, 1); c2[8] = CAND(7, 0); c2[9] = CAND(7, 1); c2[10] = CAND(8, 0); c2[11] = CAND(9, 0); c2[12] = CAND(10, 0); c2[13] = CAND(11, 0); c2[14] = CAND(12, 0); c2[15] = CAND(13, 0);
        sort16_desc(c1); sort16_desc(c2);
        merge16_desc(best, c1); merge16_desc(best, c2);
        KINS(best, CAND(14, 0)); KINS(best, CAND(15, 0));
#undef CAND
        const size_t ob = (size_t)(tok0 + r32) * 128 + 2 * h;
        { int* eo = (int*)(ws + WS_EIDX) + ob;
#pragma unroll
          for (int g = 0; g < 8; ++g) { const int ab0 = best[g] & 255, ab1 = best[g + 8] & 255;
              const int e0 = *(const LAS unsigned char*)(slot + (ab0 >> 4)) * 128 + *(const LAS unsigned char*)(slot + 16 + (ab0 & 15));
              const int e1 = *(const LAS unsigned char*)(slot + (ab1 >> 4)) * 128 + *(const LAS unsigned char*)(slot + 16 + (ab1 & 15));
              *(u32x2*)(eo + g * 16) = (u32x2){(unsigned)e0, (unsigned)e1}; } }
        asm volatile("" ::: "memory");
        { float gv[16]; const float bmax = keyf(best[0] & ~255); float gsum = 0.f;
#pragma unroll
          for (int j = 0; j < 16; ++j) { gv[j] = __expf(keyf(best[j] & ~255) - bmax); gsum += gv[j]; }
          const float ginv = fast_rcp(gsum);
          float* go = (float*)(ws + WS_EGATE) + ob;
#pragma unroll
          for (int g = 0; g < 8; ++g) *(f32x2*)(go + g * 16) = (f32x2){gv[g] * ginv, gv[g + 8] * ginv}; }
      }
#undef PS_QROW
        __syncthreads();
    }
}

__device__ __forceinline__ void unpack16_fp8(const u32x4 w, float* d) {
    f32x2 t;
    t = __builtin_amdgcn_cvt_pk_f32_fp8((int)w.x, false); d[0] = t.x; d[1] = t.y; t = __builtin_amdgcn_cvt_pk_f32_fp8((int)w.x, true); d[2] = t.x; d[3] = t.y;
    t = __builtin_amdgcn_cvt_pk_f32_fp8((int)w.y, false); d[4] = t.x; d[5] = t.y; t = __builtin_amdgcn_cvt_pk_f32_fp8((int)w.y, true); d[6] = t.x; d[7] = t.y;
    t = __builtin_amdgcn_cvt_pk_f32_fp8((int)w.z, false); d[8] = t.x; d[9] = t.y; t = __builtin_amdgcn_cvt_pk_f32_fp8((int)w.z, true); d[10] = t.x; d[11] = t.y;
    t = __builtin_amdgcn_cvt_pk_f32_fp8((int)w.w, false); d[12] = t.x; d[13] = t.y; t = __builtin_amdgcn_cvt_pk_f32_fp8((int)w.w, true); d[14] = t.x; d[15] = t.y;
}
__device__ __forceinline__ void peer_gather(const Params& p, int layer, int dry = 0) {
    unsigned char* ws = launder(p.ws);
    const int tid = tid_(), lane = tid & 63, wave = tid >> 6;
    const int gw = bid_() * NWAVES + wave, NGW = gridDim.x * NWAVES;
    const unsigned char* EU = ws + WS_EU + (size_t)layer * 16384 * 1024; const unsigned char* EV = ws + WS_EV + (size_t)layer * 16384 * 1024;
    const float* gn = p.norm_ffn + layer * DM;
    const bool last = (layer == DEPTH - 1);
    for (int t = gw; t < NTOK; t += NGW) {
        float* xr = (float*)(ws + WS_XR) + (size_t)t * DM + 16 * lane;
        float x1[16], hh[16], acc[16];
#pragma unroll
        for (int i = 0; i < 4; ++i) { const f32x4 a = *(const f32x4*)(xr + 4 * i); x1[4 * i] = a.x; x1[4 * i + 1] = a.y; x1[4 * i + 2] = a.z; x1[4 * i + 3] = a.w; }
        const float rs = rstd2_of(ws, t);
#pragma unroll
        for (int i = 0; i < 4; ++i) { const f32x4 g = *(const f32x4*)(gn + 16 * lane + 4 * i); hh[4 * i] = x1[4 * i] * rs * g.x; hh[4 * i + 1] = x1[4 * i + 1] * rs * g.y; hh[4 * i + 2] = x1[4 * i + 2] * rs * g.z; hh[4 * i + 3] = x1[4 * i + 3] * rs * g.w; }
#pragma unroll
        for (int i = 0; i < 16; ++i) acc[i] = 0.f;
        const int* ei = (const int*)(ws + WS_EIDX) + (size_t)t * 128; const float* eg = (const float*)(ws + WS_EGATE) + (size_t)t * 128;
        for (int hd = 0; hd < 8; ++hd) {
            const int slot = (lane >> 2) & 15;
            const int e_l = ei[hd * 16 + slot]; const float g_l = eg[hd * 16 + slot];
            float part[16];
#pragma unroll
            for (int j = 0; j < 16; ++j) {
                const int e = __builtin_amdgcn_readlane(e_l, 4 * j);
                const u32x4 w0 = *(const u32x4*)(EU + (size_t)e * 1024 + 16 * lane);
                float f[16], s = 0.f;
                unpack16_fp8(w0, f);
#pragma unroll
                for (int i = 0; i < 16; ++i) s += hh[i] * f[i];
                part[j] = s;
            }
            float q8[8], q4[4], q2[2], q1;
            { const bool up = (lane & 32) != 0;
#pragma unroll
              for (int i = 0; i < 8; ++i) { const float mine = up ? part[i + 8] : part[i], theirs = up ? part[i] : part[i + 8]; q8[i] = mine + __shfl_xor(theirs, 32); } }
            { const bool up = (lane & 16) != 0;
#pragma unroll
              for (int i = 0; i < 4; ++i) { const float mine = up ? q8[i + 4] : q8[i], theirs = up ? q8[i] : q8[i + 4]; q4[i] = mine + __shfl_xor(theirs, 16); } }
            { const bool up = (lane & 8) != 0;
#pragma unroll
              for (int i = 0; i < 2; ++i) { const float mine = up ? q4[i + 2] : q4[i], theirs = up ? q4[i] : q4[i + 2]; q2[i] = mine + __shfl_xor(theirs, 8); } }
            { const bool up = (lane & 4) != 0; const float mine = up ? q2[1] : q2[0], theirs = up ? q2[0] : q2[1]; q1 = mine + __shfl_xor(theirs, 4); }
            q1 += __shfl_xor(q1, 2); q1 += __shfl_xor(q1, 1);
            q1 *= (1.0f / EU_SCALE);
            const float act = 0.5f * q1 * (1.0f + erff(q1 * 0.70710678118654752f));
            const float c_l = g_l * act;
#pragma unroll
            for (int j = 0; j < 16; ++j) {
                const int e = __builtin_amdgcn_readlane(e_l, 4 * j);
                const float c = __builtin_bit_cast(float, __builtin_amdgcn_readlane(__builtin_bit_cast(int, c_l), 4 * j));
                const u32x4 w0 = *(const u32x4*)(EV + (size_t)e * 1024 + 16 * lane);
                float f[16];
                unpack16_fp8(w0, f);
#pragma unroll
                for (int i = 0; i < 16; ++i) acc[i] += c * f[i];
            }
        }
        float s = 0.f;
#pragma unroll
        for (int i = 0; i < 16; ++i) { x1[i] += acc[i] * (1.0f / EV_SCALE); s += x1[i] * x1[i]; }
        s = wave_sum(s);
        if (dry) continue;
        if (!last) {
#pragma unroll
            for (int i = 0; i < 4; ++i) *(f32x4*)(xr + 4 * i) = (f32x4){x1[4 * i], x1[4 * i + 1], x1[4 * i + 2], x1[4 * i + 3]};
            bf16_t* xb = (bf16_t*)(ws + WS_XB) + (size_t)t * DM + 16 * lane;
            store8_bf16(xb, x1); store8_bf16(xb + 8, x1 + 8);
            if (lane == 0) ((float*)(ws + WS_SS1))[t] = s;
        } else {
            const float r = 1.0f / sqrtf(s * (1.0f / DM) + EPS);
            float* o = p.out + (size_t)t * DM + 16 * lane; const float* gf = p.norm_final + 16 * lane;
#pragma unroll
            for (int i = 0; i < 4; ++i) { const f32x4 g = *(const f32x4*)(gf + 4 * i); *(f32x4*)(o + 4 * i) = (f32x4){x1[4 * i] * r * g.x, x1[4 * i + 1] * r * g.y, x1[4 * i + 2] * r * g.z, x1[4 * i + 3] * r * g.w}; }
        }
    }
}


__device__ __forceinline__ float dot16_fp8(const u32x4 w, const float* h) {
    float f[16]; unpack16_fp8(w, f); float s = 0.f;
#pragma unroll
    for (int i = 0; i < 16; ++i) s += h[i] * f[i];
    return s;
}
__device__ __forceinline__ void gather_u(const Params& p, int layer, LAS unsigned char* lds) {
    unsigned char* ws = launder(p.ws);
    const int tid = tid_(), lane = tid & 63, wave = __builtin_amdgcn_readfirstlane(tid >> 6), sl = lane & 7, eg = lane >> 3;
    const unsigned char* EU = ws + WS_EU + (size_t)layer * 16384 * 1024;
    const unsigned sl16 = 16u * sl, eg64 = 64u * eg, pdo = (16u * eg + 2u * sl) * 2u;
    for (int unit = bid_(); unit < 256; unit += gridDim.x) {
        const int x = unit & 7, j = unit >> 3;
        unsigned char* pd = ws + WS_PD + (size_t)x * NTOK * 128 * 2;
        const int tb = 512 * j + 64 * wave;
        const unsigned char* eub = EU + (size_t)x * 16384 * 128;
        const unsigned char* eib = ws + WS_EIDX;
        const unsigned char* hqb = ws + WS_HQ + 128 * x;
        u32x4 wA[16], wB[16]; u32x4 idg, hqg; float hsg;
        LAS unsigned char* wl = lds + wave * 2048;
#define GU_GLD_IDS(t_) do { if (lane < 32) idg = *(const u32x4*)(eib + (size_t)(t_) * 512 + 16u * lane); } while (0)
#define GU_GLD_X(t_) do { if (lane < 8) hqg = *(const u32x4*)(hqb + (size_t)(t_) * DM + 16u * lane); if (lane == 0) hsg = ((const float*)(ws + WS_HS))[(size_t)(t_) * 8 + x]; } while (0)
#define GU_LST_IDS(s_) do { if (lane < 32) *(LAS u32x4*)(wl + (s_) * 512 + 16 * lane) = idg; } while (0)
#define GU_LST_X(s_) do { if (lane < 8) *(LAS u32x4*)(wl + 1024 + (s_) * 160 + 16 * lane) = hqg; if (lane == 0) *(LAS float*)(wl + 1024 + (s_) * 160 + 128) = hsg; } while (0)
#define GU_LLD_IDS(dst, s_) do { const LAS u32x4* ei_ = (const LAS u32x4*)(wl + (s_) * 512 + eg64); _Pragma("unroll") for (int i = 0; i < 4; ++i) { const u32x4 e4_ = ei_[i]; dst[4 * i] = (int)e4_.x; dst[4 * i + 1] = (int)e4_.y; dst[4 * i + 2] = (int)e4_.z; dst[4 * i + 3] = (int)e4_.w; } } while (0)
#define GU_IDS(dst, t_) do { const u32x4* ei_ = (const u32x4*)(eib + (size_t)(t_) * 512 + eg64); _Pragma("unroll") for (int i = 0; i < 4; ++i) { const u32x4 e4_ = ei_[i]; dst[4 * i] = (int)e4_.x; dst[4 * i + 1] = (int)e4_.y; dst[4 * i + 2] = (int)e4_.z; dst[4 * i + 3] = (int)e4_.w; } } while (0)
#define GU_PCS(wd, ids) do { _Pragma("unroll") for (int i = 0; i < 16; ++i) wd[i] = *(const u32x4*)(eub + (unsigned)(((unsigned)ids[i] << 7) + sl16)); } while (0)
#define GU_X(t_) do { hqn = *(const u32x4*)(hqb + (size_t)(t_) * DM + sl16); hsn = ((const float*)(ws + WS_HS))[(size_t)(t_) * 8 + x] * (1.0f / EU_SCALE); } while (0)
#define GU_TOKEN(W, WN, tt_) do { \
            const int t = tb + (tt_), tn2 = tb + ((tt_) + 2 < 64 ? (tt_) + 2 : 63), tn3 = tb + ((tt_) + 3 < 64 ? (tt_) + 3 : 63); \
              \
            int idn[16]; GU_LLD_IDS(idn, ((tt_) + 1) & 1); \
            const u32x4 hq = *(const LAS u32x4*)(wl + 1024 + ((tt_) & 1) * 160 + sl16); const float hs = *(const LAS float*)(wl + 1024 + ((tt_) & 1) * 160 + 128) * (1.0f / EU_SCALE); \
            __builtin_amdgcn_s_setprio(2); GU_PCS(WN, idn); __builtin_amdgcn_s_setprio(0);                 \
            GU_LST_IDS((tt_) & 1); GU_LST_X(((tt_) + 1) & 1); \
            GU_GLD_IDS(tn3); GU_GLD_X(tn2); \
            int part[16]; \
              \
            _Pragma("unroll") for (int i = 0; i < 16; ++i) { const u32x4 wp = W[i]; int a_ = __builtin_amdgcn_sdot4((int)wp.x, (int)hq.x, 0, true); a_ = __builtin_amdgcn_sdot4((int)wp.y, (int)hq.y, a_, false); \
                a_ = __builtin_amdgcn_sdot4((int)wp.z, (int)hq.z, a_, false); part[i] = __builtin_amdgcn_sdot4((int)wp.w, (int)hq.w, a_, false); } \
            int q8[8], q4[4], q2[2]; \
            { const bool up = (lane & 4) != 0; _Pragma("unroll") for (int m = 0; m < 8; ++m) { const int mine = up ? part[m + 8] : part[m]; q8[m] = mine + dpp_xor4(part[m], part[m + 8]); } } \
            { const bool up = (lane & 2) != 0; _Pragma("unroll") for (int m = 0; m < 4; ++m) { const int s1 = q8[m] + dpp_xor2(q8[m]), s2 = q8[m + 4] + dpp_xor2(q8[m + 4]); q4[m] = up ? s2 : s1; } } \
            { const bool up = (lane & 1) != 0; _Pragma("unroll") for (int m = 0; m < 2; ++m) { const int s1 = q4[m] + dpp_xor1(q4[m]), s2 = q4[m + 2] + dpp_xor1(q4[m + 2]); q2[m] = up ? s2 : s1; } } \
              \
            *(h16x2*)(pd + (size_t)t * 256 + pdo) = (h16x2){(_Float16)((float)q2[0] * hs), (_Float16)((float)q2[1] * hs)}; } while (0)
        GU_GLD_IDS(tb); GU_LST_IDS(0); GU_GLD_IDS(tb + 1); GU_LST_IDS(1); GU_GLD_X(tb); GU_LST_X(0);
        { int id0[16]; GU_LLD_IDS(id0, 0); GU_PCS(wA, id0); }
        GU_GLD_IDS(tb + 2); GU_GLD_X(tb + 1);
        for (int tt = 0; tt < 64; tt += 2) { GU_TOKEN(wA, wB, tt); GU_TOKEN(wB, wA, tt + 1); }
#undef GU_TOKEN
#undef GU_IDS
#undef GU_PCS
#undef GU_X
#undef GU_GLD_IDS
#undef GU_GLD_X
#undef GU_LST_IDS
#undef GU_LST_X
#undef GU_LLD_IDS
    }
}
__device__ __forceinline__ float erf_as(float x) {
    const float ax = fabsf(x), t = fast_rcp(1.0f + 0.3275911f * ax);
    const float poly = t * (0.254829592f + t * (-0.284496736f + t * (1.421413741f + t * (-1.453152027f + t * 1.061405429f))));
    const float y = 1.0f - poly * fast_exp2(-ax * ax * LOG2E);
    return copysignf(y, x);
}
__device__ __forceinline__ void gather_act(const Params& p) {
    unsigned char* ws = launder(p.ws);
    const size_t g0 = (size_t)bid_() * NTHREADS + tid_(), gs = (size_t)gridDim.x * NTHREADS;
    const h16x4* pd = (const h16x4*)(ws + WS_PD); const f32x4* gt = (const f32x4*)(ws + WS_EGATE); unsigned* c8 = (unsigned*)(ws + WS_C); float* csv = (float*)(ws + WS_CS);
    constexpr size_t N4 = (size_t)NTOK * 128 / 4;
    for (size_t i = g0; i < N4; i += gs) {
        h16x4 ph[8];
#pragma unroll
        for (int x = 0; x < 8; ++x) ph[x] = pd[i + (size_t)x * N4];
        f32x4 a = {0.f, 0.f, 0.f, 0.f};
#pragma unroll
        for (int x = 0; x < 8; ++x) { a[0] += (float)ph[x][0]; a[1] += (float)ph[x][1]; a[2] += (float)ph[x][2]; a[3] += (float)ph[x][3]; }
        const f32x4 g = gt[i]; f32x4 r;
#pragma unroll
        for (int q = 0; q < 4; ++q) { const float v = a[q]; r[q] = g[q] * (0.5f * v * (1.0f + erf_as(v * 0.70710678118654752f))); }
        float cam = fmaxf(fmaxf(fabsf(r[0]), fabsf(r[1])), fmaxf(fabsf(r[2]), fabsf(r[3])));
        cam = fmaxf(cam, dpp_xor1f(cam)); cam = fmaxf(cam, dpp_xor2f(cam)); cam = fmaxf(cam, dpp_xor4f(cam)); cam = fmaxf(cam, dpp_xor8f(cam)); cam = max_xor16(cam);
        const float csc = cam > 0.f ? 127.0f / cam : 0.f;
        c8[i] = pk4_i8(r[0] * csc, r[1] * csc, r[2] * csc, r[3] * csc);
        if ((i & 31) == 0) csv[i >> 5] = cam * (1.0f / (127.0f * EV_SCALE));
    }
}
__device__ __forceinline__ void gather_v(const Params& p, int layer, LAS unsigned char* lds) {
    unsigned char* ws = launder(p.ws);
    const int tid = tid_(), lane = tid & 63, wave = __builtin_amdgcn_readfirstlane(tid >> 6), sl = lane & 7, eg = lane >> 3;
    const unsigned char* EV = ws + WS_EV + (size_t)layer * 16384 * 1024;
    const bool last = (layer == DEPTH - 1);
    const unsigned sl16 = 16u * sl, eg64 = 64u * eg, eg16 = 16u * eg, eg4 = 4u * eg, xbo = 32u * sl + 4u * eg;
    for (int unit = bid_(); unit < 256; unit += gridDim.x) {
        const int x = unit & 7, j = unit >> 3;
        const int tb = 512 * j + 64 * wave;
        const unsigned char* evb = EV + (size_t)x * 16384 * 128;
        const unsigned char* eib = ws + WS_EIDX; const unsigned char* cib = ws + WS_C; const unsigned char* csb = ws + WS_CS;
        unsigned char* xbb = ws + WS_XB + 256 * x;
        u32x4 wA[16], wB[16]; u32x4 idg, cg; float csg; unsigned x1n;
        LAS unsigned char* wl = lds + wave * 2048;
#define GV_GLD_IDS(t_) do { if (lane < 32) idg = *(const u32x4*)(eib + (size_t)(t_) * 512 + 16u * lane); } while (0)
#define GV_GLD_C(t_) do { if (lane < 8) cg = *(const u32x4*)(cib + (size_t)(t_) * 128 + 16u * lane); if (lane == 0) csg = *(const float*)(csb + (size_t)(t_) * 4); } while (0)
#define GV_LST_IDS(s_) do { if (lane < 32) *(LAS u32x4*)(wl + (s_) * 512 + 16 * lane) = idg; } while (0)
#define GV_LST_C(s_) do { if (lane < 8) *(LAS u32x4*)(wl + 1024 + (s_) * 160 + 16 * lane) = cg; if (lane == 0) *(LAS float*)(wl + 1024 + (s_) * 160 + 128) = csg; } while (0)
#define GV_LLD_IDS(dst, s_) do { const LAS u32x4* ei_ = (const LAS u32x4*)(wl + (s_) * 512 + eg64); _Pragma("unroll") for (int i = 0; i < 4; ++i) { const u32x4 e4_ = ei_[i]; dst[4 * i] = (int)e4_.x; dst[4 * i + 1] = (int)e4_.y; dst[4 * i + 2] = (int)e4_.z; dst[4 * i + 3] = (int)e4_.w; } } while (0)
#define GV_IDS(dst, t_) do { const u32x4* ei_ = (const u32x4*)(eib + (size_t)(t_) * 512 + eg64); _Pragma("unroll") for (int i = 0; i < 4; ++i) { const u32x4 e4_ = ei_[i]; dst[4 * i] = (int)e4_.x; dst[4 * i + 1] = (int)e4_.y; dst[4 * i + 2] = (int)e4_.z; dst[4 * i + 3] = (int)e4_.w; } } while (0)
#define GV_PCS(wd, ids, lo) do { _Pragma("unroll") for (int i = (lo); i < (lo) + 8; ++i) wd[i] = *(const u32x4*)(evb + (unsigned)(((unsigned)ids[i] << 7) + sl16)); } while (0)
#define GV_CF(cd, sd, t_) do { cd = *(const u32x4*)(cib + (size_t)(t_) * 128 + eg16); sd = *(const float*)(csb + (size_t)(t_) * 4); } while (0)
#define GV_ACC(W, lo) do { _Pragma("unroll") for (int g_ = (lo) / 4; g_ < (lo) / 4 + 2; ++g_) { \
                const u32x4 r0 = W[4 * g_], r1 = W[4 * g_ + 1], r2 = W[4 * g_ + 2], r3 = W[4 * g_ + 3]; \
                _Pragma("unroll") for (int d_ = 0; d_ < 4; ++d_) { \
                    const unsigned lo01 = __builtin_amdgcn_perm(r1[d_], r0[d_], 0x05010400u), hi01 = __builtin_amdgcn_perm(r1[d_], r0[d_], 0x07030602u); \
                    const unsigned lo23 = __builtin_amdgcn_perm(r3[d_], r2[d_], 0x05010400u), hi23 = __builtin_amdgcn_perm(r3[d_], r2[d_], 0x07030602u); \
                      \
                    acc[4 * d_ + 0] = (g_ == 0) ? __builtin_amdgcn_sdot4((int)__builtin_amdgcn_perm(lo23, lo01, 0x05040100u), cq[g_], 0, true) : __builtin_amdgcn_sdot4((int)__builtin_amdgcn_perm(lo23, lo01, 0x05040100u), cq[g_], acc[4 * d_ + 0], false); \
                    acc[4 * d_ + 1] = (g_ == 0) ? __builtin_amdgcn_sdot4((int)__builtin_amdgcn_perm(lo23, lo01, 0x07060302u), cq[g_], 0, true) : __builtin_amdgcn_sdot4((int)__builtin_amdgcn_perm(lo23, lo01, 0x07060302u), cq[g_], acc[4 * d_ + 1], false); \
                    acc[4 * d_ + 2] = (g_ == 0) ? __builtin_amdgcn_sdot4((int)__builtin_amdgcn_perm(hi23, hi01, 0x05040100u), cq[g_], 0, true) : __builtin_amdgcn_sdot4((int)__builtin_amdgcn_perm(hi23, hi01, 0x05040100u), cq[g_], acc[4 * d_ + 2], false); \
                    acc[4 * d_ + 3] = (g_ == 0) ? __builtin_amdgcn_sdot4((int)__builtin_amdgcn_perm(hi23, hi01, 0x07060302u), cq[g_], 0, true) : __builtin_amdgcn_sdot4((int)__builtin_amdgcn_perm(hi23, hi01, 0x07060302u), cq[g_], acc[4 * d_ + 3], false); } } } while (0)
#define GV_TOKEN(W, WN, tt_) do { \
            const int t = tb + (tt_), tn = tb + ((tt_) + 1 < 64 ? (tt_) + 1 : 63), tn2 = tb + ((tt_) + 2 < 64 ? (tt_) + 2 : 63), tn3 = tb + ((tt_) + 3 < 64 ? (tt_) + 3 : 63); \
            const unsigned x1 = x1n; \
              \
            int idn[16]; GV_LLD_IDS(idn, ((tt_) + 1) & 1); \
            const u32x4 C = *(const LAS u32x4*)(wl + 1024 + ((tt_) & 1) * 160 + eg16); const float S = *(const LAS float*)(wl + 1024 + ((tt_) & 1) * 160 + 128); \
            __builtin_amdgcn_s_setprio(2); GV_PCS(WN, idn, 0); __builtin_amdgcn_s_setprio(0);              \
            GV_LST_IDS((tt_) & 1); GV_LST_C(((tt_) + 1) & 1); \
            GV_GLD_IDS(tn3); GV_GLD_C(tn2); \
            const float cs = S; int cq[4]; cq[0] = (int)C.x; cq[1] = (int)C.y; cq[2] = (int)C.z; cq[3] = (int)C.w; \
            int acc[16]; \
            _Pragma("unroll") for (int q = 0; q < 16; ++q) acc[q] = 0; \
            GV_ACC(W, 0); \
            __builtin_amdgcn_s_setprio(2); GV_PCS(WN, idn, 8); __builtin_amdgcn_s_setprio(0);              \
            x1n = *(const unsigned*)(xbb + (size_t)tn * (DM * 2) + xbo); \
            GV_ACC(W, 8); \
            int q8[8], q4[4]; float q2[2]; \
              \
              \
            _Pragma("unroll") for (int m = 0; m < 8; ++m) { \
                const auto r_ = __builtin_amdgcn_permlane32_swap((unsigned)acc[m], (unsigned)acc[m + 8], false, false); q8[m] = (int)r_[0] + (int)r_[1]; } \
            _Pragma("unroll") for (int m = 0; m < 4; ++m) { \
                const auto r_ = __builtin_amdgcn_permlane16_swap((unsigned)q8[m], (unsigned)q8[m + 4], false, false); q4[m] = (int)r_[0] + (int)r_[1]; } \
            { const bool up = (lane & 8) != 0; _Pragma("unroll") for (int m = 0; m < 2; ++m) { const int s1 = q4[m] + dpp_xor8(q4[m]), s2 = q4[m + 2] + dpp_xor8(q4[m + 2]); q2[m] = (float)(up ? s2 : s1) * cs; } } \
              \
            const float y0 = bflo(x1) + q2[0], y1 = bfhi(x1) + q2[1]; \
            *(unsigned*)(xbb + (size_t)t * (DM * 2) + xbo) = pk2(y0, y1); \
            const float ssq = wave_sum(y0 * y0 + y1 * y1); \
            if (lane == 0) ((float*)(ws + WS_PSS))[(size_t)t * 8 + x] = ssq; } while (0)
        GV_GLD_IDS(tb); GV_LST_IDS(0); GV_GLD_IDS(tb + 1); GV_LST_IDS(1); GV_GLD_C(tb); GV_LST_C(0);
        x1n = *(const unsigned*)(xbb + (size_t)tb * (DM * 2) + xbo);
        { int id0[16]; GV_LLD_IDS(id0, 0); GV_PCS(wA, id0, 0); GV_PCS(wA, id0, 8); }
        GV_GLD_IDS(tb + 2); GV_GLD_C(tb + 1);
        for (int tt = 0; tt < 64; tt += 2) { GV_TOKEN(wA, wB, tt); GV_TOKEN(wB, wA, tt + 1); }
#undef GV_TOKEN
#undef GV_ACC
#undef GV_CF
#undef GV_IDS
#undef GV_PCS
    }
}
__device__ __forceinline__ void final_norm(const Params& p) {
    unsigned char* ws = launder(p.ws);
    const int tid = tid_(), lane = tid & 63, wave = tid >> 6;
    const int gw = bid_() * NWAVES + wave, NGW = gridDim.x * NWAVES;
    for (int m = gw; m < NTOK; m += NGW) {
        const f32x4 sa = *(const f32x4*)((const float*)(ws + WS_PSS) + (size_t)m * 8), sb = *(const f32x4*)((const float*)(ws + WS_PSS) + (size_t)m * 8 + 4);
        const float r = __builtin_amdgcn_rsqf((((sa.x + sa.y) + (sa.z + sa.w)) + ((sb.x + sb.y) + (sb.z + sb.w))) * (1.0f / DM) + EPS);
        const u32x2* xr = (const u32x2*)((const bf16_t*)(ws + WS_XB) + (size_t)m * DM) + lane; const f32x4* gf = (const f32x4*)p.norm_final + lane;
        f32x4* o = (f32x4*)(p.out + (size_t)m * DM) + lane;
#pragma unroll
        for (int q = 0; q < 4; ++q) { const u32x2 w = xr[64 * q]; const f32x4 g = gf[64 * q]; o[64 * q] = (f32x4){bflo(w.x) * r * g.x, bfhi(w.x) * r * g.y, bflo(w.y) * r * g.z, bfhi(w.y) * r * g.w}; }
    }
}

namespace pg8 {
#define PG8_LAS __attribute__((address_space(3)))
constexpr int BM = 256, BK = 64, HALF = 128, HTB = HALF * BK * 2, STAGE_BYTES = 8 * HTB, NXCD = 8, WGM = 8;
__host__ __device__ __forceinline__ int lds_byte(int r, int c) { const int st = (r >> 4) * 2 + (c >> 5), rr = r & 15, cc = c & 31, ob = rr * 64 + cc * 2; return st * 1024 + (ob ^ (((ob >> 9) & 1) << 5)); }
__host__ __device__ __forceinline__ void stage_rc(int b, int& R, int& C) { const int st = b / 1024, sb = b % 1024, swz = sb ^ (((sb >> 9) & 1) << 5); R = (st >> 1) * 16 + swz / 64; C = (st & 1) * 32 + (swz % 64) / 2; }
__host__ __device__ __forceinline__ int perm32(int rho) { const int n = rho >> 4, i = rho & 15; return 8 * (i >> 2) + 4 * n + (i & 3); }
struct Unit { int pm, pn, idx; };
typedef ::Gemm Gemm;
struct StaticOrder {
    int nM, nN, nwg, G, c;
    __host__ __device__ void init(int M, int N, int G_, int c_) { nM = M / BM; nN = N / BM; nwg = nM * nN; G = G_; c = c_; }
    __host__ __device__ bool next(int i, Unit& u) const {
        const long L = (long)i * G + c; if (L >= nwg) return false;
        int wgid = (int)L; { const int q = nwg / NXCD, r = nwg % NXCD, xcd = wgid % NXCD, off = wgid / NXCD; wgid = (xcd < r ? xcd * (q + 1) : r * (q + 1) + (xcd - r) * q) + off; }
        const int nig = WGM * nN, gid = wgid / nig, fm = gid * WGM, gsz = (nM - fm) < WGM ? (nM - fm) : WGM;
        u.pm = fm + ((wgid % nig) % gsz); u.pn = (wgid % nig) / gsz; u.idx = i; return true;
    }
    __device__ __forceinline__ void a_ready(const Unit&) const {}
    __device__ __forceinline__ void done(const Unit&) const {}
};
constexpr int RS_TAB_OFF = 131072 + 1024, RS_MAX_UNITS = 8;
template <class Epi> struct EpiAdapt {
    static constexpr bool PERM = true, AFTER_DRAIN = false;
    const Epi& e; PG8_LAS unsigned char* lds0; float rsv[RS_MAX_UNITS]; int nrs;
    __device__ __forceinline__ void fill(int tid) const {
        if (tid < 256) {
#pragma unroll
            for (int i = 0; i < RS_MAX_UNITS; ++i) if (i < nrs) ((PG8_LAS float*)(lds0 + RS_TAB_OFF))[i * 256 + tid] = rsv[i];
        }
    }
    __device__ __forceinline__ void operator()(const f32x4 (&acc)[2][2][4][2], const Unit& u, int wr, int wc, int fr, int fq) const {
        const PG8_LAS float* rst = (const PG8_LAS float*)(lds0 + RS_TAB_OFF) + (u.idx & (RS_MAX_UNITS - 1)) * 256;
        const bool resid = (e.kind == 3);
        u32x4 rcur[2], rnxt[2];
        const int col0 = u.pn * BM + wc * 32 + 8 * fq;
#define EA_LOADRES(dst, g_) do { const GAS bf16_t* rr_ = (const GAS bf16_t*)e.aux + (size_t)(u.pm * BM + ((g_) >> 2) * HALF + wr * 64 + ((g_) & 3) * 16 + fr) * DM + col0; \
            dst[0] = *(const GAS u32x4*)rr_; dst[1] = *(const GAS u32x4*)(rr_ + HALF); } while (0)
        if (resid) EA_LOADRES(rcur, 0);
#pragma unroll
        for (int g = 0; g < 8; ++g) {
            const int ai = g >> 2, m = g & 3;
            const int rl = ai * HALF + wr * 64 + m * 16 + fr, row = u.pm * BM + rl;
            if (resid && g < 7) EA_LOADRES(rnxt, g + 1);
            const float rs = rst[rl];
            float v[2][8];
#pragma unroll
            for (int bj = 0; bj < 2; ++bj) { const f32x4 a = acc[ai][bj][m][0], b = acc[ai][bj][m][1]; v[bj][0] = a[0]; v[bj][1] = a[1]; v[bj][2] = a[2]; v[bj][3] = a[3]; v[bj][4] = b[0]; v[bj][5] = b[1]; v[bj][6] = b[2]; v[bj][7] = b[3]; }
            if (resid) {
#pragma unroll
                for (int bj = 0; bj < 2; ++bj) { float r8[8]; unpack8(rcur[bj], r8);
#pragma unroll
                    for (int e_ = 0; e_ < 8; ++e_) v[bj][e_] += r8[e_]; }
            }
            e.row16(row, u.pn, wc, fq, v, rs);
            asm volatile("" ::: "memory");
            if (resid && g < 7) { rcur[0] = rnxt[0]; rcur[1] = rnxt[1]; }
        }
#undef EA_LOADRES
    }
};
template <class Epi, class Sched, bool ALIGN_EPI = false, bool SP2 = false>
__device__ __forceinline__ void gemm_phase(PG8_LAS unsigned char* lds, const Gemm g, const Sched& S, const Epi& E) {
    const int tid = tid_(), wid = __builtin_amdgcn_readfirstlane(tid >> 6), lane = tid & 63, wr = wid >> 2, wc = wid & 3, fr = lane & 15, fq = lane >> 4;
    const int K = g.K, nt = K / BK; const int lda = g.lda, ldb = g.ldb;
    unsigned voffA[2], voffB[2];
#pragma unroll
    for (int i = 0; i < 2; ++i) { int R, C; stage_rc(tid * 16 + i * 8192, R, C); const int Rb = Epi::PERM ? ((R & ~31) + perm32(R & 31)) : R;
        voffA[i] = (unsigned)(R * lda + C) * 2u; voffB[i] = (unsigned)(Rb * ldb + C) * 2u; }
    const size_t kstep = (size_t)(BK * 2);
    const size_t hstepA = (size_t)HALF * lda * 2, hstepB = (size_t)HALF * ldb * 2;
    const size_t tstepA = 2 * hstepA, tstepB = 2 * hstepB;
    const unsigned ldsw = (unsigned)wid * 1024u;
    const int aoff = lds_byte(wr * 64 + fr, fq * 8), boff = lds_byte(wc * 32 + fr, fq * 8);
#define PG8_SA(b, h) (((b) * 2 + (h)) * HTB)
#define PG8_SB(b, h) ((4 + (b) * 2 + (h)) * HTB)
#define PG8_STAGE(bufoff, gbase, voff) do { _Pragma("unroll") for (int _i = 0; _i < 2; ++_i) \
        __builtin_amdgcn_global_load_lds((const unsigned*)((const char*)(gbase) + (voff)[_i]), (PG8_LAS unsigned*)(lds + (bufoff) + ldsw + _i * 8192), 16, 0, 0); } while (0)
#define PG8_LDA(dst, b, h) do { _Pragma("unroll") for (int m = 0; m < 4; ++m) _Pragma("unroll") for (int k = 0; k < 2; ++k) dst[m][k] = *(const PG8_LAS bf16x8*)(lds + PG8_SA(b, h) + aoff + m * 2048 + k * 1024); } while (0)
#define PG8_LDB(dst, b, h) do { _Pragma("unroll") for (int n = 0; n < 2; ++n) _Pragma("unroll") for (int k = 0; k < 2; ++k) dst[n][k] = *(const PG8_LAS bf16x8*)(lds + PG8_SB(b, h) + boff + n * 2048 + k * 1024); } while (0)
#define PG8_MMA(ai, bj, At, Bt) do { __builtin_amdgcn_s_setprio(1); _Pragma("unroll") for (int m = 0; m < 4; ++m) _Pragma("unroll") for (int n = 0; n < 2; ++n) _Pragma("unroll") for (int k = 0; k < 2; ++k) \
        acc[ai][bj][m][n] = __builtin_amdgcn_mfma_f32_16x16x32_bf16(Bt[n][k], At[m][k], acc[ai][bj][m][n], 0, 0, 0); __builtin_amdgcn_s_setprio(0); } while (0)
#define PG8_WAIT_V(n) asm volatile("s_waitcnt vmcnt(" #n ")" ::: "memory")
#define PG8_WAIT_L(n) asm volatile("s_waitcnt lgkmcnt(" #n ")" ::: "memory")
#define PG8_BAR __builtin_amdgcn_s_barrier()
#define PG8_SCHED __builtin_amdgcn_sched_barrier(0)
    Unit cur, nxt; int ui = 0;
    if (!S.next(0, cur)) return;
    float zero_ = 0.f; asm volatile("" : "+v"(zero_));
    f32x4 acc[2][2][4][2];
#pragma unroll
    for (int a = 0; a < 2; ++a)
#pragma unroll
        for (int b = 0; b < 2; ++b)
#pragma unroll
            for (int m = 0; m < 4; ++m)
#pragma unroll
                for (int n = 0; n < 2; ++n) acc[a][b][m][n] = (f32x4){zero_, zero_, zero_, zero_};
    bf16x8 At[4][2], B0[2][2], B1[2][2];
    const char* cA = (const char*)g.A + (size_t)cur.pm * tstepA; const char* cB = (const char*)g.Bt + (size_t)cur.pn * tstepB;
    S.a_ready(cur);
    if constexpr (SP2) {
        PG8_STAGE(PG8_SB(0, 0), cB, voffB); PG8_STAGE(PG8_SB(0, 1), cB + hstepB, voffB); PG8_STAGE(PG8_SA(0, 0), cA, voffA); PG8_STAGE(PG8_SA(0, 1), cA + hstepA, voffA);
        E.fill(tid);
        if (wr == 1) PG8_BAR;
        PG8_WAIT_V(2); PG8_BAR;
        PG8_STAGE(PG8_SB(1, 0), cB + kstep, voffB); PG8_STAGE(PG8_SA(1, 0), cA + kstep, voffA); PG8_STAGE(PG8_SB(1, 1), cB + hstepB + kstep, voffB);
        PG8_WAIT_V(6); PG8_BAR;
    } else {
        PG8_STAGE(PG8_SB(0, 0), cB, voffB); PG8_STAGE(PG8_SA(0, 0), cA, voffA); PG8_STAGE(PG8_SB(0, 1), cB + hstepB, voffB); PG8_STAGE(PG8_SA(0, 1), cA + hstepA, voffA);
        E.fill(tid);
        if (wr == 1) PG8_BAR;
        PG8_WAIT_V(4); PG8_BAR;
        PG8_STAGE(PG8_SB(1, 0), cB + kstep, voffB); PG8_STAGE(PG8_SA(1, 0), cA + kstep, voffA); PG8_STAGE(PG8_SB(1, 1), cB + hstepB + kstep, voffB);
        PG8_WAIT_V(6); PG8_BAR;
    }
    for (;;) {
        const bool has_next = S.next(ui + 1, nxt);
        const char* nA = has_next ? (const char*)g.A + (size_t)nxt.pm * tstepA : cA; const char* nB = has_next ? (const char*)g.Bt + (size_t)nxt.pn * tstepB : cB;
        for (int t = 0; t < nt; t += 2) {
            const bool last = (t == nt - 2);
            const char* a1 = cA + (size_t)(t + 1) * kstep;
            const char* a2 = last ? nA : cA + (size_t)(t + 2) * kstep; const char* b2 = last ? nB : cB + (size_t)(t + 2) * kstep;
            const char* a3 = a2 + kstep; const char* b3 = b2 + kstep;
            if (last && has_next) S.a_ready(nxt);
            if constexpr (SP2) {
            PG8_LDB(B0, 0, 0); PG8_LDB(B1, 0, 1); PG8_SCHED; PG8_LDA(At, 0, 0); PG8_STAGE(PG8_SA(1, 1), a1 + hstepA, voffA);
            PG8_WAIT_V(8); PG8_WAIT_L(0); PG8_BAR; PG8_MMA(0, 0, At, B0); PG8_MMA(0, 1, At, B1); PG8_BAR; PG8_SCHED;
            PG8_LDA(At, 0, 1); PG8_STAGE(PG8_SB(0, 0), b2, voffB); PG8_STAGE(PG8_SB(0, 1), b2 + hstepB, voffB); PG8_STAGE(PG8_SA(0, 0), a2, voffA);
            PG8_WAIT_V(8); PG8_WAIT_L(0); PG8_BAR; PG8_MMA(1, 0, At, B0); PG8_MMA(1, 1, At, B1); PG8_BAR; PG8_SCHED;
            PG8_LDB(B0, 1, 0); PG8_LDB(B1, 1, 1); PG8_SCHED; PG8_LDA(At, 1, 0); PG8_STAGE(PG8_SA(0, 1), a2 + hstepA, voffA);
            PG8_WAIT_V(8); PG8_WAIT_L(0); PG8_BAR; PG8_MMA(0, 0, At, B0); PG8_MMA(0, 1, At, B1); PG8_BAR; PG8_SCHED;
            PG8_LDA(At, 1, 1); PG8_STAGE(PG8_SB(1, 0), b3, voffB); PG8_STAGE(PG8_SB(1, 1), b3 + hstepB, voffB); PG8_STAGE(PG8_SA(1, 0), a3, voffA);
            PG8_WAIT_V(8); PG8_WAIT_L(0); PG8_BAR; PG8_MMA(1, 0, At, B0); PG8_MMA(1, 1, At, B1); PG8_BAR; PG8_SCHED;
            } else {
            PG8_LDB(B0, 0, 0); PG8_SCHED; PG8_LDA(At, 0, 0); PG8_STAGE(PG8_SA(1, 1), a1 + hstepA, voffA);
            PG8_WAIT_L(8); PG8_BAR; PG8_WAIT_L(0); PG8_MMA(0, 0, At, B0); PG8_BAR; PG8_SCHED;
            PG8_LDB(B1, 0, 1); PG8_STAGE(PG8_SB(0, 0), b2, voffB);
            PG8_BAR; PG8_WAIT_L(0); PG8_MMA(0, 1, At, B1); PG8_BAR;
            PG8_LDA(At, 0, 1); PG8_STAGE(PG8_SA(0, 0), a2, voffA);
            PG8_BAR; PG8_WAIT_L(0); PG8_MMA(1, 0, At, B0); PG8_BAR; PG8_SCHED;
            PG8_STAGE(PG8_SB(0, 1), b2 + hstepB, voffB);
            PG8_WAIT_V(6); PG8_BAR; PG8_MMA(1, 1, At, B1); PG8_BAR;
            PG8_LDB(B0, 1, 0); PG8_SCHED; PG8_LDA(At, 1, 0); PG8_STAGE(PG8_SA(0, 1), a2 + hstepA, voffA);
            PG8_WAIT_L(8); PG8_BAR; PG8_WAIT_L(0); PG8_MMA(0, 0, At, B0); PG8_BAR; PG8_SCHED;
            PG8_LDB(B1, 1, 1); PG8_STAGE(PG8_SB(1, 0), b3, voffB);
            PG8_BAR; PG8_WAIT_L(0); PG8_MMA(0, 1, At, B1); PG8_BAR;
            PG8_LDA(At, 1, 1); PG8_STAGE(PG8_SA(1, 0), a3, voffA);
            PG8_BAR; PG8_WAIT_L(0); PG8_MMA(1, 0, At, B0); PG8_BAR; PG8_SCHED;
            PG8_STAGE(PG8_SB(1, 1), b3 + hstepB, voffB);
            PG8_WAIT_V(6); PG8_BAR; PG8_MMA(1, 1, At, B1); PG8_BAR;
            }
        }
        if constexpr (ALIGN_EPI) { if (wr == 0) PG8_BAR; }
        if constexpr (!Epi::AFTER_DRAIN) { E(acc, cur, wr, wc, fr, fq); S.done(cur); }
        if (!has_next) break;
#pragma unroll
        for (int a = 0; a < 2; ++a)
#pragma unroll
            for (int b = 0; b < 2; ++b)
#pragma unroll
                for (int m = 0; m < 4; ++m)
#pragma unroll
                    for (int n = 0; n < 2; ++n) acc[a][b][m][n] = (f32x4){zero_, zero_, zero_, zero_};
        cur = nxt; cA = nA; cB = nB; ++ui;
        if constexpr (ALIGN_EPI) { if (wr == 1) PG8_BAR; }
    }
    PG8_WAIT_V(0);
    if constexpr (!ALIGN_EPI) { if (wr == 0) PG8_BAR; }
    PG8_BAR;
    if constexpr (Epi::AFTER_DRAIN) { E.fused(acc, cur, wr, wc, fr, fq, lds, wid, lane); S.done(cur); }
#undef PG8_SA
#undef PG8_SB
#undef PG8_STAGE
#undef PG8_LDA
#undef PG8_LDB
#undef PG8_MMA
#undef PG8_WAIT_V
#undef PG8_WAIT_L
#undef PG8_BAR
#undef PG8_SCHED
}
}

template <class Epi> __device__ __forceinline__ void run_gemm(LAS unsigned char* lds, const Gemm g, int c0, int G, const Epi& E) {
#if USE_MFMA_GEMM
    pg8::StaticOrder S; S.init(g.M, g.N, G, c0);
    pg8::EpiAdapt<Epi> EA{E, lds, {}, 0};
    {
        const int tid = tid_(); pg8::Unit u; int n = 0;
#pragma unroll
        for (int i = 0; i < pg8::RS_MAX_UNITS; ++i) { if (!S.next(i, u)) break; EA.rsv[i] = (tid < 256) ? E.row_scale(u.pm * 256 + tid) : 0.f; n = i + 1; }
        EA.nrs = n;
    }
    pg8::gemm_phase<pg8::EpiAdapt<Epi>, pg8::StaticOrder, true, true>(lds, g, S, EA);
#else
    gemm_naive<Epi>(g, c0, G, E);
#endif
}

__device__ __forceinline__ void hquant_rows(unsigned char* ws, const float* gain) {
    const int tid = tid_(), lane = tid & 63, wave = tid >> 6;
    const int gw = bid_() * NWAVES + wave, NGW = gridDim.x * NWAVES;
    f32x4 gv[4];
#pragma unroll
    for (int q = 0; q < 4; ++q) gv[q] = *(const GAS f32x4*)((const GAS float*)gain + 16 * lane + 4 * q);
    for (int m = gw; m < NTOK; m += NGW) {
        const u32x4* xr = (const u32x4*)((const bf16_t*)(ws + WS_XB) + (size_t)m * DM + 16 * lane);
        const float rs = rstd2_of(ws, m);
        float h[16]; float am = 0.f;
        { const u32x4 w0 = xr[0], w1 = xr[1]; unpack8(w0, h); unpack8(w1, h + 8); }
#pragma unroll
        for (int q = 0; q < 4; ++q) { const f32x4 g = gv[q]; h[4 * q] *= rs * g.x; h[4 * q + 1] *= rs * g.y; h[4 * q + 2] *= rs * g.z; h[4 * q + 3] *= rs * g.w; }
#pragma unroll
        for (int i = 0; i < 16; ++i) am = fmaxf(am, fabsf(h[i]));
        am = fmaxf(am, dpp_xor1f(am)); am = fmaxf(am, dpp_xor2f(am)); am = fmaxf(am, dpp_xor4f(am));
        const float sc = am > 0.f ? 127.0f / am : 0.f;
        u32x4 o; o.x = pk4_i8(h[0] * sc, h[1] * sc, h[2] * sc, h[3] * sc); o.y = pk4_i8(h[4] * sc, h[5] * sc, h[6] * sc, h[7] * sc); o.z = pk4_i8(h[8] * sc, h[9] * sc, h[10] * sc, h[11] * sc); o.w = pk4_i8(h[12] * sc, h[13] * sc, h[14] * sc, h[15] * sc);
        *(u32x4*)(ws + WS_HQ + (size_t)m * DM + 16 * lane) = o;
        if ((lane & 7) == 0) ((float*)(ws + WS_HS))[(size_t)m * 8 + (lane >> 3)] = am * (1.0f / 127.0f);
    }
}
__device__ __forceinline__ void gemm_phase_any(const Params& p, int sub, int layer, LAS unsigned char* lds) {
    unsigned char* ws = launder(p.ws);
    const int G = gridDim.x, bx = bid_();
    Gemm g; EpiAll E; E.ws = ws; E.aux = nullptr; int c0 = bx, Gs = G;
    g.M = NTOK;
    if (sub == 0) { g.A = (const bf16_t*)(ws + WS_XB); g.Bt = (const bf16_t*)(ws + WS_WIN) + (size_t)layer * DINP * DM; g.N = DINP; g.K = DM; E.kind = 0; E.aux = p.b_forget + layer * 4; }
    else if (sub == 1) {
        if (bx < 16) fcum_scan(ws, bx, tid_(), lds);
        const int G1 = G / 2; const bool first = bx < G1;
        g.A = first ? (const bf16_t*)(ws + WS_CQ) : (const bf16_t*)(ws + WS_CKV);
        g.Bt = first ? (const bf16_t*)(ws + WS_WUQ) + (size_t)layer * 512 * 256 : (const bf16_t*)(ws + WS_WUKV) + (size_t)layer * 512 * 128;
        g.N = 512; g.K = first ? 256 : 128; E.kind = first ? 1 : 2; c0 = first ? bx : bx - G1; Gs = first ? G1 : G - G1;
    }
    else if (sub == 3) { g.A = (const bf16_t*)(ws + WS_Y); g.Bt = (const bf16_t*)(ws + WS_WOUT) + (size_t)layer * DM * DM; g.N = DM; g.K = DM; E.kind = 3; E.aux = (const float*)(ws + WS_XB); }
    else { g.A = (const bf16_t*)(ws + WS_XB); g.Bt = (const bf16_t*)(ws + WS_WQ) + (size_t)layer * 2048 * DM; g.N = 2048; g.K = DM; E.kind = 4; }
    g.lda = g.K; g.ldb = g.K;
    run_gemm(lds, g, c0, Gs, E);
    if (sub == 1) mixers_mfma<0>(p, ws, layer, lds);
}
template <int SUB>
__device__ __forceinline__ void run_phase(const Params& p, int layer, LAS unsigned char* lds) {
    unsigned char* ws = launder(p.ws);
    if constexpr (SUB == -1) { phase_prologue(p, lds); }
    else if constexpr (SUB == 0 || SUB == 1 || SUB == 3 || SUB == 4) { gemm_phase_any(p, SUB, layer, lds); }
    else if constexpr (SUB == 2) {
#if NAIVE_MIX || MIX_DEBUG
        mixers_naive(ws);
#else
        mixers_mfma<1>(p, ws, layer, lds);
#endif
    }
    else if constexpr (SUB == 17) { mixers_mfma<0>(p, ws, layer, lds); mixers_mfma<1>(p, ws, layer, lds); }
    else if constexpr (SUB == 5) {
#if NAIVE_SCORE
        peer_score_naive(ws, layer);
#else
        peer_score_mfma(ws, layer, lds, p.norm_ffn + layer * DM);
#endif
    }
    else if constexpr (SUB == 6) { gather_u(p, layer, lds); }
    else if constexpr (SUB == 7) { gather_act(p); }
    else if constexpr (SUB == 8) { gather_v(p, layer, lds); }
    else if constexpr (SUB == 9) { final_norm(p); }
}
template <int SUB>
__global__ void __launch_bounds__(NTHREADS, 2) phase_kernel(Params p, int layer) {
    extern __shared__ __attribute__((aligned(16))) unsigned char lds_raw[];
    run_phase<SUB>(p, layer, (LAS unsigned char*)lds_raw);
}


typedef GAS unsigned gu32;
#define XB_TMO      128
#define XB_XCNT(j)  (256  + 64 * (j))
#define XB_XSUB(j)  (1280 + 64 * (j))
#define XB_XGEN(j)  (2304 + 64 * (j))
#define XB_TOP      3328
#define XB_TOPGEN   3392
#define XCD_BAR_WORDS 3456
#define XB_SPIN_CAP (1u << 18)

__device__ __forceinline__ unsigned xb_ld(unsigned* p)              { return __hip_atomic_load(p, __ATOMIC_RELAXED, __HIP_MEMORY_SCOPE_AGENT); }
__device__ __forceinline__ unsigned xb_add(unsigned* p, unsigned v) { return __hip_atomic_fetch_add(p, v, __ATOMIC_RELAXED, __HIP_MEMORY_SCOPE_AGENT); }
__device__ __forceinline__ unsigned xb_xcc_id() { return (unsigned)__builtin_amdgcn_s_getreg((3 << 11) | 20) & 0xFu; }
#define XB_SPIN(cond, bar) do { unsigned _sp = 0; while (cond) { __builtin_amdgcn_s_sleep(1); \
    if ((++_sp & 255u) == 0u) { if (xb_ld(&(bar)[XB_TMO])) break; if (_sp > XB_SPIN_CAP) { atomicAdd(&(bar)[XB_TMO], 1u); break; } } } } while (0)

struct XcdBarrier {
    unsigned* bar; unsigned x;
    volatile LAS unsigned* st;
};

__device__ __forceinline__ XcdBarrier xcd_barrier_post(unsigned* bar, volatile LAS unsigned* st) {
    XcdBarrier b; b.bar = bar; b.x = xb_xcc_id(); b.st = st;
    if (threadIdx.x == 0) (void)xb_add(&bar[XB_XCNT(b.x)], 1u);
    return b;
}
__device__ __forceinline__ void xcd_barrier_complete(unsigned* bar, unsigned x, unsigned& nloc, unsigned& nx) {
    const unsigned G = gridDim.x * gridDim.y * gridDim.z;
    unsigned sum, cnt, mine, sp = 0u;
    for (;;) {
        sum = 0u; cnt = 0u; mine = 0u;
#pragma unroll
        for (unsigned j = 0; j < 16; ++j) { const unsigned c = xb_ld(&bar[XB_XCNT(j)]); sum += c; cnt += (c > 0u) ? 1u : 0u; mine = (j == x) ? c : mine; }
        if (sum == G) break;
        __builtin_amdgcn_s_sleep(1);
        if ((++sp & 255u) == 0u) { if (xb_ld(&bar[XB_TMO])) break; if (sp > XB_SPIN_CAP) { atomicAdd(&bar[XB_TMO], 1u); break; } }
    }
    nloc = mine > 0u ? mine : 1u; nx = cnt > 0u ? cnt : 1u;
}

__device__ __forceinline__ void xcd_barrier(const XcdBarrier& b) {
    asm volatile("s_waitcnt vmcnt(0)" ::: "memory");
    __syncthreads();
    if (threadIdx.x == 0) {
        unsigned* bar = b.bar;
        __builtin_amdgcn_s_waitcnt(0);
        unsigned nloc = b.st[0], nx = b.st[1];
        if (nloc == 0u) { xcd_barrier_complete(bar, b.x, nloc, nx); b.st[0] = nloc; b.st[1] = nx; }
        const unsigned old = xb_add(&bar[XB_XSUB(b.x)], 1u);
        const unsigned gen = old / nloc;
        if (old + 1u == (gen + 1u) * nloc) {
            __builtin_amdgcn_fence(__ATOMIC_RELEASE, "agent");
            asm volatile("s_waitcnt vmcnt(0)" ::: "memory");
            const unsigned og = xb_add(&bar[XB_TOP], 1u);
            const unsigned tg = og / nx;
            if (og + 1u == (tg + 1u) * nx) xb_add(&bar[XB_TOPGEN], 1u);
            else XB_SPIN(xb_ld(&bar[XB_TOPGEN]) == tg, bar);
            __builtin_amdgcn_fence(__ATOMIC_ACQUIRE, "agent");
            xb_add(&bar[XB_XGEN(b.x)], 1u);
            asm volatile("s_waitcnt vmcnt(0)" ::: "memory");
        } else {
            XB_SPIN(xb_ld(&bar[XB_XGEN(b.x)]) == gen, bar);
            __builtin_amdgcn_fence(__ATOMIC_ACQUIRE, "agent");
            asm volatile("s_waitcnt vmcnt(0)" ::: "memory");
        }
    }
    __syncthreads();
}


template <int PH>
__device__ __forceinline__ void one_phase(const Params& p, LAS unsigned char* lds) {
#if defined(__HIP_DEVICE_COMPILE__)
    typedef const __attribute__((address_space(4))) Params* KP;
    KP kp = (KP)__builtin_amdgcn_kernarg_segment_ptr(); asm volatile("" : "+s"(kp));
    Params q;
    { const __attribute__((address_space(4))) unsigned long long* src = (const __attribute__((address_space(4))) unsigned long long*)kp; unsigned long long* dst = (unsigned long long*)&q;
#pragma unroll
      for (int i = 0; i < (int)(sizeof(Params) / 8); ++i) dst[i] = src[i]; }
#else
    const Params q = p;
#endif
    if (!(q.ph_lo <= PH && PH < q.ph_hi)) return;
    if constexpr (PH == 0) run_phase<-1>(q, 0, lds);
    else if constexpr (PH == NPH - 1) run_phase<9>(q, 0, lds);
    else {
        constexpr int layer = (PH - 1) / NSUB, sub = (PH - 1) % NSUB;
        if constexpr (sub == 0 || sub == 1 || sub == 3 || sub == 4) gemm_phase_any(q, sub, layer, lds);
        else if constexpr (sub == 2) { if (!NAIVE_MIX && !MIX_DEBUG) run_phase<2>(q, layer, lds); }
        else if constexpr (sub == 5) { if (!NAIVE_SCORE) run_phase<5>(q, layer, lds); }
        else if constexpr (sub == 6) run_phase<6>(q, layer, lds);
        else if constexpr (sub == 7) run_phase<7>(q, layer, lds);
        else run_phase<8>(q, layer, lds);
    }
    if (PH + 1 < q.ph_hi) { XcdBarrier xb; xb.bar = (unsigned*)(launder(q.ws) + WS_CTL) + CW_BAR; xb.x = xb_xcc_id(); xb.st = (volatile LAS unsigned*)(lds + 131072 + 320) + 8; xcd_barrier(xb); }
}
__global__ void __launch_bounds__(NTHREADS, 2) fwd_kernel(Params p) {
    extern __shared__ __attribute__((aligned(16))) unsigned char lds_raw[];
    LAS unsigned char* lds = (LAS unsigned char*)lds_raw;
    volatile LAS unsigned* misc = (volatile LAS unsigned*)(lds + 131072 + 320);
    if (threadIdx.x < 32) misc[threadIdx.x] = 0u;
    __syncthreads();
    (void)xcd_barrier_post((unsigned*)(p.ws + WS_CTL) + CW_BAR, misc + 8);
    one_phase<0>(p, lds); one_phase<1>(p, lds); one_phase<2>(p, lds); one_phase<3>(p, lds); one_phase<4>(p, lds);
    one_phase<5>(p, lds); one_phase<6>(p, lds); one_phase<7>(p, lds); one_phase<8>(p, lds); one_phase<9>(p, lds);
    one_phase<10>(p, lds); one_phase<11>(p, lds); one_phase<12>(p, lds); one_phase<13>(p, lds); one_phase<14>(p, lds);
    one_phase<15>(p, lds); one_phase<16>(p, lds); one_phase<17>(p, lds); one_phase<18>(p, lds); one_phase<19>(p, lds);
    static_assert(NPH == 20, "phase list above");
}

constexpr int LDS_BYTES = 147456;

template <int SUB> static void launch_phase(const Params& p, int layer, int grid, hipStream_t stream) {
    static bool attr = false;
    if (!attr) { (void)hipFuncSetAttribute((const void*)phase_kernel<SUB>, hipFuncAttributeMaxDynamicSharedMemorySize, LDS_BYTES); attr = true; }
    hipLaunchKernelGGL(phase_kernel<SUB>, dim3(grid), dim3(NTHREADS), LDS_BYTES, stream, p, layer);
}
extern "C" void kernel_launch(void* const* d_in, const int* in_sizes, int n_in, void* d_out, int out_size, void* d_ws, size_t ws_size, hipStream_t stream) {
    static int grid = 0;
    if (grid == 0) {
        if (n_in != 16 || out_size != NTOK * DM || ws_size < WS_END) { fprintf(stderr, "kernel_launch: unexpected sizes (n_in %d out %d ws %zu)\n", n_in, out_size, ws_size); grid = -1; return; }
        int dev = 0, cus = 0, per_cu = 0;
        (void)hipGetDevice(&dev); (void)hipDeviceGetAttribute(&cus, hipDeviceAttributeMultiprocessorCount, dev);
        (void)hipFuncSetAttribute((const void*)fwd_kernel, hipFuncAttributeMaxDynamicSharedMemorySize, LDS_BYTES);
        if (hipOccupancyMaxActiveBlocksPerMultiprocessor(&per_cu, (const void*)fwd_kernel, NTHREADS, LDS_BYTES) != hipSuccess || per_cu < 1) { fprintf(stderr, "kernel_launch: occupancy query reports %d blocks per CU for the fused kernel\n", per_cu); per_cu = 1; }
        (void)hipGetLastError();
        grid = (cus > 0 ? cus : 256) * (per_cu < 1 ? per_cu : 1);
    }
    if (grid < 0) return;
    (void)hipMemsetAsync((char*)d_ws + WS_CTL, 0, CTL_BYTES, stream);
    Params p{};
    p.x = (const float*)d_in[0]; p.norm_mix = (const float*)d_in[1]; p.w_in = (const float*)d_in[2]; p.b_forget = (const float*)d_in[3]; p.norm_cq = (const float*)d_in[4]; p.norm_ckv = (const float*)d_in[5];
    p.w_uq = (const float*)d_in[6]; p.w_ukv = (const float*)d_in[7]; p.head_gain = (const float*)d_in[8]; p.w_out = (const float*)d_in[9]; p.norm_ffn = (const float*)d_in[10]; p.w_query = (const float*)d_in[11];
    p.sub_keys = (const float*)d_in[12]; p.expert_u = (const float*)d_in[13]; p.expert_v = (const float*)d_in[14]; p.norm_final = (const float*)d_in[15];
    p.out = (float*)d_out; p.ws = (unsigned char*)d_ws;
    static bool attr = false;
    if (!attr) { (void)hipFuncSetAttribute((const void*)fwd_kernel, hipFuncAttributeMaxDynamicSharedMemorySize, LDS_BYTES); attr = true; }
    int ph = 0;
    while (ph < NPH) {
        const int sub = (ph == 0 || ph == NPH - 1) ? -1 : (ph - 1) % NSUB, layer = (ph == 0 || ph == NPH - 1) ? 0 : (ph - 1) / NSUB;
        if ((NAIVE_MIX || MIX_DEBUG) && sub == 2) { launch_phase<2>(p, layer, grid, stream); if (MIX_DEBUG) launch_phase<17>(p, layer, grid, stream); ++ph; continue; }
        if (NAIVE_SCORE && sub == 5) { launch_phase<5>(p, layer, grid, stream); ++ph; continue; }
        int hi = ph + 1;
        while (hi < NPH) { const int s2 = (hi == NPH - 1) ? -1 : (hi - 1) % NSUB; if (((NAIVE_MIX || MIX_DEBUG) && s2 == 2) || (NAIVE_SCORE && s2 == 5)) break; ++hi; }
        p.ph_lo = ph; p.ph_hi = hi;
        void* args[] = {&p};
        hipError_t e = hipLaunchCooperativeKernel((const void*)fwd_kernel, dim3(grid), dim3(NTHREADS), args, LDS_BYTES, stream);
        if (e != hipSuccess) fprintf(stderr, "cooperative launch failed: %s (grid %d, phases %d..%d)\n", hipGetErrorString(e), grid, ph, hi);
        ph = hi;
    }
}
```
